# Optimizing an MI355X kernel written in HIP

```python
import math
import jax, jax.numpy as jnp
from jax import lax
import numpy as np


D_MODEL = 1024
BATCH = 1
SEQ = 16384
DEPTH = 1
DEC_BATCH = 16
DEC_SEQ = 32
PAST_LEN = 4096

CHUNK = 64
Q_BLOCK = 128
N_MEM = 256
EPS = 1e-6
NEG_INF = -1e30
MLA_HEADS = 8
MLA_Q_RANK = 384
MLA_KV_RANK = 256
MLA_NOPE = 64
MLA_ROPE = 32
MLA_V = 64
MLA_THETA = 10000.0
MLA_SCALE = (MLA_NOPE + MLA_ROPE) ** -0.5
DIFF_HEADS = 8
DIFF_DC = 32
DIFF_V = 2 * DIFF_DC
DIFF_ROT = DIFF_DC // 4
ROPE_THETA = 500000.0
DIFF_SCALE = DIFF_DC ** -0.5
MEM_HEADS = 4
MEM_DH = 128
MEM_SCALE = MEM_DH ** -0.5
D_FF = 4 * D_MODEL
N_BRANCH = 3
DIFF_QK_W = DIFF_HEADS * 2 * DIFF_DC
DIFF_V_W = DIFF_HEADS * DIFF_V
MEM_W = MEM_HEADS * MEM_DH
MLA_O_W = MLA_HEADS * MLA_V
IN_SIZES = (MLA_Q_RANK, MLA_KV_RANK, MLA_ROPE, DIFF_QK_W, DIFF_QK_W, DIFF_V_W, MEM_W)
IN_SPLIT_POINTS = tuple(int(v) for v in np.cumsum(IN_SIZES)[:-1])
IN_WIDTH = int(sum(IN_SIZES))

kernel_name = "hybrid_mla_diffattn_memory_stream_step"


def rmsnorm(x, g):
    xf = x.astype(jnp.float32)
    y = xf * lax.rsqrt(jnp.mean(xf * xf, axis=-1, keepdims=True) + EPS)
    return (y * g.astype(jnp.float32)).astype(x.dtype)


def rope(x, pos, rot_dim, theta):
    half = rot_dim // 2
    inv = jnp.power(jnp.float32(theta), -jnp.arange(half, dtype=jnp.float32) * (2.0 / rot_dim))
    ang = pos.astype(jnp.float32)[:, None] * inv[None, :]
    shape = (1, pos.shape[0]) + (1,) * (x.ndim - 3) + (half,)
    c = jnp.cos(ang).reshape(shape)
    s = jnp.sin(ang).reshape(shape)
    xf = x.astype(jnp.float32)
    x1 = xf[..., :half]
    x2 = xf[..., half:rot_dim]
    out = jnp.concatenate([x1 * c - x2 * s, x2 * c + x1 * s, xf[..., rot_dim:]], axis=-1)
    return out.astype(x.dtype)


def sweep_queries(fn, q_args, q_pos):
    t = q_pos.shape[0]
    if t <= Q_BLOCK or t % Q_BLOCK != 0:
        return fn(q_args, q_pos)
    nb = t // Q_BLOCK

    def to_blocks(a):
        return jnp.moveaxis(a.reshape((a.shape[0], nb, Q_BLOCK) + a.shape[2:]), 1, 0)

    def from_blocks(o):
        return jnp.moveaxis(o, 0, 1).reshape((o.shape[1], t) + o.shape[3:])

    blocks = jax.tree_util.tree_map(to_blocks, q_args)
    outs = lax.map(lambda bp: fn(bp[0], bp[1]), (blocks, q_pos.reshape(nb, Q_BLOCK)))
    return jax.tree_util.tree_map(from_blocks, outs)


def memory_kv(mem, norm_g, w_k, w_v):
    b, m, _ = mem.shape
    mn = rmsnorm(mem, norm_g)
    k = jnp.einsum('bmd,de->bme', mn, w_k).reshape(b, m, MEM_HEADS, MEM_DH)
    v = jnp.einsum('bmd,de->bme', mn, w_v).reshape(b, m, MEM_HEADS, MEM_DH)
    return k, v


def layer_forward(x, pos, past, mem_k, mem_v, p, lam_init):
    b, t, _ = x.shape
    f32 = jnp.float32
    xn = rmsnorm(x, p['pre_mix_g'])
    proj = jnp.einsum('btd,de->bte', xn, p['w_in'])
    cq, ckv, kr, dq, dk, dv, mq = jnp.split(proj, IN_SPLIT_POINTS, axis=-1)

    q = jnp.einsum('btr,re->bte', rmsnorm(cq, p['mla_q_norm_g']), p['mla_w_uq'])
    q = q.reshape(b, t, MLA_HEADS, MLA_NOPE + MLA_ROPE)
    q_nope = q[..., :MLA_NOPE]
    q_rope = rope(q[..., MLA_NOPE:], pos, MLA_ROPE, MLA_THETA)
    ckv_new = rmsnorm(ckv, p['mla_kv_norm_g'])
    kr_new = rope(kr[:, :, None, :], pos, MLA_ROPE, MLA_THETA)[:, :, 0, :]

    dq = rope(dq.reshape(b, t, DIFF_HEADS, 2, DIFF_DC), pos, DIFF_ROT, ROPE_THETA)
    dk_new = rope(dk.reshape(b, t, DIFF_HEADS, 2, DIFF_DC), pos, DIFF_ROT, ROPE_THETA)
    dk_new = dk_new.reshape(b, t, DIFF_HEADS, DIFF_V)
    dv_new = dv.reshape(b, t, DIFF_HEADS, DIFF_V)

    mq = mq.reshape(b, t, MEM_HEADS, MEM_DH)

    if past is None:
        ckv_all, kr_all, dk_all, dv_all = ckv_new, kr_new, dk_new, dv_new
    else:
        ckv_all = jnp.concatenate([past[0], ckv_new], axis=1)
        kr_all = jnp.concatenate([past[1], kr_new], axis=1)
        dk_all = jnp.concatenate([past[2], dk_new], axis=1)
        dv_all = jnp.concatenate([past[3], dv_new], axis=1)
    s_len = ckv_all.shape[1]
    k_chunk = jnp.arange(s_len, dtype=jnp.int32) // CHUNK
    k_nope = jnp.einsum('bsr,rhn->bshn', ckv_all, p['mla_w_uk'])
    v_mla = jnp.einsum('bsr,rhv->bshv', ckv_all, p['mla_w_uv'])
    dk_all = dk_all.reshape(b, s_len, DIFF_HEADS, 2, DIFF_DC)
    lam = (jnp.exp(jnp.sum(p['diff_lq1'].astype(f32) * p['diff_lk1'].astype(f32)))
           - jnp.exp(jnp.sum(p['diff_lq2'].astype(f32) * p['diff_lk2'].astype(f32)))
           + lam_init)

    def block(qa, q_pos):
        qn, qr, qd, qm = qa
        mask = k_chunk[None, :] <= (q_pos // CHUNK)[:, None]
        s = (jnp.einsum('bthn,bshn->bhts', qn, k_nope)
             + jnp.einsum('bthe,bse->bhts', qr, kr_all)).astype(f32) * MLA_SCALE
        pm = jax.nn.softmax(jnp.where(mask, s, NEG_INF), axis=-1).astype(v_mla.dtype)
        o_a = jnp.einsum('bhts,bshv->bthv', pm, v_mla)
        sd = jnp.einsum('bthcd,bshcd->bchts', qd, dk_all).astype(f32) * DIFF_SCALE
        pd = jax.nn.softmax(jnp.where(mask, sd, NEG_INF), axis=-1)
        a = (pd[:, 0] - lam * pd[:, 1]).astype(dv_all.dtype)
        o_b = jnp.einsum('bhts,bshv->bthv', a, dv_all)
        sm = jnp.einsum('bthd,bmhd->bhtm', qm, mem_k).astype(f32) * MEM_SCALE
        pmem = jax.nn.softmax(sm, axis=-1).astype(mem_v.dtype)
        o_c = jnp.einsum('bhtm,bmhd->bthd', pmem, mem_v)
        return (o_a, o_b, o_c)

    o_a, o_b, o_c = sweep_queries(block, (q_nope, q_rope, dq, mq), pos)
    o_mla = o_a.reshape(b, t, MLA_O_W)
    o_diff = (rmsnorm(o_b, p['diff_subln_g']) * (1.0 - lam_init)).reshape(b, t, DIFF_V_W)
    o_mem = o_c.reshape(b, t, MEM_W)

    gates = jax.nn.sigmoid(jnp.einsum('btd,de->bte', xn, p['w_gate']) + p['b_gate'])
    gates = gates.reshape(b, t, N_BRANCH, D_MODEL)
    merged = (gates[:, :, 0] * jnp.einsum('bte,ed->btd', o_mla, p['w_o_mla'])
              + gates[:, :, 1] * jnp.einsum('bte,ed->btd', o_diff, p['w_o_diff'])
              + gates[:, :, 2] * jnp.einsum('bte,ed->btd', o_mem, p['w_o_mem']))
    mix = jnp.einsum('btd,de->bte', merged, p['w_out'])
    x = x + rmsnorm(mix, p['post_mix_g'])

    h = rmsnorm(x, p['pre_mlp_g'])
    u = jax.nn.relu(jnp.einsum('btd,df->btf', h, p['w_mlp_up']))
    f = jnp.einsum('btf,fd->btd', u * u, p['w_mlp_down'])
    x = x + rmsnorm(f, p['post_mlp_g'])
    return x, (ckv_new, kr_new, dk_new, dv_new)


def setup_inputs(seed: int = 0) -> dict:
    key = jax.random.key(seed)
    keys = list(jax.random.split(key, 40))

    def nrm(shape, scale=1.0):
        return scale * jax.random.normal(keys.pop(), shape, dtype=jnp.float32)

    def gain(n):
        return 1.0 + 0.05 * nrm((DEPTH, n))

    d = D_MODEL
    return {
        'x_prompt': nrm((BATCH, SEQ, d)),
        'x_sample': nrm((DEC_BATCH, DEC_SEQ, d)),
        'cache_mla_ckv': nrm((DEPTH, DEC_BATCH, PAST_LEN, MLA_KV_RANK)),
        'cache_mla_krope': nrm((DEPTH, DEC_BATCH, PAST_LEN, MLA_ROPE)),
        'cache_diff_k': nrm((DEPTH, DEC_BATCH, PAST_LEN, DIFF_HEADS, DIFF_V)),
        'cache_diff_v': nrm((DEPTH, DEC_BATCH, PAST_LEN, DIFF_HEADS, DIFF_V)),
        'cache_mem_k': nrm((DEPTH, DEC_BATCH, N_MEM, MEM_HEADS, MEM_DH)),
        'cache_mem_v': nrm((DEPTH, DEC_BATCH, N_MEM, MEM_HEADS, MEM_DH)),
        'mem_prompt': nrm((BATCH, N_MEM, d)),
        'pre_mix_g': gain(d),
        'w_in': nrm((DEPTH, d, IN_WIDTH), d ** -0.5),
        'mla_q_norm_g': gain(MLA_Q_RANK),
        'mla_w_uq': nrm((DEPTH, MLA_Q_RANK, MLA_HEADS * (MLA_NOPE + MLA_ROPE)), MLA_Q_RANK ** -0.5),
        'mla_kv_norm_g': gain(MLA_KV_RANK),
        'mla_w_uk': nrm((DEPTH, MLA_KV_RANK, MLA_HEADS, MLA_NOPE), MLA_KV_RANK ** -0.5),
        'mla_w_uv': nrm((DEPTH, MLA_KV_RANK, MLA_HEADS, MLA_V), MLA_KV_RANK ** -0.5),
        'diff_lq1': nrm((DEPTH, DIFF_DC), 0.1),
        'diff_lk1': nrm((DEPTH, DIFF_DC), 0.1),
        'diff_lq2': nrm((DEPTH, DIFF_DC), 0.1),
        'diff_lk2': nrm((DEPTH, DIFF_DC), 0.1),
        'diff_subln_g': gain(DIFF_V),
        'mem_norm_g': gain(d),
        'w_mem_k': nrm((DEPTH, d, MEM_W), d ** -0.5),
        'w_mem_v': nrm((DEPTH, d, MEM_W), d ** -0.5),
        'w_o_mla': nrm((DEPTH, MLA_O_W, d), MLA_O_W ** -0.5),
        'w_o_diff': nrm((DEPTH, DIFF_V_W, d), DIFF_V_W ** -0.5),
        'w_o_mem': nrm((DEPTH, MEM_W, d), MEM_W ** -0.5),
        'w_gate': nrm((DEPTH, d, N_BRANCH * d), d ** -0.5),
        'b_gate': nrm((DEPTH, N_BRANCH * d), 0.01),
        'w_out': nrm((DEPTH, d, d), d ** -0.5),
        'post_mix_g': gain(d),
        'pre_mlp_g': gain(d),
        'w_mlp_up': nrm((DEPTH, d, D_FF), d ** -0.5),
        'w_mlp_down': nrm((DEPTH, D_FF, d), D_FF ** -0.5),
        'post_mlp_g': gain(d),
    }


def reference(x_prompt, x_sample, cache_mla_ckv, cache_mla_krope, cache_diff_k, cache_diff_v,
              cache_mem_k, cache_mem_v, mem_prompt, pre_mix_g, w_in, mla_q_norm_g, mla_w_uq,
              mla_kv_norm_g, mla_w_uk, mla_w_uv, diff_lq1, diff_lk1, diff_lq2, diff_lk2,
              diff_subln_g, mem_norm_g, w_mem_k, w_mem_v, w_o_mla, w_o_diff, w_o_mem, w_gate,
              b_gate, w_out, post_mix_g, pre_mlp_g, w_mlp_up, w_mlp_down, post_mlp_g):
    past_len = cache_mla_ckv.shape[2]
    pos_p = jnp.arange(x_prompt.shape[1], dtype=jnp.int32)
    pos_s = past_len + jnp.arange(x_sample.shape[1], dtype=jnp.int32)
    xp, xs = x_prompt, x_sample
    p_ckv, p_kr, p_dk, p_dv, p_mk, p_mv = [], [], [], [], [], []
    s_ckv, s_kr, s_dk, s_dv = [], [], [], []
    for l in range(DEPTH):
        lam_init = 0.8 - 0.6 * math.exp(-0.3 * l)
        p = {
            'pre_mix_g': pre_mix_g[l], 'w_in': w_in[l],
            'mla_q_norm_g': mla_q_norm_g[l], 'mla_w_uq': mla_w_uq[l],
            'mla_kv_norm_g': mla_kv_norm_g[l], 'mla_w_uk': mla_w_uk[l], 'mla_w_uv': mla_w_uv[l],
            'diff_lq1': diff_lq1[l], 'diff_lk1': diff_lk1[l],
            'diff_lq2': diff_lq2[l], 'diff_lk2': diff_lk2[l], 'diff_subln_g': diff_subln_g[l],
            'w_o_mla': w_o_mla[l], 'w_o_diff': w_o_diff[l], 'w_o_mem': w_o_mem[l],
            'w_gate': w_gate[l], 'b_gate': b_gate[l], 'w_out': w_out[l],
            'post_mix_g': post_mix_g[l], 'pre_mlp_g': pre_mlp_g[l],
            'w_mlp_up': w_mlp_up[l], 'w_mlp_down': w_mlp_down[l], 'post_mlp_g': post_mlp_g[l],
        }
        mk_p, mv_p = memory_kv(mem_prompt, mem_norm_g[l], w_mem_k[l], w_mem_v[l])
        xp, rows_p = layer_forward(xp, pos_p, None, mk_p, mv_p, p, lam_init)
        past = (cache_mla_ckv[l], cache_mla_krope[l], cache_diff_k[l], cache_diff_v[l])
        xs, rows_s = layer_forward(xs, pos_s, past, cache_mem_k[l], cache_mem_v[l], p, lam_init)
        p_ckv.append(rows_p[0]); p_kr.append(rows_p[1]); p_dk.append(rows_p[2]); p_dv.append(rows_p[3])
        p_mk.append(mk_p); p_mv.append(mv_p)
        s_ckv.append(rows_s[0]); s_kr.append(rows_s[1]); s_dk.append(rows_s[2]); s_dv.append(rows_s[3])
    new_p_ckv = jnp.stack(p_ckv, axis=0)
    new_p_krope = jnp.stack(p_kr, axis=0)
    new_p_dk = jnp.stack(p_dk, axis=0)
    new_p_dv = jnp.stack(p_dv, axis=0)
    new_p_mem_k = jnp.stack(p_mk, axis=0)
    new_p_mem_v = jnp.stack(p_mv, axis=0)
    new_s_ckv = jnp.stack(s_ckv, axis=0)
    new_s_krope = jnp.stack(s_kr, axis=0)
    new_s_dk = jnp.stack(s_dk, axis=0)
    new_s_dv = jnp.stack(s_dv, axis=0)
    return (xp, xs, new_p_ckv, new_p_krope, new_p_dk, new_p_dv, new_p_mem_k, new_p_mem_v,
            new_s_ckv, new_s_krope, new_s_dk, new_s_dv)
```

```cpp
#include <hip/hip_runtime.h>
#include <hip/hip_cooperative_groups.h>
#include <cstdio>
#include <cstdint>
namespace cg = cooperative_groups;
namespace pg8 {
#define PG8_LAS __attribute__((address_space(3)))
typedef unsigned short bf16_t;
typedef short bf16x8 __attribute__((ext_vector_type(8)));
typedef float f32x4 __attribute__((ext_vector_type(4)));
typedef unsigned u32x4 __attribute__((ext_vector_type(4)));
constexpr int BM = 256, BK = 64, HALF = 128, HTB = HALF * BK * 2  , STAGE_BYTES = 8 * HTB, NXCD = 8, WGM = 8;

__host__ __device__ __forceinline__ int lds_byte(int r, int c) { const int st = (r >> 4) * 2 + (c >> 5), rr = r & 15, cc = c & 31, ob = rr * 64 + cc * 2; return st * 1024 + (ob ^ (((ob >> 9) & 1) << 5)); }
__host__ __device__ __forceinline__ void stage_rc(int b, int& R, int& C) { const int st = b / 1024, sb = b % 1024, swz = sb ^ (((sb >> 9) & 1) << 5); R = (st >> 1) * 16 + swz / 64; C = (st & 1) * 32 + (swz % 64) / 2; }
__host__ __device__ __forceinline__ int perm32(int rho) { const int n = rho >> 4, i = rho & 15; return 8 * (i >> 2) + 4 * n + (i & 3); }

struct Unit { int pm, pn; };
struct Gemm { const bf16_t* A; const bf16_t* Bt; int M, N, K; };

struct StaticOrder {
    int nM, nN, nwg, G, c;
    __host__ __device__ void init(int M, int N, int G_, int c_) { nM = M / BM; nN = N / BM; nwg = nM * nN; G = G_; c = c_; }
    __host__ __device__ bool next(int i, Unit& u) const {
        const long L = (long)i * G + c; if (L >= nwg) return false;
        int wgid = (int)L; { const int q = nwg / NXCD, r = nwg % NXCD, xcd = wgid % NXCD, off = wgid / NXCD; wgid = (xcd < r ? xcd * (q + 1) : r * (q + 1) + (xcd - r) * q) + off; }
        const int nig = WGM * nN, gid = wgid / nig, fm = gid * WGM, gsz = (nM - fm) < WGM ? (nM - fm) : WGM;
        u.pm = fm + ((wgid % nig) % gsz); u.pn = (wgid % nig) / gsz; return true;
    }
    __device__ __forceinline__ void a_ready(const Unit&) const {}
    __device__ __forceinline__ void done(const Unit&) const {}
};

__device__ __forceinline__ unsigned cvt_pk_bf16(float lo, float hi) { unsigned r; asm volatile("v_cvt_pk_bf16_f32 %0, %1, %2" : "=v"(r) : "v"(lo), "v"(hi)); return r; }
template <class Epi, class Sched, bool ALIGN_EPI = false, bool SP2 = false>
__device__ __forceinline__ void gemm_phase(PG8_LAS unsigned char* lds, const Gemm g, const Sched& S, const Epi& E) {
    int tid_l = threadIdx.x; asm volatile("" : "+v"(tid_l));
    const int tid = tid_l, wid = __builtin_amdgcn_readfirstlane(tid >> 6), lane = tid & 63, wr = wid >> 2, wc = wid & 3, fr = lane & 15, fq = lane >> 4;
    const int K = g.K, nt = K / BK;
    unsigned voffA[2], voffB[2];
#pragma unroll
    for (int i = 0; i < 2; ++i) { int R, C; stage_rc(tid * 16 + i * 8192, R, C); const int Rb = Epi::PERM ? ((R & ~31) + perm32(R & 31)) : R;
        voffA[i] = (unsigned)(R * K + C) * 2u; voffB[i] = (unsigned)(Rb * K + C) * 2u; }
    const size_t kstep = (size_t)(BK * 2);
    const size_t hstep = (size_t)HALF * K * 2;
    const size_t tstep = 2 * hstep;
    const unsigned ldsw = (unsigned)wid * 1024u;
    const int aoff = lds_byte(wr * 64 + fr, fq * 8), boff = lds_byte(wc * 32 + fr, fq * 8);
#define PG8_SA(b, h) (((b) * 2 + (h)) * HTB)
#define PG8_SB(b, h) ((4 + (b) * 2 + (h)) * HTB)
#define PG8_STAGE(bufoff, gbase, voff) do { _Pragma("unroll") for (int _i = 0; _i < 2; ++_i) \
        __builtin_amdgcn_global_load_lds((const unsigned*)((const char*)(gbase) + (voff)[_i]), (PG8_LAS unsigned*)(lds + (bufoff) + ldsw + _i * 8192), 16, 0, 0); } while (0)
#define PG8_LDA(dst, b, h) do { _Pragma("unroll") for (int m = 0; m < 4; ++m) _Pragma("unroll") for (int k = 0; k < 2; ++k) dst[m][k] = *(const PG8_LAS bf16x8*)(lds + PG8_SA(b, h) + aoff + m * 2048 + k * 1024); } while (0)
#define PG8_LDB(dst, b, h) do { _Pragma("unroll") for (int n = 0; n < 2; ++n) _Pragma("unroll") for (int k = 0; k < 2; ++k) dst[n][k] = *(const PG8_LAS bf16x8*)(lds + PG8_SB(b, h) + boff + n * 2048 + k * 1024); } while (0)
#define PG8_MMA(ai, bj, At, Bt) do { __builtin_amdgcn_s_setprio(1); _Pragma("unroll") for (int m = 0; m < 4; ++m) _Pragma("unroll") for (int n = 0; n < 2; ++n) _Pragma("unroll") for (int k = 0; k < 2; ++k) \
        acc[ai][bj][m][n] = __builtin_amdgcn_mfma_f32_16x16x32_bf16(Bt[n][k], At[m][k], acc[ai][bj][m][n], 0, 0, 0); __builtin_amdgcn_s_setprio(0); } while (0)
#define PG8_WAIT_V(n) asm volatile("s_waitcnt vmcnt(" #n ")" ::: "memory")
#define PG8_WAIT_L(n) asm volatile("s_waitcnt lgkmcnt(" #n ")" ::: "memory")
#define PG8_BAR __builtin_amdgcn_s_barrier()
#define PG8_SCHED __builtin_amdgcn_sched_barrier(0)
    Unit cur, nxt; int ui = 0;
    if (!S.next(0, cur)) return;
    f32x4 acc[2][2][4][2];
#pragma unroll
    for (int a = 0; a < 2; ++a)
#pragma unroll
        for (int b = 0; b < 2; ++b)
#pragma unroll
            for (int m = 0; m < 4; ++m)
#pragma unroll
                for (int n = 0; n < 2; ++n) acc[a][b][m][n] = (f32x4){0.f, 0.f, 0.f, 0.f};
    bf16x8 At[4][2], B0[2][2], B1[2][2];
    const char* cA = (const char*)g.A + (size_t)cur.pm * tstep; const char* cB = (const char*)g.Bt + (size_t)cur.pn * tstep;
    S.a_ready(cur);
    if constexpr (SP2) {
        PG8_STAGE(PG8_SB(0, 0), cB, voffB); PG8_STAGE(PG8_SB(0, 1), cB + hstep, voffB); PG8_STAGE(PG8_SA(0, 0), cA, voffA); PG8_STAGE(PG8_SA(0, 1), cA + hstep, voffA);
        if (wr == 1) PG8_BAR;
        PG8_WAIT_V(2); PG8_BAR;
        PG8_STAGE(PG8_SB(1, 0), cB + kstep, voffB); PG8_STAGE(PG8_SA(1, 0), cA + kstep, voffA); PG8_STAGE(PG8_SB(1, 1), cB + hstep + kstep, voffB);
        PG8_WAIT_V(6); PG8_BAR;
    } else {
        PG8_STAGE(PG8_SB(0, 0), cB, voffB); PG8_STAGE(PG8_SA(0, 0), cA, voffA); PG8_STAGE(PG8_SB(0, 1), cB + hstep, voffB); PG8_STAGE(PG8_SA(0, 1), cA + hstep, voffA);
        if (wr == 1) PG8_BAR;
        PG8_WAIT_V(4); PG8_BAR;
        PG8_STAGE(PG8_SB(1, 0), cB + kstep, voffB); PG8_STAGE(PG8_SA(1, 0), cA + kstep, voffA); PG8_STAGE(PG8_SB(1, 1), cB + hstep + kstep, voffB);
        PG8_WAIT_V(6); PG8_BAR;
    }
    for (;;) {
        const bool has_next = S.next(ui + 1, nxt);
        const char* nA = has_next ? (const char*)g.A + (size_t)nxt.pm * tstep : cA; const char* nB = has_next ? (const char*)g.Bt + (size_t)nxt.pn * tstep : cB;
        _Pragma("unroll 1") for (int t = 0; t < nt; t += 2) {
            const bool last = (t == nt - 2);
            const char* a1 = cA + (size_t)(t + 1) * kstep;
            const char* a2 = last ? nA : cA + (size_t)(t + 2) * kstep; const char* b2 = last ? nB : cB + (size_t)(t + 2) * kstep;
            const char* a3 = a2 + kstep; const char* b3 = b2 + kstep;
            if (last && has_next) S.a_ready(nxt);
            if constexpr (SP2) {
            PG8_LDB(B0, 0, 0); PG8_LDB(B1, 0, 1); PG8_SCHED; PG8_LDA(At, 0, 0); PG8_STAGE(PG8_SA(1, 1), a1 + hstep, voffA);
            PG8_WAIT_V(8); PG8_WAIT_L(0); PG8_BAR; PG8_MMA(0, 0, At, B0); PG8_MMA(0, 1, At, B1); PG8_BAR; PG8_SCHED;
            PG8_LDA(At, 0, 1); PG8_STAGE(PG8_SB(0, 0), b2, voffB); PG8_STAGE(PG8_SB(0, 1), b2 + hstep, voffB); PG8_STAGE(PG8_SA(0, 0), a2, voffA);
            PG8_WAIT_V(8); PG8_WAIT_L(0); PG8_BAR; PG8_MMA(1, 0, At, B0); PG8_MMA(1, 1, At, B1); PG8_BAR; PG8_SCHED;
            PG8_LDB(B0, 1, 0); PG8_LDB(B1, 1, 1); PG8_SCHED; PG8_LDA(At, 1, 0); PG8_STAGE(PG8_SA(0, 1), a2 + hstep, voffA);
            PG8_WAIT_V(8); PG8_WAIT_L(0); PG8_BAR; PG8_MMA(0, 0, At, B0); PG8_MMA(0, 1, At, B1); PG8_BAR; PG8_SCHED;
            PG8_LDA(At, 1, 1); PG8_STAGE(PG8_SB(1, 0), b3, voffB); PG8_STAGE(PG8_SB(1, 1), b3 + hstep, voffB); PG8_STAGE(PG8_SA(1, 0), a3, voffA);
            PG8_WAIT_V(8); PG8_WAIT_L(0); PG8_BAR; PG8_MMA(1, 0, At, B0); PG8_MMA(1, 1, At, B1); PG8_BAR; PG8_SCHED;
            } else {
            PG8_LDB(B0, 0, 0); PG8_SCHED; PG8_LDA(At, 0, 0); PG8_STAGE(PG8_SA(1, 1), a1 + hstep, voffA);
            PG8_WAIT_L(8); PG8_BAR; PG8_WAIT_L(0); PG8_MMA(0, 0, At, B0); PG8_BAR; PG8_SCHED;
            PG8_LDB(B1, 0, 1); PG8_STAGE(PG8_SB(0, 0), b2, voffB);
            PG8_BAR; PG8_WAIT_L(0); PG8_MMA(0, 1, At, B1); PG8_BAR;
            PG8_LDA(At, 0, 1); PG8_STAGE(PG8_SA(0, 0), a2, voffA);
            PG8_BAR; PG8_WAIT_L(0); PG8_MMA(1, 0, At, B0); PG8_BAR; PG8_SCHED;
            PG8_STAGE(PG8_SB(0, 1), b2 + hstep, voffB);
            PG8_WAIT_V(6); PG8_BAR; PG8_MMA(1, 1, At, B1); PG8_BAR;
            PG8_LDB(B0, 1, 0); PG8_SCHED; PG8_LDA(At, 1, 0); PG8_STAGE(PG8_SA(0, 1), a2 + hstep, voffA);
            PG8_WAIT_L(8); PG8_BAR; PG8_WAIT_L(0); PG8_MMA(0, 0, At, B0); PG8_BAR; PG8_SCHED;
            PG8_LDB(B1, 1, 1); PG8_STAGE(PG8_SB(1, 0), b3, voffB);
            PG8_BAR; PG8_WAIT_L(0); PG8_MMA(0, 1, At, B1); PG8_BAR;
            PG8_LDA(At, 1, 1); PG8_STAGE(PG8_SA(1, 0), a3, voffA);
            PG8_BAR; PG8_WAIT_L(0); PG8_MMA(1, 0, At, B0); PG8_BAR; PG8_SCHED;
            PG8_STAGE(PG8_SB(1, 1), b3 + hstep, voffB);
            PG8_WAIT_V(6); PG8_BAR; PG8_MMA(1, 1, At, B1); PG8_BAR;
            }
        }
        if constexpr (ALIGN_EPI) { if (wr == 0) PG8_BAR; }
        if constexpr (!Epi::AFTER_DRAIN) { E(acc, cur, wr, wc, fr, fq); S.done(cur); }
        if (!has_next) break;
#pragma unroll
        for (int a = 0; a < 2; ++a)
#pragma unroll
            for (int b = 0; b < 2; ++b)
#pragma unroll
                for (int m = 0; m < 4; ++m)
#pragma unroll
                    for (int n = 0; n < 2; ++n) acc[a][b][m][n] = (f32x4){0.f, 0.f, 0.f, 0.f};
        cur = nxt; cA = nA; cB = nB; ++ui;
        if constexpr (ALIGN_EPI) { if (wr == 1) PG8_BAR; }
    }
    PG8_WAIT_V(0);
    if constexpr (!ALIGN_EPI) { if (wr == 0) PG8_BAR; }
    PG8_BAR;
    if constexpr (Epi::AFTER_DRAIN) { E.fused(acc, cur, wr, wc, fr, fq, lds, wid, lane); S.done(cur); }
#undef PG8_SA
#undef PG8_SB
#undef PG8_STAGE
#undef PG8_LDA
#undef PG8_LDB
#undef PG8_MMA
#undef PG8_WAIT_V
#undef PG8_WAIT_L
#undef PG8_BAR
#undef PG8_SCHED
}
}

#define LAS __attribute__((address_space(3)))
#define DI __device__ __forceinline__
typedef unsigned short bf16;
typedef unsigned u32x4 __attribute__((ext_vector_type(4)));
typedef unsigned u32x2 __attribute__((ext_vector_type(2)));
typedef float f32x4 __attribute__((ext_vector_type(4)));
typedef float f32x2 __attribute__((ext_vector_type(2)));
typedef float f32x16 __attribute__((ext_vector_type(16)));
typedef short bf16x8 __attribute__((ext_vector_type(8)));
typedef short s16x4 __attribute__((ext_vector_type(4)));
typedef __bf16 bf16x2_t __attribute__((ext_vector_type(2)));

constexpr int DM = 1024, SEQ = 16384, NSB = 16, NST = 32, PAST = 4096, NMEM = 256;
constexpr int MROWS = SEQ + NSB * NST;
constexpr int SKEYS = PAST + NST;
constexpr int MKROWS = SEQ + NSB * SKEYS;
constexpr int INWP = 2816, NING = INWP + 3072;
constexpr int DFF = 4096;
constexpr float EPSN = 1e-6f;
constexpr float LOG2E = 1.4426950408889634f;
constexpr float C_MLA = 0.10206207261596575f * LOG2E;
constexpr float C_DIFF = 0.17677669529663687f * LOG2E;
constexpr float C_MEM = 0.08838834764831845f * LOG2E;
constexpr float LAM_INIT = 0.2f;

constexpr size_t O_Y = 0;
constexpr size_t O_PCKV = (size_t)MROWS * DM;
constexpr size_t O_PKR = O_PCKV + (size_t)SEQ * 256;
constexpr size_t O_PDK = O_PKR + (size_t)SEQ * 32;
constexpr size_t O_PDV = O_PDK + (size_t)SEQ * 512;
constexpr size_t O_PMK = O_PDV + (size_t)SEQ * 512;
constexpr size_t O_PMV = O_PMK + (size_t)NMEM * 512;
constexpr size_t O_SCKV = O_PMV + (size_t)NMEM * 512;
constexpr size_t O_SKR = O_SCKV + (size_t)512 * 256;
constexpr size_t O_SDK = O_SKR + (size_t)512 * 32;
constexpr size_t O_SDV = O_SDK + (size_t)512 * 512;
constexpr size_t O_END = O_SDV + (size_t)512 * 512;

constexpr size_t MiB = 1u << 20;
constexpr size_t WS_TABM = 1 * MiB;
constexpr size_t WS_TABD = 3 * MiB;
constexpr size_t WS_W = 4 * MiB;
constexpr size_t W_ING = WS_W;
constexpr size_t W_UQ = W_ING + (size_t)NING * 1024 * 2;
constexpr size_t W_UKV = W_UQ + (size_t)768 * 384 * 2;
constexpr size_t W_MEM = W_UKV + (size_t)1024 * 256 * 2;
constexpr size_t W_OM = W_MEM + (size_t)1024 * 1024 * 2;
constexpr size_t W_OUT = W_OM + (size_t)3 * 1024 * 512 * 2;
constexpr size_t W_UP = W_OUT + (size_t)1024 * 1024 * 2;
constexpr size_t W_DN = W_UP + (size_t)4096 * 1024 * 2;
constexpr size_t W_END = W_DN + (size_t)1024 * 4096 * 2;
static_assert(W_END <= 44 * MiB, "weights");
constexpr size_t WS_G = 44 * MiB;
constexpr size_t WS_MIX = 44 * MiB;
constexpr size_t WS_DQ = 148 * MiB;
constexpr size_t WS_MQ = 165 * MiB;
constexpr size_t WS_QM = 182 * MiB;
constexpr size_t WS_DKP = 208 * MiB;
constexpr size_t WS_DVP = 225 * MiB;
constexpr size_t WS_KR = 242 * MiB;
constexpr size_t WS_MK = 248 * MiB;
constexpr size_t WS_MV = 253 * MiB;
constexpr size_t WS_LAT = 258 * MiB;
constexpr size_t WS_CQN = 299 * MiB;
constexpr size_t WS_OA = 258 * MiB;
constexpr size_t WS_XN = 312 * MiB;
constexpr size_t WS_CQ = 346 * MiB;
constexpr size_t WS_KN = 312 * MiB;
constexpr size_t WS_VM = 393 * MiB;
constexpr size_t WS_MRG = 348 * MiB;
constexpr size_t WS_MRGB = 416 * MiB;
constexpr size_t WS_U = 348 * MiB;
constexpr size_t WS_END = 480 * MiB;
static_assert(WS_KR + (size_t)MKROWS * 32 * 2 <= WS_MK && WS_LAT + (size_t)MKROWS * 256 * 2 <= WS_CQN && WS_CQN + (size_t)MROWS * 384 * 2 <= WS_XN, "ws map 1");
static_assert(WS_OA + (size_t)3 * MROWS * 512 * 2 <= WS_XN && WS_XN + (size_t)MROWS * 1024 * 2 <= WS_CQ && WS_KN + (size_t)MKROWS * 512 * 2 <= WS_VM, "ws map 2");
static_assert(WS_VM + (size_t)MKROWS * 512 * 2 <= WS_END && WS_MRG + (size_t)MROWS * 1024 * 4 <= WS_MRGB && WS_U + (size_t)MROWS * 4096 * 2 <= WS_END, "ws map 3");
static_assert(WS_G + (size_t)MROWS * 3072 * 2 <= WS_DQ && WS_QM + (size_t)MROWS * 768 * 2 <= WS_DKP && WS_MK + (size_t)17 * 256 * 512 * 2 <= WS_MV && WS_MV + (size_t)17 * 256 * 512 * 2 <= WS_LAT, "ws map 4");

DI unsigned pk2(float lo, float hi) { f32x2 v = {lo, hi}; bf16x2_t b = __builtin_convertvector(v, bf16x2_t); return __builtin_bit_cast(unsigned, b); }
DI u32x4 pk8(f32x4 a, f32x4 b) { u32x4 w; w.x = pk2(a[0], a[1]); w.y = pk2(a[2], a[3]); w.z = pk2(b[0], b[1]); w.w = pk2(b[2], b[3]); return w; }
DI float bf_lo(unsigned u) { return __uint_as_float(u << 16); }
DI float bf_hi(unsigned u) { return __uint_as_float(u & 0xffff0000u); }
DI float wave_sum(float v) {
#pragma unroll
    for (int o = 1; o < 64; o <<= 1) v += __shfl_xor(v, o);
    return v;
}
DI int row_pos(int row) { return row < SEQ ? row : PAST + ((row - SEQ) & 31); }
DI int row_krow(int row) { if (row < SEQ) return row; const int rs = row - SEQ; return SEQ + (rs >> 5) * SKEYS + PAST + (rs & 31); }
DI float* out_row(float* out, int row, size_t offP, size_t offS, int W) { return row < SEQ ? out + offP + (size_t)row * W : out + offS + (size_t)(row - SEQ) * W; }

#define EPI_ROWS_BEGIN _Pragma("unroll") for (int ai = 0; ai < 2; ++ai) _Pragma("unroll") for (int m = 0; m < 4; ++m) { int row = row0 + ai * 128 + m * 16; asm volatile("" : "+v"(row)); f32x4 v0 = acc[ai][bj][m][0], v1 = acc[ai][bj][m][1];
#define EPI_ROWS_END asm volatile("" ::: "memory"); }

struct EpiP1 {
    static constexpr bool PERM = true, AFTER_DRAIN = false;
    bf16* CQ; bf16* KR; bf16* DQ; bf16* DKP; bf16* DVP; bf16* MQ; bf16* G; float* out; const float* bgate; const float* tabm; const float* tabd;
    DI void operator()(const f32x4 (&acc)[2][2][4][2], const pg8::Unit& u, int wr, int wc, int fr, int fq) const {
        const int row0 = u.pm * 256 + wr * 64 + fr;
#pragma unroll
        for (int bj = 0; bj < 2; ++bj) {
            const int cgp = u.pn * 256 + bj * 128 + wc * 32;
            const int c = cgp + 8 * fq;
            if (cgp >= INWP) {
                const int gc = c - INWP;
                const f32x4 b0 = *(const f32x4*)(bgate + gc), b1 = *(const f32x4*)(bgate + gc + 4);
                EPI_ROWS_BEGIN
                    v0 += b0; v1 += b1;
#pragma unroll
                    for (int e = 0; e < 4; ++e) { v0[e] = 1.f / (1.f + __expf(-v0[e])); v1[e] = 1.f / (1.f + __expf(-v1[e])); }
                    *(u32x4*)(G + (size_t)row * 3072 + gc) = pk8(v0, v1);
                EPI_ROWS_END
            } else if (cgp < 384) {
                EPI_ROWS_BEGIN
                    *(u32x4*)(CQ + (size_t)row * 384 + c) = pk8(v0, v1);
                EPI_ROWS_END
            } else if (cgp < 640) {
                EPI_ROWS_BEGIN
                    float* p = out_row(out, row, O_PCKV, O_SCKV, 256) + (c - 384);
                    *(f32x4*)p = v0; *(f32x4*)(p + 4) = v1;
                EPI_ROWS_END
            } else if (cgp < 672) {
                EPI_ROWS_BEGIN
                    f32x4 p0, p1;
#pragma unroll
                    for (int e = 0; e < 4; ++e) { p0[e] = __shfl_xor(v0[e], 32); p1[e] = __shfl_xor(v1[e], 32); }
                    const float* tb = tabm + (size_t)row_pos(row) * 32 + 8 * (fq & 1);
                    const f32x4 c0 = *(const f32x4*)tb, c1 = *(const f32x4*)(tb + 4), s0 = *(const f32x4*)(tb + 16), s1 = *(const f32x4*)(tb + 20);
                    f32x4 o0, o1;
                    if (fq < 2) { o0 = v0 * c0 - p0 * s0; o1 = v1 * c1 - p1 * s1; } else { o0 = v0 * c0 + p0 * s0; o1 = v1 * c1 + p1 * s1; }
                    float* p = out_row(out, row, O_PKR, O_SKR, 32) + (c - 640);
                    *(f32x4*)p = o0; *(f32x4*)(p + 4) = o1;
                    *(u32x4*)(KR + (size_t)row_krow(row) * 32 + (c - 640)) = pk8(o0, o1);
                    asm volatile("" ::: "memory");
                EPI_ROWS_END
            } else if (cgp < 1696) {
                const bool isq = cgp < 1184;
                EPI_ROWS_BEGIN
                    if (fq == 0) {
                        const float* tb = tabd + (size_t)row_pos(row) * 8;
                        const f32x4 cc = *(const f32x4*)tb, ss = *(const f32x4*)(tb + 4);
                        const f32x4 n0 = v0 * cc - v1 * ss, n1 = v1 * cc + v0 * ss; v0 = n0; v1 = n1;
                    }
                    if (isq) { v0 *= C_DIFF; v1 *= C_DIFF; *(u32x4*)(DQ + (size_t)row * 512 + (c - 672)) = pk8(v0, v1); }
                    else {
                        float* p = out_row(out, row, O_PDK, O_SDK, 512) + (c - 1184);
                        *(f32x4*)p = v0; *(f32x4*)(p + 4) = v1;
                        if (row < SEQ) *(u32x4*)(DKP + (size_t)row * 512 + (c - 1184)) = pk8(v0, v1);
                    }
                EPI_ROWS_END
            } else if (cgp < 2208) {
                EPI_ROWS_BEGIN
                    float* p = out_row(out, row, O_PDV, O_SDV, 512) + (c - 1696);
                    *(f32x4*)p = v0; *(f32x4*)(p + 4) = v1;
                    if (row < SEQ) *(u32x4*)(DVP + (size_t)row * 512 + (c - 1696)) = pk8(v0, v1);
                EPI_ROWS_END
            } else if (cgp < 2720) {
                EPI_ROWS_BEGIN
                    v0 *= C_MEM; v1 *= C_MEM;
                    *(u32x4*)(MQ + (size_t)row * 512 + (c - 2208)) = pk8(v0, v1);
                EPI_ROWS_END
            }
        }
    }
};

struct EpiMemKV {
    static constexpr bool PERM = true, AFTER_DRAIN = false;
    float* out; bf16* MK; bf16* MV;
    DI void operator()(const f32x4 (&acc)[2][2][4][2], const pg8::Unit& u, int wr, int wc, int fr, int fq) const {
        const int row0 = u.pm * 256 + wr * 64 + fr;
#pragma unroll
        for (int bj = 0; bj < 2; ++bj) {
            const int c = u.pn * 256 + bj * 128 + wc * 32 + 8 * fq;
            const bool isk = c < 512; const int cc = isk ? c : c - 512;
            float* ob = out + (isk ? O_PMK : O_PMV); bf16* bb = isk ? MK : MV;
            EPI_ROWS_BEGIN
                float* p = ob + (size_t)row * 512 + cc; *(f32x4*)p = v0; *(f32x4*)(p + 4) = v1;
                *(u32x4*)(bb + (size_t)row * 512 + cc) = pk8(v0, v1);
            EPI_ROWS_END
        }
    }
};

struct EpiUQ {
    static constexpr bool PERM = true, AFTER_DRAIN = false;
    bf16* QM; const float* tabm;
    DI void operator()(const f32x4 (&acc)[2][2][4][2], const pg8::Unit& u, int wr, int wc, int fr, int fq) const {
        const int row0 = u.pm * 256 + wr * 64 + fr;
#pragma unroll
        for (int bj = 0; bj < 2; ++bj) {
            const int cgp = u.pn * 256 + bj * 128 + wc * 32; const int c = cgp + 8 * fq;
            const bool isrope = ((cgp >> 5) % 3) == 2;
            if (isrope) {
                EPI_ROWS_BEGIN
                    f32x4 p0, p1;
#pragma unroll
                    for (int e = 0; e < 4; ++e) { p0[e] = __shfl_xor(v0[e], 32); p1[e] = __shfl_xor(v1[e], 32); }
                    const float* tb = tabm + (size_t)row_pos(row) * 32 + 8 * (fq & 1);
                    const f32x4 c0 = *(const f32x4*)tb, c1 = *(const f32x4*)(tb + 4), s0 = *(const f32x4*)(tb + 16), s1 = *(const f32x4*)(tb + 20);
                    f32x4 o0, o1;
                    if (fq < 2) { o0 = v0 * c0 - p0 * s0; o1 = v1 * c1 - p1 * s1; } else { o0 = v0 * c0 + p0 * s0; o1 = v1 * c1 + p1 * s1; }
                    o0 *= C_MLA; o1 *= C_MLA;
                    *(u32x4*)(QM + (size_t)row * 768 + c) = pk8(o0, o1);
                    asm volatile("" ::: "memory");
                EPI_ROWS_END
            } else {
                EPI_ROWS_BEGIN
                    v0 *= C_MLA; v1 *= C_MLA;
                    *(u32x4*)(QM + (size_t)row * 768 + c) = pk8(v0, v1);
                EPI_ROWS_END
            }
        }
    }
};

struct EpiBf16Split {
    static constexpr bool PERM = true, AFTER_DRAIN = false;
    bf16* A; bf16* B;
    DI void operator()(const f32x4 (&acc)[2][2][4][2], const pg8::Unit& u, int wr, int wc, int fr, int fq) const {
        const int row0 = u.pm * 256 + wr * 64 + fr;
#pragma unroll
        for (int bj = 0; bj < 2; ++bj) {
            const int c = u.pn * 256 + bj * 128 + wc * 32 + 8 * fq;
            bf16* bb = c < 512 ? A + c : B + (c - 512);
            EPI_ROWS_BEGIN
                *(u32x4*)(bb + (size_t)row * 512) = pk8(v0, v1);
            EPI_ROWS_END
        }
    }
};

template <int BR> struct EpiMerge {
    static constexpr bool PERM = true, AFTER_DRAIN = false;
    const bf16* G; float* MRG; bf16* MRGB;
    DI void operator()(const f32x4 (&acc)[2][2][4][2], const pg8::Unit& u, int wr, int wc, int fr, int fq) const {
        const int row0 = u.pm * 256 + wr * 64 + fr;
#pragma unroll
        for (int bj = 0; bj < 2; ++bj) {
            const int c = u.pn * 256 + bj * 128 + wc * 32 + 8 * fq;
            EPI_ROWS_BEGIN
                const u32x4 g = *(const u32x4*)(G + (size_t)row * 3072 + BR * 1024 + c);
                const f32x4 g0 = {bf_lo(g.x), bf_hi(g.x), bf_lo(g.y), bf_hi(g.y)}, g1 = {bf_lo(g.z), bf_hi(g.z), bf_lo(g.w), bf_hi(g.w)};
                v0 *= g0; v1 *= g1;
                float* p = MRG + (size_t)row * 1024 + c;
                if (BR > 0) { v0 += *(const f32x4*)p; v1 += *(const f32x4*)(p + 4); }
                if (BR < 2) { *(f32x4*)p = v0; *(f32x4*)(p + 4) = v1; }
                else *(u32x4*)(MRGB + (size_t)row * 1024 + c) = pk8(v0, v1);
            EPI_ROWS_END
        }
    }
};

struct EpiF32 {
    static constexpr bool PERM = true, AFTER_DRAIN = false;
    float* O; int ldc;
    DI void operator()(const f32x4 (&acc)[2][2][4][2], const pg8::Unit& u, int wr, int wc, int fr, int fq) const {
        const int row0 = u.pm * 256 + wr * 64 + fr;
#pragma unroll
        for (int bj = 0; bj < 2; ++bj) {
            const int c = u.pn * 256 + bj * 128 + wc * 32 + 8 * fq;
            EPI_ROWS_BEGIN
                float* p = O + (size_t)row * ldc + c; *(f32x4*)p = v0; *(f32x4*)(p + 4) = v1;
            EPI_ROWS_END
        }
    }
};

struct EpiUp {
    static constexpr bool PERM = true, AFTER_DRAIN = false;
    bf16* U;
    DI void operator()(const f32x4 (&acc)[2][2][4][2], const pg8::Unit& u, int wr, int wc, int fr, int fq) const {
        const int row0 = u.pm * 256 + wr * 64 + fr;
#pragma unroll
        for (int bj = 0; bj < 2; ++bj) {
            const int c = u.pn * 256 + bj * 128 + wc * 32 + 8 * fq;
            EPI_ROWS_BEGIN
#pragma unroll
                for (int e = 0; e < 4; ++e) { const float a = fmaxf(v0[e], 0.f), b = fmaxf(v1[e], 0.f); v0[e] = a * a; v1[e] = b * b; }
                *(u32x4*)(U + (size_t)row * DFF + c) = pk8(v0, v1);
            EPI_ROWS_END
        }
    }
};

struct Chunk { u32x4 a, b; };
template <bool F32> DI void ld_chunk(Chunk& c, const void* base, size_t eoff, bool valid) {
    c.a = (u32x4){0u, 0u, 0u, 0u}; c.b = (u32x4){0u, 0u, 0u, 0u};
    if (valid) {
        if (F32) { const float* p = (const float*)base + eoff; c.a = *(const u32x4*)p; c.b = *(const u32x4*)(p + 4); }
        else { c.a = *(const u32x4*)((const bf16*)base + eoff); }
    }
}
template <bool F32> DI u32x4 cvt_chunk(const Chunk& c) {
    if (!F32) return c.a;
    u32x4 w;
    w.x = pk2(__uint_as_float(c.a.x), __uint_as_float(c.a.y)); w.y = pk2(__uint_as_float(c.a.z), __uint_as_float(c.a.w));
    w.z = pk2(__uint_as_float(c.b.x), __uint_as_float(c.b.y)); w.w = pk2(__uint_as_float(c.b.z), __uint_as_float(c.b.w));
    return w;
}
typedef short v4i16_t __attribute__((ext_vector_type(4)));
DI s16x4 vtr(const LAS unsigned char* p) { return __builtin_bit_cast(s16x4, __builtin_amdgcn_ds_read_tr16_b64_v4i16((LAS v4i16_t*)p)); }
DI bf16x8 pack8(const f32x16& s, int b) {
    u32x4 w; w.x = pk2(s[b], s[b + 1]); w.y = pk2(s[b + 2], s[b + 3]); w.z = pk2(s[b + 4], s[b + 5]); w.w = pk2(s[b + 6], s[b + 7]);
    return __builtin_bit_cast(bf16x8, w);
}

struct AU {
    const bf16* Q; int ldq; int qrow0; int nq;
    const void* Ka; const void* Kb; int ldk; int nsplit;
    const bf16* Kr; int ldkr;
    const void* Va; const void* Vb; int ldv;
    int nkeys; int limbase;
    bf16* O; int ldo;
    float lam; const float* subg;
};

template <int MODE, bool F32>
DI void attn_unit(LAS unsigned char* lds, const AU& a, const int tid_in) {
    int tid = tid_in; asm volatile("" : "+v"(tid));
    constexpr int NS = (MODE == 1) ? 2 : 1;
    constexpr int DQK = (MODE == 0) ? 96 : (MODE == 1 ? 64 : 128);
    constexpr int DV = (MODE == 2) ? 128 : 64;
    constexpr int NKS = DQK / 16, NDB = DV / 32;
    constexpr int KSTR = DQK * 2 + 16, VSTR = DV * 2 + 16, KBY = 64 * KSTR, VBY = 64 * VSTR, BUFB = KBY + VBY;
    constexpr int KC = (MODE == 0) ? 64 : DQK, KCH = KC / 8, NKJ = KC / 64, VCH = DV / 8, NVJ = DV / 64;
    const int lane = tid & 63, wave = __builtin_amdgcn_readfirstlane(tid >> 6), r = lane & 31, h = lane >> 5;
    const int NT = (a.nkeys + 63) >> 6;
    int lim = a.limbase + (wave >> 1); if (lim > NT - 1) lim = NT - 1;
    const bool active = wave * 32 < a.nq;
    bf16x8 qf[NKS];
#pragma unroll
    for (int s = 0; s < NKS; ++s) {
        qf[s] = (bf16x8){0, 0, 0, 0, 0, 0, 0, 0};
        if (active) qf[s] = *(const bf16x8*)(a.Q + (size_t)(a.qrow0 + wave * 32 + r) * a.ldq + 16 * s + 8 * h);
    }
    float mrun[NS], lrun[NS]; f32x16 o[NS][NDB];
#pragma unroll
    for (int c = 0; c < NS; ++c) { mrun[c] = -1e30f; lrun[c] = 0.f;
#pragma unroll
        for (int d = 0; d < NDB; ++d)
#pragma unroll
            for (int i = 0; i < 16; ++i) o[c][d][i] = 0.f; }
    Chunk ck[NKJ], cr, cv[NVJ];
    cr.a = (u32x4){0u, 0u, 0u, 0u}; cr.b = cr.a;
#define AT_LOAD(t) do { const int kv0_ = (t) * 64; \
        _Pragma("unroll") for (int j = 0; j < NKJ; ++j) { const int q_ = tid + 512 * j, rw_ = q_ / KCH, ch_ = q_ % KCH, kv_ = kv0_ + rw_; \
            const bool fs_ = kv_ < a.nsplit; ld_chunk<F32>(ck[j], fs_ ? a.Ka : a.Kb, (size_t)(fs_ ? kv_ : kv_ - a.nsplit) * a.ldk + ch_ * 8, kv_ < a.nkeys); } \
        if (MODE == 0) { if (tid < 256) { const int rw_ = tid >> 2, ch_ = tid & 3, kv_ = kv0_ + rw_; ld_chunk<false>(cr, a.Kr, (size_t)kv_ * a.ldkr + ch_ * 8, kv_ < a.nkeys); } } \
        _Pragma("unroll") for (int j = 0; j < NVJ; ++j) { const int q_ = tid + 512 * j, rw_ = q_ / VCH, ch_ = q_ % VCH, kv_ = kv0_ + rw_; \
            const bool fs_ = kv_ < a.nsplit; ld_chunk<F32>(cv[j], fs_ ? a.Va : a.Vb, (size_t)(fs_ ? kv_ : kv_ - a.nsplit) * a.ldv + ch_ * 8, kv_ < a.nkeys); } } while (0)
#define AT_COMMIT(buf) do { LAS unsigned char* kb_ = lds + (buf) * BUFB; \
        _Pragma("unroll") for (int j = 0; j < NKJ; ++j) { const int q_ = tid + 512 * j, rw_ = q_ / KCH, ch_ = q_ % KCH; *(LAS u32x4*)(kb_ + rw_ * KSTR + ch_ * 16) = cvt_chunk<F32>(ck[j]); } \
        if (MODE == 0) { if (tid < 256) { const int rw_ = tid >> 2, ch_ = tid & 3; *(LAS u32x4*)(kb_ + rw_ * KSTR + 128 + ch_ * 16) = cr.a; } } \
        _Pragma("unroll") for (int j = 0; j < NVJ; ++j) { const int q_ = tid + 512 * j, rw_ = q_ / VCH, ch_ = q_ % VCH; *(LAS u32x4*)(kb_ + KBY + rw_ * VSTR + ch_ * 16) = cvt_chunk<F32>(cv[j]); } } while (0)
    AT_LOAD(0); AT_COMMIT(0);
    __syncthreads();
    const int qq = (lane & 15) >> 2, pp = lane & 3, blk = (lane >> 4) & 1;
    for (int t = 0; t < NT; ++t) {
        const int buf = t & 1;
        if (MODE != 2 && t + 1 < NT) AT_LOAD(t + 1);
        if (active && t <= lim) {
            const LAS unsigned char* Kt = lds + buf * BUFB; const LAS unsigned char* Vt = Kt + KBY;
            const bool halft = (a.nkeys - t * 64) <= 32;
            bf16x8 pf[NS][2][2];
#pragma unroll
            for (int c = 0; c < NS; ++c) {
                f32x16 s0, s1;
#pragma unroll
                for (int i = 0; i < 16; ++i) { s0[i] = 0.f; s1[i] = 0.f; }
                constexpr int KSN = (MODE == 1) ? 2 : NKS;
#pragma unroll
                for (int ks = 0; ks < KSN; ++ks) {
                    const int kk = (MODE == 1) ? 2 * c + ks : ks;
                    const bf16x8 k0 = *(const LAS bf16x8*)(Kt + r * KSTR + kk * 32 + h * 16);
                    const bf16x8 k1 = *(const LAS bf16x8*)(Kt + (32 + r) * KSTR + kk * 32 + h * 16);
                    s0 = __builtin_amdgcn_mfma_f32_32x32x16_bf16(k0, qf[kk], s0, 0, 0, 0);
                    s1 = __builtin_amdgcn_mfma_f32_32x32x16_bf16(k1, qf[kk], s1, 0, 0, 0);
                }
                if (halft) {
#pragma unroll
                    for (int i = 0; i < 16; ++i) s1[i] = -1e30f;
                }
                float mx = s0[0];
#pragma unroll
                for (int i = 0; i < 16; ++i) { mx = fmaxf(mx, s0[i]); mx = fmaxf(mx, s1[i]); }
                mx = fmaxf(mx, __shfl_xor(mx, 32));
                const float mn = fmaxf(mrun[c], mx); const float al = __builtin_amdgcn_exp2f(mrun[c] - mn); mrun[c] = mn;
                float ps = 0.f;
#pragma unroll
                for (int i = 0; i < 16; ++i) { s0[i] = __builtin_amdgcn_exp2f(s0[i] - mn); s1[i] = __builtin_amdgcn_exp2f(s1[i] - mn); ps += s0[i] + s1[i]; }
                lrun[c] = lrun[c] * al + ps;
#pragma unroll
                for (int d = 0; d < NDB; ++d)
#pragma unroll
                    for (int i = 0; i < 16; ++i) o[c][d][i] *= al;
                pf[c][0][0] = pack8(s0, 0); pf[c][0][1] = pack8(s0, 8); pf[c][1][0] = pack8(s1, 0); pf[c][1][1] = pack8(s1, 8);
            }
#pragma unroll
            for (int d = 0; d < NDB; ++d)
#pragma unroll
                for (int kb = 0; kb < 2; ++kb)
#pragma unroll
                    for (int sp = 0; sp < 2; ++sp) {
                        const LAS unsigned char* vp = Vt + (kb * 32 + sp * 16 + 4 * h + qq) * VSTR + (d * 32 + 16 * blk + 4 * pp) * 2;
                        const s16x4 lo = vtr(vp), hi = vtr(vp + 8 * VSTR);
                        const bf16x8 vf = (bf16x8){lo[0], lo[1], lo[2], lo[3], hi[0], hi[1], hi[2], hi[3]};
#pragma unroll
                        for (int c = 0; c < NS; ++c) o[c][d] = __builtin_amdgcn_mfma_f32_32x32x16_bf16(vf, pf[c][kb][sp], o[c][d], 0, 0, 0);
                    }
        }
        if (t + 1 < NT) { if (MODE == 2) AT_LOAD(t + 1); AT_COMMIT(buf ^ 1); }
        __syncthreads();
    }
#undef AT_LOAD
#undef AT_COMMIT
    if (active) {
        const int qi = wave * 32 + r;
        float inv[NS];
#pragma unroll
        for (int c = 0; c < NS; ++c) { const float lt = lrun[c] + __shfl_xor(lrun[c], 32); inv[c] = 1.f / lt; }
        float rs = 1.f;
        if (MODE == 1) {
            float ss = 0.f;
#pragma unroll
            for (int d = 0; d < NDB; ++d)
#pragma unroll
                for (int i = 0; i < 16; ++i) { const float v = o[0][d][i] * inv[0] - a.lam * (o[NS - 1][d][i] * inv[NS - 1]); o[0][d][i] = v; ss += v * v; }
            ss += __shfl_xor(ss, 32);
            rs = rsqrtf(ss * (1.f / 64.f) + EPSN) * (1.f - LAM_INIT);
        } else rs = inv[0];
        bf16* op = a.O + (size_t)(a.qrow0 + qi) * a.ldo;
#pragma unroll
        for (int d = 0; d < NDB; ++d)
#pragma unroll
            for (int g4 = 0; g4 < 4; ++g4) {
                const int dc = d * 32 + 8 * g4 + 4 * h;
                float w0 = o[0][d][4 * g4] * rs, w1 = o[0][d][4 * g4 + 1] * rs, w2 = o[0][d][4 * g4 + 2] * rs, w3 = o[0][d][4 * g4 + 3] * rs;
                if (MODE == 1) { const f32x4 gg = *(const f32x4*)(a.subg + dc); w0 *= gg[0]; w1 *= gg[1]; w2 *= gg[2]; w3 *= gg[3]; }
                u32x2 w; w.x = pk2(w0, w1); w.y = pk2(w2, w3);
                if (qi < a.nq) *(u32x2*)(op + dc) = w;
            }
    }
}

DI void p0_transpose_item(const float* W, int K, int N, bf16* WT, int row_off, LAS float* scr, int item, int lane) {
    const int nblk = N / 32, kb = item / nblk, nb = item % nblk, k0 = 64 * kb, n0 = 32 * nb;
#pragma unroll 8
    for (int i = 0; i < 32; ++i) { const int kk = 2 * i + (lane >> 5); scr[kk * 33 + (lane & 31)] = W[(size_t)(k0 + kk) * N + n0 + (lane & 31)]; }
    asm volatile("s_waitcnt lgkmcnt(0)" ::: "memory");
    const int c = lane & 7;
#pragma unroll
    for (int j = 0; j < 4; ++j) { const int n = (lane >> 3) + 8 * j; const LAS float* s = scr + (8 * c) * 33 + n;
        u32x4 o; o.x = pk2(s[0 * 33], s[1 * 33]); o.y = pk2(s[2 * 33], s[3 * 33]); o.z = pk2(s[4 * 33], s[5 * 33]); o.w = pk2(s[6 * 33], s[7 * 33]);
        *(u32x4*)(WT + (size_t)(row_off + n0 + n) * K + k0 + 8 * c) = o; }
    asm volatile("s_waitcnt lgkmcnt(0)" ::: "memory");
}
DI void rms_row_1024(const float* xrow, const float* g, bf16* orow, int lane) {
    const f32x4* xr = (const f32x4*)xrow + lane; const f32x4* gr = (const f32x4*)g + lane;
    f32x4 v[4]; float s = 0.f;
#pragma unroll
    for (int j = 0; j < 4; ++j) { v[j] = xr[64 * j]; s += (v[j].x * v[j].x + v[j].y * v[j].y) + (v[j].z * v[j].z + v[j].w * v[j].w); }
    const float rstd = rsqrtf(wave_sum(s) * (1.f / 1024.f) + EPSN);
    u32x2* o8 = (u32x2*)orow + lane;
#pragma unroll
    for (int j = 0; j < 4; ++j) { const f32x4 gg = gr[64 * j]; u32x2 w; w.x = pk2(v[j].x * rstd * gg.x, v[j].y * rstd * gg.y); w.y = pk2(v[j].z * rstd * gg.z, v[j].w * rstd * gg.w); o8[64 * j] = w; }
}


template <int K> DI const float* inp_ld() {
    auto kp = __builtin_amdgcn_kernarg_segment_ptr();
    unsigned long long v;
    asm volatile("s_load_dwordx2 %0, %1, %2\n\ts_waitcnt lgkmcnt(0)" : "=s"(v) : "s"(kp), "n"(K * 8));
    return (const float*)v;
}
#define INP(k) inp_ld<k>()

struct Args { const float* in[35]; float* out; unsigned char* ws; int ph_lo, ph_hi; };

constexpr int NPHASE = 11;
constexpr int LDS_BYTES = 147456;

__global__ void __launch_bounds__(512, 2) fwd_kernel(Args args) {
    extern __shared__ __attribute__((aligned(16))) unsigned char lds_raw[];
    LAS unsigned char* lds = (LAS unsigned char*)lds_raw;
    cg::grid_group grid = cg::this_grid();
    const int tid = threadIdx.x, lane = tid & 63, wave = __builtin_amdgcn_readfirstlane(tid >> 6);
    const int G = gridDim.x, bid = blockIdx.x;
    const int gw = bid * 8 + wave, NGW = G * 8;
    unsigned char* ws = args.ws; float* out = args.out;
    const int lo = args.ph_lo, hi = args.ph_hi;
#ifndef PHM
#define PHM 0x7ff
#endif
#define IN(k) (((PHM >> (k)) & 1) && lo <= (k) && (k) < hi)
#define SEAM(k) do { if (IN(k) && IN((k) + 1)) grid.sync(); } while (0)
#define XN ((bf16*)(ws + WS_XN))
#define GB ((bf16*)(ws + WS_G))
#define CQ ((bf16*)(ws + WS_CQ))
#define CQN ((bf16*)(ws + WS_CQN))
#define QM ((bf16*)(ws + WS_QM))
#define DQ ((bf16*)(ws + WS_DQ))
#define MQ ((bf16*)(ws + WS_MQ))
#define DKP ((bf16*)(ws + WS_DKP))
#define DVP ((bf16*)(ws + WS_DVP))
#define KR ((bf16*)(ws + WS_KR))
#define MKB ((bf16*)(ws + WS_MK))
#define MVB ((bf16*)(ws + WS_MV))
#define LAT ((bf16*)(ws + WS_LAT))
#define KN ((bf16*)(ws + WS_KN))
#define VM ((bf16*)(ws + WS_VM))
#define OA ((bf16*)(ws + WS_OA))
#define MRG ((float*)(ws + WS_MRG))
#define MRGB ((bf16*)(ws + WS_MRGB))
#define MIX ((float*)(ws + WS_MIX))
#define UB ((bf16*)(ws + WS_U))
#define TABM ((float*)(ws + WS_TABM))
#define TABD ((float*)(ws + WS_TABD))

    if (IN(0)) {
        LAS float* scr = (LAS float*)(lds + wave * 16384);
        {
            constexpr int I_IN = 16 * 85, I_G = 16 * 96, I_UQ = 6 * 24, I_UK = 4 * 16, I_MK = 16 * 16, I_O = 8 * 32, I_OUT = 16 * 32, I_UP = 16 * 128, I_DN = 64 * 32;
            constexpr int NITEMS = I_IN + I_G + I_UQ + 2 * I_UK + 2 * I_MK + 3 * I_O + I_OUT + I_UP + I_DN;
            for (int it = gw; it < NITEMS; it += NGW) {
                int r = it;
                if (r < I_IN) { p0_transpose_item(INP(10), 1024, 2720, (bf16*)(ws + W_ING), 0, scr, r, lane); continue; } r -= I_IN;
                if (r < I_G) { p0_transpose_item(INP(27), 1024, 3072, (bf16*)(ws + W_ING), INWP, scr, r, lane); continue; } r -= I_G;
                if (r < I_UQ) { p0_transpose_item(INP(12), 384, 768, (bf16*)(ws + W_UQ), 0, scr, r, lane); continue; } r -= I_UQ;
                if (r < I_UK) { p0_transpose_item(INP(14), 256, 512, (bf16*)(ws + W_UKV), 0, scr, r, lane); continue; } r -= I_UK;
                if (r < I_UK) { p0_transpose_item(INP(15), 256, 512, (bf16*)(ws + W_UKV), 512, scr, r, lane); continue; } r -= I_UK;
                if (r < I_MK) { p0_transpose_item(INP(22), 1024, 512, (bf16*)(ws + W_MEM), 0, scr, r, lane); continue; } r -= I_MK;
                if (r < I_MK) { p0_transpose_item(INP(23), 1024, 512, (bf16*)(ws + W_MEM), 512, scr, r, lane); continue; } r -= I_MK;
                if (r < I_O) { p0_transpose_item(INP(24), 512, 1024, (bf16*)(ws + W_OM), 0, scr, r, lane); continue; } r -= I_O;
                if (r < I_O) { p0_transpose_item(INP(25), 512, 1024, (bf16*)(ws + W_OM), 1024, scr, r, lane); continue; } r -= I_O;
                if (r < I_O) { p0_transpose_item(INP(26), 512, 1024, (bf16*)(ws + W_OM), 2048, scr, r, lane); continue; } r -= I_O;
                if (r < I_OUT) { p0_transpose_item(INP(29), 1024, 1024, (bf16*)(ws + W_OUT), 0, scr, r, lane); continue; } r -= I_OUT;
                if (r < I_UP) { p0_transpose_item(INP(32), 1024, 4096, (bf16*)(ws + W_UP), 0, scr, r, lane); continue; } r -= I_UP;
                p0_transpose_item(INP(33), 4096, 1024, (bf16*)(ws + W_DN), 0, scr, r, lane);
            }
        }
        for (int i = gw * 64 + lane; i < 96 * 1024 / 8; i += NGW * 64) *(u32x4*)((bf16*)(ws + W_ING) + (size_t)2720 * 1024 + (size_t)i * 8) = (u32x4){0u, 0u, 0u, 0u};
        for (int m = gw; m < MROWS + NMEM; m += NGW) {
            if (m < SEQ) rms_row_1024(INP(0) + (size_t)m * DM, INP(9), XN + (size_t)m * DM, lane);
            else if (m < MROWS) rms_row_1024(INP(1) + (size_t)(m - SEQ) * DM, INP(9), XN + (size_t)m * DM, lane);
            else rms_row_1024(INP(8) + (size_t)(m - MROWS) * DM, INP(21), MRGB + (size_t)(m - MROWS) * DM, lane);
        }
        for (int i = gw; i < NSB * PAST; i += NGW) {
            const int b = i >> 12, s = i & 4095;
            const f32x4 v = *((const f32x4*)(INP(2) + (size_t)i * 256) + lane);
            u32x2 w; w.x = pk2(v.x, v.y); w.y = pk2(v.z, v.w);
            *((u32x2*)(LAT + (size_t)(SEQ + b * SKEYS + s) * 256) + lane) = w;
        }
        for (int i = gw; i < NSB * PAST / 8; i += NGW) {
            const int rowi = i * 8 + (lane >> 3); const int b = rowi >> 12, s = rowi & 4095;
            const f32x4 v = *((const f32x4*)(INP(3) + (size_t)rowi * 32) + (lane & 7));
            u32x2 w; w.x = pk2(v.x, v.y); w.y = pk2(v.z, v.w);
            *((u32x2*)(KR + (size_t)(SEQ + b * SKEYS + s) * 32) + (lane & 7)) = w;
        }
        for (int i = gw * 64 + lane; i < NSB * NMEM * 512 / 4; i += NGW * 64) {
            const f32x4 a = *((const f32x4*)INP(6) + i), b = *((const f32x4*)INP(7) + i);
            u32x2 w; w.x = pk2(a.x, a.y); w.y = pk2(a.z, a.w); *((u32x2*)(MKB + (size_t)NMEM * 512) + i) = w;
            w.x = pk2(b.x, b.y); w.y = pk2(b.z, b.w); *((u32x2*)(MVB + (size_t)NMEM * 512) + i) = w;
        }
        for (int i = gw * 64 + lane; i < SEQ * 16; i += NGW * 64) {
            const int pos = i >> 4, f = i & 15;
            const float inv = powf(10000.0f, -(float)f * (2.0f / 32.0f)); const float ang = (float)pos * inv;
            TABM[(size_t)pos * 32 + f] = cosf(ang); TABM[(size_t)pos * 32 + 16 + f] = sinf(ang);
        }
        for (int i = gw * 64 + lane; i < SEQ * 4; i += NGW * 64) {
            const int pos = i >> 2, f = i & 3;
            const float inv = powf(500000.0f, -(float)f * (2.0f / 8.0f)); const float ang = (float)pos * inv;
            TABD[(size_t)pos * 8 + f] = cosf(ang); TABD[(size_t)pos * 8 + 4 + f] = sinf(ang);
        }
        asm volatile("s_waitcnt vmcnt(0) lgkmcnt(0)" ::: "memory");
        __syncthreads();
    }
    SEAM(0);

    if (IN(1)) {
        {
            pg8::Gemm g{MRGB, (const bf16*)(ws + W_MEM), NMEM, 1024, 1024}; pg8::StaticOrder S; S.init(NMEM, 1024, G, (bid + 4) % G);
            EpiMemKV E{out, MKB, MVB};
            pg8::gemm_phase<EpiMemKV, pg8::StaticOrder, true, true>(lds, g, S, E);
        }
        {
            pg8::Gemm g{XN, (const bf16*)(ws + W_ING), MROWS, NING, 1024}; pg8::StaticOrder S; S.init(MROWS, NING, G, bid);
            EpiP1 E{CQ, KR, DQ, DKP, DVP, MQ, GB, out, INP(28), TABM, TABD};
            pg8::gemm_phase<EpiP1, pg8::StaticOrder, true, true>(lds, g, S, E);
        }
    }
    SEAM(1);

    if (IN(2)) {
        for (int row = gw; row < MROWS; row += NGW) {
            {
                u32x4 raw = (u32x4){0u, 0u, 0u, 0u};
                if (lane < 48) raw = *((const u32x4*)(CQ + (size_t)row * 384) + lane);
                float v[8] = {bf_lo(raw.x), bf_hi(raw.x), bf_lo(raw.y), bf_hi(raw.y), bf_lo(raw.z), bf_hi(raw.z), bf_lo(raw.w), bf_hi(raw.w)};
                float s = 0.f;
#pragma unroll
                for (int e = 0; e < 8; ++e) s += v[e] * v[e];
                const float rstd = rsqrtf(wave_sum(s) * (1.f / 384.f) + EPSN);
                if (lane < 48) {
                    const f32x4 g0 = *((const f32x4*)INP(11) + 2 * lane), g1 = *((const f32x4*)INP(11) + 2 * lane + 1);
                    u32x4 w; w.x = pk2(v[0] * rstd * g0.x, v[1] * rstd * g0.y); w.y = pk2(v[2] * rstd * g0.z, v[3] * rstd * g0.w);
                    w.z = pk2(v[4] * rstd * g1.x, v[5] * rstd * g1.y); w.w = pk2(v[6] * rstd * g1.z, v[7] * rstd * g1.w);
                    *((u32x4*)(CQN + (size_t)row * 384) + lane) = w;
                }
            }
            {
                float* p = out_row(out, row, O_PCKV, O_SCKV, 256);
                f32x4 v = *((const f32x4*)p + lane);
                const float s = (v.x * v.x + v.y * v.y) + (v.z * v.z + v.w * v.w);
                const float rstd = rsqrtf(wave_sum(s) * (1.f / 256.f) + EPSN);
                const f32x4 gg = *((const f32x4*)INP(13) + lane);
                v.x *= rstd * gg.x; v.y *= rstd * gg.y; v.z *= rstd * gg.z; v.w *= rstd * gg.w;
                *((f32x4*)p + lane) = v;
                u32x2 w; w.x = pk2(v.x, v.y); w.y = pk2(v.z, v.w);
                *((u32x2*)(LAT + (size_t)row_krow(row) * 256) + lane) = w;
            }
        }
    }
    SEAM(2);

    if (IN(3)) {
#ifndef NO_P3A
        {
            pg8::Gemm g{CQN, (const bf16*)(ws + W_UQ), MROWS, 768, 384}; pg8::StaticOrder S; S.init(MROWS, 768, G, bid);
            EpiUQ E{QM, TABM};
            pg8::gemm_phase<EpiUQ, pg8::StaticOrder, true, true>(lds, g, S, E);
        }
#endif
#ifndef NO_P3B
        {
            pg8::Gemm g{LAT, (const bf16*)(ws + W_UKV), MKROWS, 1024, 256}; pg8::StaticOrder S; S.init(MKROWS, 1024, G, bid);
            EpiBf16Split E{KN, VM};
            pg8::gemm_phase<EpiBf16Split, pg8::StaticOrder, true, true>(lds, g, S, E);
        }
#endif
    }
    SEAM(3);

    if (IN(4)) {
        float lam;
        {
            float sa = 0.f, sb = 0.f;
            if (lane < 32) { sa = INP(16)[lane] * INP(17)[lane]; sb = INP(18)[lane] * INP(19)[lane]; }
            sa = wave_sum(sa); sb = wave_sum(sb);
            lam = expf(sa) - expf(sb) + LAM_INIT;
        }
        constexpr int BIG = 1 << 30;
#define O_MLA OA
#define O_DIFF (OA + (size_t)MROWS * 512)
#define O_MEM (OA + (size_t)2 * MROWS * 512)
        constexpr int N_IT = 256 + 256 + 256 + 256 + 64;
        for (int it = bid; it < N_IT; it += G) {
            const int ne = it < 512 ? 2 : 1;
#pragma unroll 1
            for (int e = 0; e < ne; ++e) {
                AU a; int kind;
                a.lam = lam; a.subg = INP(20); a.ldo = 512; a.Kb = nullptr; a.Vb = nullptr; a.Kr = KR; a.ldkr = 32; a.nsplit = BIG; a.ldk = 512; a.ldv = 512; a.limbase = BIG / 2;
                if (it < 512) {
                    const bool isd = it >= 256; const int j = it & 255, head = j & 7, pair = j >> 3;
                    const int qb = e == 0 ? 63 - pair : pair;
                    a.qrow0 = qb * 256; a.nq = 256; a.nkeys = (qb + 1) * 256; a.limbase = 4 * qb;
                    if (!isd) { kind = 0; a.Q = QM + head * 96; a.ldq = 768; a.Ka = KN + head * 64; a.Va = VM + head * 64; a.O = O_MLA + head * 64; }
                    else { kind = 1; a.Q = DQ + head * 64; a.ldq = 512; a.Ka = DKP + head * 64; a.Va = DVP + head * 64; a.O = O_DIFF + head * 64; }
                } else if (it < 768) {
                    const int j = it - 512; const bool isd = j >= 128; const int jj = j & 127, b = jj >> 3, head = jj & 7;
                    a.qrow0 = SEQ + b * 32; a.nq = 32; a.nkeys = SKEYS;
                    if (!isd) {
                        kind = 0; const size_t k0 = (size_t)SEQ + (size_t)b * SKEYS;
                        a.Q = QM + head * 96; a.ldq = 768; a.Ka = KN + k0 * 512 + head * 64; a.Kr = KR + k0 * 32; a.Va = VM + k0 * 512 + head * 64; a.O = O_MLA + head * 64;
                    } else {
                        kind = 2; a.Q = DQ + head * 64; a.ldq = 512; a.nsplit = PAST;
                        a.Ka = INP(4) + (size_t)b * PAST * 512 + head * 64; a.Kb = out + O_SDK + (size_t)b * 32 * 512 + head * 64;
                        a.Va = INP(5) + (size_t)b * PAST * 512 + head * 64; a.Vb = out + O_SDV + (size_t)b * 32 * 512 + head * 64;
                        a.O = O_DIFF + head * 64;
                    }
                } else {
                    const int j = it - 768; kind = 3; a.nkeys = NMEM; a.ldq = 512;
                    if (j < 256) { const int qb = j >> 2, hm = j & 3; a.qrow0 = qb * 256; a.nq = 256; a.Q = MQ + hm * 128; a.Ka = MKB + hm * 128; a.Va = MVB + hm * 128; a.O = O_MEM + hm * 128; }
                    else { const int jj = j - 256, b = jj >> 2, hm = jj & 3; a.qrow0 = SEQ + b * 32; a.nq = 32; a.Q = MQ + hm * 128;
                        a.Ka = MKB + (size_t)(1 + b) * NMEM * 512 + hm * 128; a.Va = MVB + (size_t)(1 + b) * NMEM * 512 + hm * 128; a.O = O_MEM + hm * 128; }
                }
#ifndef KMASK
#define KMASK 15
#endif
                if (kind == 0) { if (KMASK & 1) attn_unit<0, false>(lds, a, tid); }
                else if (kind == 1) { if (KMASK & 2) attn_unit<1, false>(lds, a, tid); }
                else if (kind == 2) { if (KMASK & 4) attn_unit<1, true>(lds, a, tid); }
                else { if (KMASK & 8) attn_unit<2, false>(lds, a, tid); }
            }
        }
    }
    SEAM(4);

    if (IN(5)) {
        const bf16* WOM = (const bf16*)(ws + W_OM);
        { pg8::Gemm g{OA, WOM, MROWS, 1024, 512}; pg8::StaticOrder S; S.init(MROWS, 1024, G, bid); EpiMerge<0> E{GB, MRG, MRGB};
          pg8::gemm_phase<EpiMerge<0>, pg8::StaticOrder, true, true>(lds, g, S, E); }
        { pg8::Gemm g{OA + (size_t)MROWS * 512, WOM + (size_t)1024 * 512, MROWS, 1024, 512}; pg8::StaticOrder S; S.init(MROWS, 1024, G, bid); EpiMerge<1> E{GB, MRG, MRGB};
          pg8::gemm_phase<EpiMerge<1>, pg8::StaticOrder, true, true>(lds, g, S, E); }
        { pg8::Gemm g{OA + (size_t)2 * MROWS * 512, WOM + (size_t)2048 * 512, MROWS, 1024, 512}; pg8::StaticOrder S; S.init(MROWS, 1024, G, bid); EpiMerge<2> E{GB, MRG, MRGB};
          pg8::gemm_phase<EpiMerge<2>, pg8::StaticOrder, true, true>(lds, g, S, E); }
    }
    SEAM(5);

    if (IN(6)) {
        pg8::Gemm g{MRGB, (const bf16*)(ws + W_OUT), MROWS, 1024, 1024}; pg8::StaticOrder S; S.init(MROWS, 1024, G, bid); EpiF32 E{MIX, 1024};
        pg8::gemm_phase<EpiF32, pg8::StaticOrder, true, true>(lds, g, S, E);
    }
    SEAM(6);

    if (IN(7)) {
        for (int row = gw; row < MROWS; row += NGW) {
            const float* xr = row < SEQ ? INP(0) + (size_t)row * DM : INP(1) + (size_t)(row - SEQ) * DM;
            const f32x4* mr = (const f32x4*)(MIX + (size_t)row * DM) + lane;
            f32x4 v[4]; float s = 0.f;
#pragma unroll
            for (int j = 0; j < 4; ++j) { v[j] = mr[64 * j]; s += (v[j].x * v[j].x + v[j].y * v[j].y) + (v[j].z * v[j].z + v[j].w * v[j].w); }
            const float rstd = rsqrtf(wave_sum(s) * (1.f / 1024.f) + EPSN);
            float s2 = 0.f;
#pragma unroll
            for (int j = 0; j < 4; ++j) { const f32x4 gg = *((const f32x4*)INP(30) + lane + 64 * j); const f32x4 xx = *((const f32x4*)xr + lane + 64 * j);
                v[j].x = xx.x + v[j].x * rstd * gg.x; v[j].y = xx.y + v[j].y * rstd * gg.y; v[j].z = xx.z + v[j].z * rstd * gg.z; v[j].w = xx.w + v[j].w * rstd * gg.w;
                s2 += (v[j].x * v[j].x + v[j].y * v[j].y) + (v[j].z * v[j].z + v[j].w * v[j].w);
                *((f32x4*)(out + O_Y + (size_t)row * DM) + lane + 64 * j) = v[j]; }
            const float rstd2 = rsqrtf(wave_sum(s2) * (1.f / 1024.f) + EPSN);
#pragma unroll
            for (int j = 0; j < 4; ++j) { const f32x4 gg = *((const f32x4*)INP(31) + lane + 64 * j);
                u32x2 w; w.x = pk2(v[j].x * rstd2 * gg.x, v[j].y * rstd2 * gg.y); w.y = pk2(v[j].z * rstd2 * gg.z, v[j].w * rstd2 * gg.w);
                *((u32x2*)(XN + (size_t)row * DM) + lane + 64 * j) = w; }
        }
    }
    SEAM(7);

    if (IN(8)) {
        pg8::Gemm g{XN, (const bf16*)(ws + W_UP), MROWS, DFF, 1024}; pg8::StaticOrder S; S.init(MROWS, DFF, G, bid); EpiUp E{UB};
        pg8::gemm_phase<EpiUp, pg8::StaticOrder, true, true>(lds, g, S, E);
    }
    SEAM(8);

    if (IN(9)) {
        pg8::Gemm g{UB, (const bf16*)(ws + W_DN), MROWS, 1024, DFF}; pg8::StaticOrder S; S.init(MROWS, 1024, G, bid); EpiF32 E{MIX, 1024};
        pg8::gemm_phase<EpiF32, pg8::StaticOrder, true, true>(lds, g, S, E);
    }
    SEAM(9);

    if (IN(10)) {
        for (int row = gw; row < MROWS; row += NGW) {
            const f32x4* fr_ = (const f32x4*)(MIX + (size_t)row * DM) + lane;
            f32x4 v[4]; float s = 0.f;
#pragma unroll
            for (int j = 0; j < 4; ++j) { v[j] = fr_[64 * j]; s += (v[j].x * v[j].x + v[j].y * v[j].y) + (v[j].z * v[j].z + v[j].w * v[j].w); }
            const float rstd = rsqrtf(wave_sum(s) * (1.f / 1024.f) + EPSN);
#pragma unroll
            for (int j = 0; j < 4; ++j) { const f32x4 gg = *((const f32x4*)INP(34) + lane + 64 * j); f32x4* yp = (f32x4*)(out + O_Y + (size_t)row * DM) + lane + 64 * j; const f32x4 xx = *yp;
                f32x4 y; y.x = xx.x + v[j].x * rstd * gg.x; y.y = xx.y + v[j].y * rstd * gg.y; y.z = xx.z + v[j].z * rstd * gg.z; y.w = xx.w + v[j].w * rstd * gg.w; *yp = y; }
        }
    }
#undef IN
#undef SEAM
}

#ifndef MK_N_LAUNCHES
#define MK_N_LAUNCHES 1
#endif

extern "C" void kernel_launch(void* const* d_in, const int* in_sizes, int n_in, void* d_out, int out_size, void* d_ws, size_t ws_size, hipStream_t stream) {
    static int grid = 0;
    if (grid == 0) {
        if (n_in != 35 || out_size != (int)O_END || ws_size < WS_END) { fprintf(stderr, "kernel_launch: unexpected shapes: n_in %d out %d ws %zu\n", n_in, out_size, ws_size); grid = -1; return; }
        int dev = 0, cus = 0, per_cu = 0;
        hipGetDevice(&dev); hipDeviceGetAttribute(&cus, hipDeviceAttributeMultiprocessorCount, dev);
        if (hipFuncSetAttribute((const void*)fwd_kernel, hipFuncAttributeMaxDynamicSharedMemorySize, LDS_BYTES) != hipSuccess) { fprintf(stderr, "kernel_launch: hipFuncSetAttribute failed\n"); grid = -1; return; }
        hipOccupancyMaxActiveBlocksPerMultiprocessor(&per_cu, (const void*)fwd_kernel, 512, LDS_BYTES);
        (void)hipGetLastError();
        if (per_cu < 1) per_cu = 1;
        grid = cus;
    }
    if (grid < 0) return;
    Args a{};
    for (int i = 0; i < 35; ++i) a.in[i] = (const float*)d_in[i];
    a.out = (float*)d_out; a.ws = (unsigned char*)d_ws;
#if MK_N_LAUNCHES == 1
    a.ph_lo = 0; a.ph_hi = NPHASE;
    void* kargs[] = {&a};
    hipError_t e = hipLaunchCooperativeKernel((const void*)fwd_kernel, dim3(grid), dim3(512), kargs, LDS_BYTES, stream);
    if (e != hipSuccess) fprintf(stderr, "cooperative launch failed: %s (grid %d)\n", hipGetErrorString(e), grid);
#else
    for (int p = 0; p < NPHASE; ++p) { a.ph_lo = p; a.ph_hi = p + 1; hipLaunchKernelGGL(fwd_kernel, dim3(grid), dim3(512), LDS_BYTES, stream, a); }
#endif
}
```

```cpp
#include <hip/hip_runtime.h>
#include <hip/hip_cooperative_groups.h>
#include <cstdio>
#include <cstdint>
namespace cg = cooperative_groups;
namespace pg8 {
#define PG8_LAS __attribute__((address_space(3)))
typedef unsigned short bf16_t;
typedef short bf16x8 __attribute__((ext_vector_type(8)));
typedef float f32x4 __attribute__((ext_vector_type(4)));
typedef unsigned u32x4 __attribute__((ext_vector_type(4)));
constexpr int BM = 256, BK = 64, HALF = 128, HTB = HALF * BK * 2  , STAGE_BYTES = 8 * HTB, NXCD = 8, WGM = 8;

__host__ __device__ __forceinline__ int lds_byte(int r, int c) { const int st = (r >> 4) * 2 + (c >> 5), rr = r & 15, cc = c & 31, ob = rr * 64 + cc * 2; return st * 1024 + (ob ^ (((ob >> 9) & 1) << 5)); }
__host__ __device__ __forceinline__ void stage_rc(int b, int& R, int& C) { const int st = b / 1024, sb = b % 1024, swz = sb ^ (((sb >> 9) & 1) << 5); R = (st >> 1) * 16 + swz / 64; C = (st & 1) * 32 + (swz % 64) / 2; }
__host__ __device__ __forceinline__ int perm32(int rho) { const int n = rho >> 4, i = rho & 15; return 8 * (i >> 2) + 4 * n + (i & 3); }

struct Unit { int pm, pn; };
struct Gemm { const bf16_t* A; const bf16_t* Bt; int M, N, K; };

struct StaticOrder {
    int nM, nN, nwg, G, c;
    __host__ __device__ void init(int M, int N, int G_, int c_) { nM = M / BM; nN = N / BM; nwg = nM * nN; G = G_; c = c_; }
    __host__ __device__ bool next(int i, Unit& u) const {
        const long L = (long)i * G + c; if (L >= nwg) return false;
        int wgid = (int)L; { const int q = nwg / NXCD, r = nwg % NXCD, xcd = wgid % NXCD, off = wgid / NXCD; wgid = (xcd < r ? xcd * (q + 1) : r * (q + 1) + (xcd - r) * q) + off; }
        const int nig = WGM * nN, gid = wgid / nig, fm = gid * WGM, gsz = (nM - fm) < WGM ? (nM - fm) : WGM;
        u.pm = fm + ((wgid % nig) % gsz); u.pn = (wgid % nig) / gsz; return true;
    }
    __device__ __forceinline__ void a_ready(const Unit&) const {}
    __device__ __forceinline__ void done(const Unit&) const {}
};

__device__ __forceinline__ unsigned cvt_pk_bf16(float lo, float hi) { unsigned r; asm volatile("v_cvt_pk_bf16_f32 %0, %1, %2" : "=v"(r) : "v"(lo), "v"(hi)); return r; }
template <class Epi, class Sched, bool ALIGN_EPI = false, bool SP2 = false>
__device__ __forceinline__ void gemm_phase(PG8_LAS unsigned char* lds, const Gemm g, const Sched& S, const Epi& E) {
    int tid_l = threadIdx.x; asm volatile("" : "+v"(tid_l));
    const int tid = tid_l, wid = __builtin_amdgcn_readfirstlane(tid >> 6), lane = tid & 63, wr = wid >> 2, wc = wid & 3, fr = lane & 15, fq = lane >> 4;
    const int K = g.K, nt = K / BK;
    unsigned voffA[2], voffB[2];
#pragma unroll
    for (int i = 0; i < 2; ++i) { int R, C; stage_rc(tid * 16 + i * 8192, R, C); const int Rb = Epi::PERM ? ((R & ~31) + perm32(R & 31)) : R;
        voffA[i] = (unsigned)(R * K + C) * 2u; voffB[i] = (unsigned)(Rb * K + C) * 2u; }
    const size_t kstep = (size_t)(BK * 2);
    const size_t hstep = (size_t)HALF * K * 2;
    const size_t tstep = 2 * hstep;
    const unsigned ldsw = (unsigned)wid * 1024u;
    const int aoff = lds_byte(wr * 64 + fr, fq * 8), boff = lds_byte(wc * 32 + fr, fq * 8);
#define PG8_SA(b, h) (((b) * 2 + (h)) * HTB)
#define PG8_SB(b, h) ((4 + (b) * 2 + (h)) * HTB)
#define PG8_STAGE(bufoff, gbase, voff) do { _Pragma("unroll") for (int _i = 0; _i < 2; ++_i) \
        __builtin_amdgcn_global_load_lds((const unsigned*)((const char*)(gbase) + (voff)[_i]), (PG8_LAS unsigned*)(lds + (bufoff) + ldsw + _i * 8192), 16, 0, 0); } while (0)
#define PG8_LDA(dst, b, h) do { _Pragma("unroll") for (int m = 0; m < 4; ++m) _Pragma("unroll") for (int k = 0; k < 2; ++k) dst[m][k] = *(const PG8_LAS bf16x8*)(lds + PG8_SA(b, h) + aoff + m * 2048 + k * 1024); } while (0)
#define PG8_LDB(dst, b, h) do { _Pragma("unroll") for (int n = 0; n < 2; ++n) _Pragma("unroll") for (int k = 0; k < 2; ++k) dst[n][k] = *(const PG8_LAS bf16x8*)(lds + PG8_SB(b, h) + boff + n * 2048 + k * 1024); } while (0)
#define PG8_MMA(ai, bj, At, Bt) do { __builtin_amdgcn_s_setprio(1); _Pragma("unroll") for (int m = 0; m < 4; ++m) _Pragma("unroll") for (int n = 0; n < 2; ++n) _Pragma("unroll") for (int k = 0; k < 2; ++k) \
        acc[ai][bj][m][n] = __builtin_amdgcn_mfma_f32_16x16x32_bf16(Bt[n][k], At[m][k], acc[ai][bj][m][n], 0, 0, 0); __builtin_amdgcn_s_setprio(0); } while (0)
#define PG8_WAIT_V(n) asm volatile("s_waitcnt vmcnt(" #n ")" ::: "memory")
#define PG8_WAIT_L(n) asm volatile("s_waitcnt lgkmcnt(" #n ")" ::: "memory")
#define PG8_BAR __builtin_amdgcn_s_barrier()
#define PG8_SCHED __builtin_amdgcn_sched_barrier(0)
    Unit cur, nxt; int ui = 0;
    if (!S.next(0, cur)) return;
    f32x4 acc[2][2][4][2];
#pragma unroll
    for (int a = 0; a < 2; ++a)
#pragma unroll
        for (int b = 0; b < 2; ++b)
#pragma unroll
            for (int m = 0; m < 4; ++m)
#pragma unroll
                for (int n = 0; n < 2; ++n) acc[a][b][m][n] = (f32x4){0.f, 0.f, 0.f, 0.f};
    bf16x8 At[4][2], B0[2][2], B1[2][2];
    const char* cA = (const char*)g.A + (size_t)cur.pm * tstep; const char* cB = (const char*)g.Bt + (size_t)cur.pn * tstep;
    S.a_ready(cur);
    if constexpr (SP2) {
        PG8_STAGE(PG8_SB(0, 0), cB, voffB); PG8_STAGE(PG8_SB(0, 1), cB + hstep, voffB); PG8_STAGE(PG8_SA(0, 0), cA, voffA); PG8_STAGE(PG8_SA(0, 1), cA + hstep, voffA);
        if (wr == 1) PG8_BAR;
        PG8_WAIT_V(2); PG8_BAR;
        PG8_STAGE(PG8_SB(1, 0), cB + kstep, voffB); PG8_STAGE(PG8_SA(1, 0), cA + kstep, voffA); PG8_STAGE(PG8_SB(1, 1), cB + hstep + kstep, voffB);
        PG8_WAIT_V(6); PG8_BAR;
    } else {
        PG8_STAGE(PG8_SB(0, 0), cB, voffB); PG8_STAGE(PG8_SA(0, 0), cA, voffA); PG8_STAGE(PG8_SB(0, 1), cB + hstep, voffB); PG8_STAGE(PG8_SA(0, 1), cA + hstep, voffA);
        if (wr == 1) PG8_BAR;
        PG8_WAIT_V(4); PG8_BAR;
        PG8_STAGE(PG8_SB(1, 0), cB + kstep, voffB); PG8_STAGE(PG8_SA(1, 0), cA + kstep, voffA); PG8_STAGE(PG8_SB(1, 1), cB + hstep + kstep, voffB);
        PG8_WAIT_V(6); PG8_BAR;
    }
    for (;;) {
        const bool has_next = S.next(ui + 1, nxt);
        const char* nA = has_next ? (const char*)g.A + (size_t)nxt.pm * tstep : cA; const char* nB = has_next ? (const char*)g.Bt + (size_t)nxt.pn * tstep : cB;
        _Pragma("unroll 1") for (int t = 0; t < nt; t += 2) {
            const bool last = (t == nt - 2);
            const char* a1 = cA + (size_t)(t + 1) * kstep;
            const char* a2 = last ? nA : cA + (size_t)(t + 2) * kstep; const char* b2 = last ? nB : cB + (size_t)(t + 2) * kstep;
            const char* a3 = a2 + kstep; const char* b3 = b2 + kstep;
            if (last && has_next) S.a_ready(nxt);
            if constexpr (SP2) {
            PG8_LDB(B0, 0, 0); PG8_LDB(B1, 0, 1); PG8_SCHED; PG8_LDA(At, 0, 0); PG8_STAGE(PG8_SA(1, 1), a1 + hstep, voffA);
            PG8_WAIT_V(8); PG8_WAIT_L(0); PG8_BAR; PG8_MMA(0, 0, At, B0); PG8_MMA(0, 1, At, B1); PG8_BAR; PG8_SCHED;
            PG8_LDA(At, 0, 1); PG8_STAGE(PG8_SB(0, 0), b2, voffB); PG8_STAGE(PG8_SB(0, 1), b2 + hstep, voffB); PG8_STAGE(PG8_SA(0, 0), a2, voffA);
            PG8_WAIT_V(8); PG8_WAIT_L(0); PG8_BAR; PG8_MMA(1, 0, At, B0); PG8_MMA(1, 1, At, B1); PG8_BAR; PG8_SCHED;
            PG8_LDB(B0, 1, 0); PG8_LDB(B1, 1, 1); PG8_SCHED; PG8_LDA(At, 1, 0); PG8_STAGE(PG8_SA(0, 1), a2 + hstep, voffA);
            PG8_WAIT_V(8); PG8_WAIT_L(0); PG8_BAR; PG8_MMA(0, 0, At, B0); PG8_MMA(0, 1, At, B1); PG8_BAR; PG8_SCHED;
            PG8_LDA(At, 1, 1); PG8_STAGE(PG8_SB(1, 0), b3, voffB); PG8_STAGE(PG8_SB(1, 1), b3 + hstep, voffB); PG8_STAGE(PG8_SA(1, 0), a3, voffA);
            PG8_WAIT_V(8); PG8_WAIT_L(0); PG8_BAR; PG8_MMA(1, 0, At, B0); PG8_MMA(1, 1, At, B1); PG8_BAR; PG8_SCHED;
            } else {
            PG8_LDB(B0, 0, 0); PG8_SCHED; PG8_LDA(At, 0, 0); PG8_STAGE(PG8_SA(1, 1), a1 + hstep, voffA);
            PG8_WAIT_L(8); PG8_BAR; PG8_WAIT_L(0); PG8_MMA(0, 0, At, B0); PG8_BAR; PG8_SCHED;
            PG8_LDB(B1, 0, 1); PG8_STAGE(PG8_SB(0, 0), b2, voffB);
            PG8_BAR; PG8_WAIT_L(0); PG8_MMA(0, 1, At, B1); PG8_BAR;
            PG8_LDA(At, 0, 1); PG8_STAGE(PG8_SA(0, 0), a2, voffA);
            PG8_BAR; PG8_WAIT_L(0); PG8_MMA(1, 0, At, B0); PG8_BAR; PG8_SCHED;
            PG8_STAGE(PG8_SB(0, 1), b2 + hstep, voffB);
            PG8_WAIT_V(6); PG8_BAR; PG8_MMA(1, 1, At, B1); PG8_BAR;
            PG8_LDB(B0, 1, 0); PG8_SCHED; PG8_LDA(At, 1, 0); PG8_STAGE(PG8_SA(0, 1), a2 + hstep, voffA);
            PG8_WAIT_L(8); PG8_BAR; PG8_WAIT_L(0); PG8_MMA(0, 0, At, B0); PG8_BAR; PG8_SCHED;
            PG8_LDB(B1, 1, 1); PG8_STAGE(PG8_SB(1, 0), b3, voffB);
            PG8_BAR; PG8_WAIT_L(0); PG8_MMA(0, 1, At, B1); PG8_BAR;
            PG8_LDA(At, 1, 1); PG8_STAGE(PG8_SA(1, 0), a3, voffA);
            PG8_BAR; PG8_WAIT_L(0); PG8_MMA(1, 0, At, B0); PG8_BAR; PG8_SCHED;
            PG8_STAGE(PG8_SB(1, 1), b3 + hstep, voffB);
            PG8_WAIT_V(6); PG8_BAR; PG8_MMA(1, 1, At, B1); PG8_BAR;
            }
        }
        if constexpr (ALIGN_EPI) { if (wr == 0) PG8_BAR; }
        if constexpr (!Epi::AFTER_DRAIN) { E(acc, cur, wr, wc, fr, fq); S.done(cur); }
        if (!has_next) break;
#pragma unroll
        for (int a = 0; a < 2; ++a)
#pragma unroll
            for (int b = 0; b < 2; ++b)
#pragma unroll
                for (int m = 0; m < 4; ++m)
#pragma unroll
                    for (int n = 0; n < 2; ++n) acc[a][b][m][n] = (f32x4){0.f, 0.f, 0.f, 0.f};
        cur = nxt; cA = nA; cB = nB; ++ui;
        if constexpr (ALIGN_EPI) { if (wr == 1) PG8_BAR; }
    }
    PG8_WAIT_V(0);
    if constexpr (!ALIGN_EPI) { if (wr == 0) PG8_BAR; }
    PG8_BAR;
    if constexpr (Epi::AFTER_DRAIN) { E.fused(acc, cur, wr, wc, fr, fq, lds, wid, lane); S.done(cur); }
#undef PG8_SA
#undef PG8_SB
#undef PG8_STAGE
#undef PG8_LDA
#undef PG8_LDB
#undef PG8_MMA
#undef PG8_WAIT_V
#undef PG8_WAIT_L
#undef PG8_BAR
#undef PG8_SCHED
}
}

#define LAS __attribute__((address_space(3)))
#define DI __device__ __forceinline__
typedef unsigned short bf16;
typedef unsigned u32x4 __attribute__((ext_vector_type(4)));
typedef unsigned u32x2 __attribute__((ext_vector_type(2)));
typedef float f32x4 __attribute__((ext_vector_type(4)));
typedef float f32x2 __attribute__((ext_vector_type(2)));
typedef float f32x16 __attribute__((ext_vector_type(16)));
typedef short bf16x8 __attribute__((ext_vector_type(8)));
typedef short s16x4 __attribute__((ext_vector_type(4)));
typedef __bf16 bf16x2_t __attribute__((ext_vector_type(2)));

constexpr int DM = 1024, SEQ = 16384, NSB = 16, NST = 32, PAST = 4096, NMEM = 256;
constexpr int MROWS = SEQ + NSB * NST;
constexpr int SKEYS = PAST + NST;
constexpr int MKROWS = SEQ + NSB * SKEYS;
constexpr int INWP = 2816, NING = INWP + 3072;
constexpr int DFF = 4096;
constexpr float EPSN = 1e-6f;
constexpr float LOG2E = 1.4426950408889634f;
constexpr float C_MLA = 0.10206207261596575f * LOG2E;
constexpr float C_DIFF = 0.17677669529663687f * LOG2E;
constexpr float C_MEM = 0.08838834764831845f * LOG2E;
constexpr float LAM_INIT = 0.2f;

constexpr size_t O_Y = 0;
constexpr size_t O_PCKV = (size_t)MROWS * DM;
constexpr size_t O_PKR = O_PCKV + (size_t)SEQ * 256;
constexpr size_t O_PDK = O_PKR + (size_t)SEQ * 32;
constexpr size_t O_PDV = O_PDK + (size_t)SEQ * 512;
constexpr size_t O_PMK = O_PDV + (size_t)SEQ * 512;
constexpr size_t O_PMV = O_PMK + (size_t)NMEM * 512;
constexpr size_t O_SCKV = O_PMV + (size_t)NMEM * 512;
constexpr size_t O_SKR = O_SCKV + (size_t)512 * 256;
constexpr size_t O_SDK = O_SKR + (size_t)512 * 32;
constexpr size_t O_SDV = O_SDK + (size_t)512 * 512;
constexpr size_t O_END = O_SDV + (size_t)512 * 512;

constexpr size_t MiB = 1u << 20;
constexpr size_t WS_TABM = 1 * MiB;
constexpr size_t WS_TABD = 3 * MiB;
constexpr size_t WS_W = 4 * MiB;
constexpr size_t W_ING = WS_W;
constexpr size_t W_UQ = W_ING + (size_t)NING * 1024 * 2;
constexpr size_t W_UKV = W_UQ + (size_t)768 * 384 * 2;
constexpr size_t W_MEM = W_UKV + (size_t)1024 * 256 * 2;
constexpr size_t W_OM = W_MEM + (size_t)1024 * 1024 * 2;
constexpr size_t W_OUT = W_OM + (size_t)3 * 1024 * 512 * 2;
constexpr size_t W_UP = W_OUT + (size_t)1024 * 1024 * 2;
constexpr size_t W_DN = W_UP + (size_t)4096 * 1024 * 2;
constexpr size_t W_END = W_DN + (size_t)1024 * 4096 * 2;
static_assert(W_END <= 44 * MiB, "weights");
constexpr size_t WS_G = 44 * MiB;
constexpr size_t WS_MIX = 44 * MiB;
constexpr size_t WS_DQ = 148 * MiB;
constexpr size_t WS_MQ = 165 * MiB;
constexpr size_t WS_QM = 182 * MiB;
constexpr size_t WS_DKP = 208 * MiB;
constexpr size_t WS_DVP = 225 * MiB;
constexpr size_t WS_KR = 242 * MiB;
constexpr size_t WS_MK = 248 * MiB;
constexpr size_t WS_MV = 253 * MiB;
constexpr size_t WS_LAT = 258 * MiB;
constexpr size_t WS_CQN = 299 * MiB;
constexpr size_t WS_OA = 258 * MiB;
constexpr size_t WS_XN = 312 * MiB;
constexpr size_t WS_CQ = 346 * MiB;
constexpr size_t WS_KN = 312 * MiB;
constexpr size_t WS_VM = 393 * MiB;
constexpr size_t WS_MRG = 348 * MiB;
constexpr size_t WS_MRGB = 416 * MiB;
constexpr size_t WS_U = 348 * MiB;
constexpr size_t WS_END = 480 * MiB;
static_assert(WS_KR + (size_t)MKROWS * 32 * 2 <= WS_MK && WS_LAT + (size_t)MKROWS * 256 * 2 <= WS_CQN && WS_CQN + (size_t)MROWS * 384 * 2 <= WS_XN, "ws map 1");
static_assert(WS_OA + (size_t)3 * MROWS * 512 * 2 <= WS_XN && WS_XN + (size_t)MROWS * 1024 * 2 <= WS_CQ && WS_KN + (size_t)MKROWS * 512 * 2 <= WS_VM, "ws map 2");
static_assert(WS_VM + (size_t)MKROWS * 512 * 2 <= WS_END && WS_MRG + (size_t)MROWS * 1024 * 4 <= WS_MRGB && WS_U + (size_t)MROWS * 4096 * 2 <= WS_END, "ws map 3");
static_assert(WS_G + (size_t)MROWS * 3072 * 2 <= WS_DQ && WS_QM + (size_t)MROWS * 768 * 2 <= WS_DKP && WS_MK + (size_t)17 * 256 * 512 * 2 <= WS_MV && WS_MV + (size_t)17 * 256 * 512 * 2 <= WS_LAT, "ws map 4");

DI unsigned pk2(float lo, float hi) { f32x2 v = {lo, hi}; bf16x2_t b = __builtin_convertvector(v, bf16x2_t); return __builtin_bit_cast(unsigned, b); }
DI u32x4 pk8(f32x4 a, f32x4 b) { u32x4 w; w.x = pk2(a[0], a[1]); w.y = pk2(a[2], a[3]); w.z = pk2(b[0], b[1]); w.w = pk2(b[2], b[3]); return w; }
DI float bf_lo(unsigned u) { return __uint_as_float(u << 16); }
DI float bf_hi(unsigned u) { return __uint_as_float(u & 0xffff0000u); }
DI float wave_sum(float v) {
#pragma unroll
    for (int o = 1; o < 64; o <<= 1) v += __shfl_xor(v, o);
    return v;
}
DI int row_pos(int row) { return row < SEQ ? row : PAST + ((row - SEQ) & 31); }
DI int row_krow(int row) { if (row < SEQ) return row; const int rs = row - SEQ; return SEQ + (rs >> 5) * SKEYS + PAST + (rs & 31); }
DI float* out_row(float* out, int row, size_t offP, size_t offS, int W) { return row < SEQ ? out + offP + (size_t)row * W : out + offS + (size_t)(row - SEQ) * W; }

#define EPI_ROWS_BEGIN _Pragma("unroll") for (int ai = 0; ai < 2; ++ai) _Pragma("unroll") for (int m = 0; m < 4; ++m) { int row = row0 + ai * 128 + m * 16; asm volatile("" : "+v"(row)); f32x4 v0 = acc[ai][bj][m][0], v1 = acc[ai][bj][m][1];
#define EPI_ROWS_END asm volatile("" ::: "memory"); }

#ifndef TST_GATE
#define TST_GATE 1
#endif
#ifndef TST_KR
#define TST_KR 1
#endif
#ifndef TST_DQ
#define TST_DQ 1
#endif
struct EpiP1 {
    static constexpr bool PERM = true, AFTER_DRAIN = false;
    bf16* CQ; bf16* KR; bf16* DQ; bf16* DKP; bf16* DVP; bf16* MQ; bf16* G; float* out; const float* bgate; const float* tabm; const float* tabd;
    DI void operator()(const f32x4 (&acc)[2][2][4][2], const pg8::Unit& u, int wr, int wc, int fr, int fq) const {
        const int row0 = u.pm * 256 + wr * 64 + fr;
#pragma unroll
        for (int bj = 0; bj < 2; ++bj) {
            const int cgp = u.pn * 256 + bj * 128 + wc * 32;
            const int c = cgp + 8 * fq;
            if (TST_GATE && cgp >= INWP) {
                const int gc = c - INWP;
                EPI_ROWS_BEGIN
                    v0 += *(const f32x4*)(bgate + gc); v1 += *(const f32x4*)(bgate + gc + 4);
#pragma unroll
                    for (int e = 0; e < 4; ++e) { v0[e] = 1.f / (1.f + __expf(-v0[e])); v1[e] = 1.f / (1.f + __expf(-v1[e])); }
                    *(u32x4*)(G + (size_t)row * 3072 + gc) = pk8(v0, v1);
                EPI_ROWS_END
            } else if (cgp < 384) {
                EPI_ROWS_BEGIN
                    *(u32x4*)(CQ + (size_t)row * 384 + c) = pk8(v0, v1);
                EPI_ROWS_END
            } else if (cgp < 640) {
                EPI_ROWS_BEGIN
                    float* p = out_row(out, row, O_PCKV, O_SCKV, 256) + (c - 384);
                    *(f32x4*)p = v0; *(f32x4*)(p + 4) = v1;
                EPI_ROWS_END
            } else if (TST_KR && cgp < 672) {
                EPI_ROWS_BEGIN
                    const float* tb = tabm + (size_t)row_pos(row) * 32 + 8 * (fq & 1);
                    float* p = out_row(out, row, O_PKR, O_SKR, 32) + (c - 640);
                    const float sg = fq < 2 ? -1.f : 1.f;
                    f32x4 pv;
#pragma unroll
                    for (int e = 0; e < 4; ++e) pv[e] = __shfl_xor(v0[e], 32);
                    const f32x4 o0 = v0 * *(const f32x4*)tb + pv * (*(const f32x4*)(tb + 16) * sg);
                    asm volatile("" ::: "memory");
#pragma unroll
                    for (int e = 0; e < 4; ++e) pv[e] = __shfl_xor(v1[e], 32);
                    const f32x4 o1 = v1 * *(const f32x4*)(tb + 4) + pv * (*(const f32x4*)(tb + 20) * sg);
                    *(f32x4*)p = o0; *(f32x4*)(p + 4) = o1;
                    *(u32x4*)(KR + (size_t)row_krow(row) * 32 + (c - 640)) = pk8(o0, o1);
                EPI_ROWS_END
            } else if (TST_DQ && cgp < 1696) {
                const bool isq = cgp < 1184;
                EPI_ROWS_BEGIN
                    if (fq == 0) {
                        const float* tb = tabd + (size_t)row_pos(row) * 8;
                        const f32x4 cc = *(const f32x4*)tb, ss = *(const f32x4*)(tb + 4);
                        const f32x4 n0 = v0 * cc - v1 * ss, n1 = v1 * cc + v0 * ss; v0 = n0; v1 = n1;
                    }
                    if (isq) { v0 *= C_DIFF; v1 *= C_DIFF; *(u32x4*)(DQ + (size_t)row * 512 + (c - 672)) = pk8(v0, v1); }
                    else {
                        float* p = out_row(out, row, O_PDK, O_SDK, 512) + (c - 1184);
                        *(f32x4*)p = v0; *(f32x4*)(p + 4) = v1;
                        if (row < SEQ) *(u32x4*)(DKP + (size_t)row * 512 + (c - 1184)) = pk8(v0, v1);
                    }
                EPI_ROWS_END
            } else if (cgp < 2208) {
                EPI_ROWS_BEGIN
                    float* p = out_row(out, row, O_PDV, O_SDV, 512) + (c - 1696);
                    *(f32x4*)p = v0; *(f32x4*)(p + 4) = v1;
                    if (row < SEQ) *(u32x4*)(DVP + (size_t)row * 512 + (c - 1696)) = pk8(v0, v1);
                EPI_ROWS_END
            } else if (cgp < 2720) {
                EPI_ROWS_BEGIN
                    v0 *= C_MEM; v1 *= C_MEM;
                    *(u32x4*)(MQ + (size_t)row * 512 + (c - 2208)) = pk8(v0, v1);
                EPI_ROWS_END
            }
        }
    }
};

struct EpiMemKV {
    static constexpr bool PERM = true, AFTER_DRAIN = false;
    float* out; bf16* MK; bf16* MV;
    DI void operator()(const f32x4 (&acc)[2][2][4][2], const pg8::Unit& u, int wr, int wc, int fr, int fq) const {
        const int row0 = u.pm * 256 + wr * 64 + fr;
#pragma unroll
        for (int bj = 0; bj < 2; ++bj) {
            const int c = u.pn * 256 + bj * 128 + wc * 32 + 8 * fq;
            const bool isk = c < 512; const int cc = isk ? c : c - 512;
            float* ob = out + (isk ? O_PMK : O_PMV); bf16* bb = isk ? MK : MV;
            EPI_ROWS_BEGIN
                float* p = ob + (size_t)row * 512 + cc; *(f32x4*)p = v0; *(f32x4*)(p + 4) = v1;
                *(u32x4*)(bb + (size_t)row * 512 + cc) = pk8(v0, v1);
            EPI_ROWS_END
        }
    }
};

struct EpiUQ {
    static constexpr bool PERM = true, AFTER_DRAIN = false;
    bf16* QM; const float* tabm;
    DI void operator()(const f32x4 (&acc)[2][2][4][2], const pg8::Unit& u, int wr, int wc, int fr, int fq) const {
        const int row0 = u.pm * 256 + wr * 64 + fr;
#pragma unroll
        for (int bj = 0; bj < 2; ++bj) {
            const int cgp = u.pn * 256 + bj * 128 + wc * 32; const int c = cgp + 8 * fq;
            const bool isrope = ((cgp >> 5) % 3) == 2;
            if (isrope) {
                EPI_ROWS_BEGIN
                    f32x4 p0, p1;
#pragma unroll
                    for (int e = 0; e < 4; ++e) { p0[e] = __shfl_xor(v0[e], 32); p1[e] = __shfl_xor(v1[e], 32); }
                    const float* tb = tabm + (size_t)row_pos(row) * 32 + 8 * (fq & 1);
                    const f32x4 c0 = *(const f32x4*)tb, c1 = *(const f32x4*)(tb + 4), s0 = *(const f32x4*)(tb + 16), s1 = *(const f32x4*)(tb + 20);
                    f32x4 o0, o1;
                    if (fq < 2) { o0 = v0 * c0 - p0 * s0; o1 = v1 * c1 - p1 * s1; } else { o0 = v0 * c0 + p0 * s0; o1 = v1 * c1 + p1 * s1; }
                    o0 *= C_MLA; o1 *= C_MLA;
                    *(u32x4*)(QM + (size_t)row * 768 + c) = pk8(o0, o1);
                    asm volatile("" ::: "memory");
                EPI_ROWS_END
            } else {
                EPI_ROWS_BEGIN
                    v0 *= C_MLA; v1 *= C_MLA;
                    *(u32x4*)(QM + (size_t)row * 768 + c) = pk8(v0, v1);
                EPI_ROWS_END
            }
        }
    }
};

struct EpiBf16Split {
    static constexpr bool PERM = true, AFTER_DRAIN = false;
    bf16* A; bf16* B;
    DI void operator()(const f32x4 (&acc)[2][2][4][2], const pg8::Unit& u, int wr, int wc, int fr, int fq) const {
        const int row0 = u.pm * 256 + wr * 64 + fr;
#pragma unroll
        for (int bj = 0; bj < 2; ++bj) {
            const int c = u.pn * 256 + bj * 128 + wc * 32 + 8 * fq;
            bf16* bb = c < 512 ? A + c : B + (c - 512);
            EPI_ROWS_BEGIN
                *(u32x4*)(bb + (size_t)row * 512) = pk8(v0, v1);
            EPI_ROWS_END
        }
    }
};

template <int BR> struct EpiMerge {
    static constexpr bool PERM = true, AFTER_DRAIN = false;
    const bf16* G; float* MRG; bf16* MRGB;
    DI void operator()(const f32x4 (&acc)[2][2][4][2], const pg8::Unit& u, int wr, int wc, int fr, int fq) const {
        const int row0 = u.pm * 256 + wr * 64 + fr;
#pragma unroll
        for (int bj = 0; bj < 2; ++bj) {
            const int c = u.pn * 256 + bj * 128 + wc * 32 + 8 * fq;
            EPI_ROWS_BEGIN
                const u32x4 g = *(const u32x4*)(G + (size_t)row * 3072 + BR * 1024 + c);
                const f32x4 g0 = {bf_lo(g.x), bf_hi(g.x), bf_lo(g.y), bf_hi(g.y)}, g1 = {bf_lo(g.z), bf_hi(g.z), bf_lo(g.w), bf_hi(g.w)};
                v0 *= g0; v1 *= g1;
                float* p = MRG + (size_t)row * 1024 + c;
                if (BR > 0) { v0 += *(const f32x4*)p; v1 += *(const f32x4*)(p + 4); }
                if (BR < 2) { *(f32x4*)p = v0; *(f32x4*)(p + 4) = v1; }
                else *(u32x4*)(MRGB + (size_t)row * 1024 + c) = pk8(v0, v1);
            EPI_ROWS_END
        }
    }
};

struct EpiF32 {
    static constexpr bool PERM = true, AFTER_DRAIN = false;
    float* O; int ldc;
    DI void operator()(const f32x4 (&acc)[2][2][4][2], const pg8::Unit& u, int wr, int wc, int fr, int fq) const {
        const int row0 = u.pm * 256 + wr * 64 + fr;
#pragma unroll
        for (int bj = 0; bj < 2; ++bj) {
            const int c = u.pn * 256 + bj * 128 + wc * 32 + 8 * fq;
            EPI_ROWS_BEGIN
                float* p = O + (size_t)row * ldc + c; *(f32x4*)p = v0; *(f32x4*)(p + 4) = v1;
            EPI_ROWS_END
        }
    }
};

struct EpiUp {
    static constexpr bool PERM = true, AFTER_DRAIN = false;
    bf16* U;
    DI void operator()(const f32x4 (&acc)[2][2][4][2], const pg8::Unit& u, int wr, int wc, int fr, int fq) const {
        const int row0 = u.pm * 256 + wr * 64 + fr;
#pragma unroll
        for (int bj = 0; bj < 2; ++bj) {
            const int c = u.pn * 256 + bj * 128 + wc * 32 + 8 * fq;
            EPI_ROWS_BEGIN
#pragma unroll
                for (int e = 0; e < 4; ++e) { const float a = fmaxf(v0[e], 0.f), b = fmaxf(v1[e], 0.f); v0[e] = a * a; v1[e] = b * b; }
                *(u32x4*)(U + (size_t)row * DFF + c) = pk8(v0, v1);
            EPI_ROWS_END
        }
    }
};

struct Chunk { u32x4 a, b; };
template <bool F32> DI void ld_chunk(Chunk& c, const void* base, size_t eoff, bool valid) {
    c.a = (u32x4){0u, 0u, 0u, 0u}; c.b = (u32x4){0u, 0u, 0u, 0u};
    if (valid) {
        if (F32) { const __attribute__((address_space(1))) float* p = (const __attribute__((address_space(1))) float*)base + eoff; c.a = *(const __attribute__((address_space(1))) u32x4*)p; c.b = *(const __attribute__((address_space(1))) u32x4*)(p + 4); }
        else { c.a = *(const __attribute__((address_space(1))) u32x4*)((const __attribute__((address_space(1))) bf16*)base + eoff); }
    }
}
#define GASP __attribute__((address_space(1)))
template <bool F32> DI void ld_chunk2(Chunk& c, const GASP unsigned char* p, bool valid) {
    c.a = (u32x4){0u, 0u, 0u, 0u}; c.b = (u32x4){0u, 0u, 0u, 0u};
    if (valid) { c.a = *(const GASP u32x4*)p; if (F32) c.b = *(const GASP u32x4*)(p + 16); }
}
template <bool F32> DI u32x4 cvt_chunk(const Chunk& c) {
    if (!F32) return c.a;
    u32x4 w;
    w.x = pk2(__uint_as_float(c.a.x), __uint_as_float(c.a.y)); w.y = pk2(__uint_as_float(c.a.z), __uint_as_float(c.a.w));
    w.z = pk2(__uint_as_float(c.b.x), __uint_as_float(c.b.y)); w.w = pk2(__uint_as_float(c.b.z), __uint_as_float(c.b.w));
    return w;
}
typedef short v4i16_t __attribute__((ext_vector_type(4)));
DI s16x4 vtr(const LAS unsigned char* p) { return __builtin_bit_cast(s16x4, __builtin_amdgcn_ds_read_tr16_b64_v4i16((LAS v4i16_t*)p)); }
DI bf16x8 pack8(const f32x16& s, int b) {
    u32x4 w; w.x = pk2(s[b], s[b + 1]); w.y = pk2(s[b + 2], s[b + 3]); w.z = pk2(s[b + 4], s[b + 5]); w.w = pk2(s[b + 6], s[b + 7]);
    return __builtin_bit_cast(bf16x8, w);
}

struct AU {
    const bf16* Q; int ldq; int qrow0; int nq;
    const void* Ka; const void* Kb; int ldk; int nsplit;
    const bf16* Kr; int ldkr;
    const void* Va; const void* Vb; int ldv;
    int nkeys; int limbase;
    bf16* O; int ldo;
    float lam; const float* subg;
};

template <int MODE, bool F32>
DI void attn_unit(LAS unsigned char* lds, const AU& a, const int tid_in) {
    int tid = tid_in; asm volatile("" : "+v"(tid));
    constexpr int NS = (MODE == 1) ? 2 : 1;
    constexpr int DQK = (MODE == 0) ? 96 : (MODE == 1 ? 64 : 128);
    constexpr int DV = (MODE == 2) ? 128 : 64;
    constexpr int NKS = DQK / 16, NDB = DV / 32;
    constexpr int KSTR = DQK * 2 + 16, VSTR = DV * 2 + 16, KBY = 64 * KSTR, VBY = 64 * VSTR;
    constexpr int KC = (MODE == 0) ? 64 : DQK, KCH = KC / 8, NKJ = KC / 64, VCH = DV / 8, NVJ = DV / 64;
    constexpr bool PREF = (MODE != 2);
    constexpr int NDH = 1;
    constexpr bool PVA = (MODE != 1);
    constexpr float THR = 8.f;
    const int lane = tid & 63, wave = __builtin_amdgcn_readfirstlane(tid >> 6), r = lane & 31, h = lane >> 5;
    const int NT = (a.nkeys + 63) >> 6;
    int lim = a.limbase + (wave >> 1); if (lim > NT - 1) lim = NT - 1;
    const bool active = wave * 32 < a.nq;
    const int ntw = active ? lim + 1 : 0;
    const bool late = wave >= 4;
    bf16x8 qf[NKS];
#pragma unroll
    for (int s = 0; s < NKS; ++s) {
        qf[s] = (bf16x8){0, 0, 0, 0, 0, 0, 0, 0};
        if (active) qf[s] = *(const bf16x8*)(a.Q + (size_t)(a.qrow0 + wave * 32 + r) * a.ldq + 16 * s + 8 * h);
    }
    float mrun[NS], lrun[NS]; f32x16 o[NS][NDB]; f32x16 sA, sB; bf16x8 pf[NS][2][2];
#pragma unroll
    for (int c = 0; c < NS; ++c) { mrun[c] = -1e30f; lrun[c] = 0.f;
#pragma unroll
        for (int i = 0; i < 16; ++i) { sA[i] = 0.f; sB[i] = 0.f; }
#pragma unroll
        for (int x = 0; x < 4; ++x) pf[c][x >> 1][x & 1] = (bf16x8){0, 0, 0, 0, 0, 0, 0, 0};
#pragma unroll
        for (int d = 0; d < NDB; ++d)
#pragma unroll
            for (int i = 0; i < 16; ++i) o[c][d][i] = 0.f; }
    Chunk ck[NKJ], cr, cv[NVJ];
    constexpr int ESZ = F32 ? 4 : 2;
    int koff_[NKJ], krw_[NKJ], voff_[NVJ], vrw_[NVJ];
#pragma unroll
    for (int j = 0; j < NKJ; ++j) { const int q_ = tid + 512 * j; krw_[j] = q_ / KCH; koff_[j] = (krw_[j] * 512 + (q_ % KCH) * 8) * ESZ; }
#pragma unroll
    for (int j = 0; j < NVJ; ++j) { const int q_ = tid + 512 * j; vrw_[j] = q_ / VCH; voff_[j] = (vrw_[j] * 512 + (q_ % VCH) * 8) * ESZ; }
    cr.a = (u32x4){0u, 0u, 0u, 0u}; cr.b = cr.a;
    const int qq = (lane & 15) >> 2, pp = lane & 3, blk = (lane >> 4) & 1;
    const int kroff = r * KSTR + h * 16, vroff = (4 * h + qq) * VSTR + (16 * blk + 4 * pp) * 2;
#define AT_LOAD(t) do { const int kv0_ = (t) * 64; const bool fs_ = kv0_ < a.nsplit; const size_t tb_ = (size_t)(fs_ ? kv0_ : kv0_ - a.nsplit) * 512; \
        const GASP unsigned char* kbs_ = (const GASP unsigned char*)(fs_ ? a.Ka : a.Kb) + tb_ * ESZ; const GASP unsigned char* vbs_ = (const GASP unsigned char*)(fs_ ? a.Va : a.Vb) + tb_ * ESZ; \
        _Pragma("unroll") for (int j = 0; j < NKJ; ++j) ld_chunk2<F32>(ck[j], kbs_ + koff_[j], kv0_ + krw_[j] < a.nkeys); \
        if (MODE == 0) { if (tid < 256) ld_chunk2<false>(cr, (const GASP unsigned char*)a.Kr + (size_t)kv0_ * 64 + (size_t)((tid >> 2) * 64 + (tid & 3) * 16), kv0_ + (tid >> 2) < a.nkeys); } \
        _Pragma("unroll") for (int j = 0; j < NVJ; ++j) ld_chunk2<F32>(cv[j], vbs_ + voff_[j], kv0_ + vrw_[j] < a.nkeys); } while (0)
#define AT_COMMIT(t) do { LAS unsigned char* kb_ = lds + ((t) % 3) * KBY; LAS unsigned char* vb_ = lds + 3 * KBY + ((t) & 3) * VBY; \
        _Pragma("unroll") for (int j = 0; j < NKJ; ++j) { const int q_ = tid + 512 * j, rw_ = q_ / KCH, ch_ = q_ % KCH; *(LAS u32x4*)(kb_ + rw_ * KSTR + ch_ * 16) = cvt_chunk<F32>(ck[j]); } \
        if (MODE == 0) { if (tid < 256) { const int rw_ = tid >> 2, ch_ = tid & 3; *(LAS u32x4*)(kb_ + rw_ * KSTR + 128 + ch_ * 16) = cr.a; } } \
        _Pragma("unroll") for (int j = 0; j < NVJ; ++j) { const int q_ = tid + 512 * j, rw_ = q_ / VCH, ch_ = q_ % VCH; *(LAS u32x4*)(vb_ + rw_ * VSTR + ch_ * 16) = cvt_chunk<F32>(cv[j]); } } while (0)
#define AT_QKC(tt, c) do { const LAS unsigned char* kp_ = lds + (((tt) % 3) * KBY + kroff); const bool halft_ = (a.nkeys - (tt) * 64) <= 32; \
        f32x16 s0_, s1_; \
        _Pragma("unroll") for (int i = 0; i < 16; ++i) { s0_[i] = 0.f; s1_[i] = 0.f; } \
        constexpr int KSN_ = (MODE == 1) ? 2 : NKS; constexpr int KBT_ = (KSN_ > 4) ? ((KSN_ % 4 == 0) ? 4 : 3) : KSN_; \
        _Pragma("unroll") for (int kb0 = 0; kb0 < KSN_; kb0 += KBT_) { \
            bf16x8 kf_[2 * KBT_]; \
            _Pragma("unroll") for (int ks = 0; ks < KBT_; ++ks) { const int kk = ((MODE == 1) ? 2 * (c) : 0) + kb0 + ks; \
                kf_[2 * ks] = *(const LAS bf16x8*)(kp_ + kk * 32); kf_[2 * ks + 1] = *(const LAS bf16x8*)(kp_ + 32 * KSTR + kk * 32); } \
            __builtin_amdgcn_sched_barrier(0); \
            _Pragma("unroll") for (int ks = 0; ks < KBT_; ++ks) { const int kk = ((MODE == 1) ? 2 * (c) : 0) + kb0 + ks; \
                s0_ = __builtin_amdgcn_mfma_f32_32x32x16_bf16(kf_[2 * ks], qf[kk], s0_, 0, 0, 0); \
                s1_ = __builtin_amdgcn_mfma_f32_32x32x16_bf16(kf_[2 * ks + 1], qf[kk], s1_, 0, 0, 0); } \
            __builtin_amdgcn_sched_barrier(0); } \
        if (halft_) { _Pragma("unroll") for (int i = 0; i < 16; ++i) s1_[i] = -1e30f; } \
        sA = s0_; sB = s1_; } while (0)
#define AT_SM(c) do { \
        float mx = fmaxf(sA[0], sB[0]); \
        _Pragma("unroll") for (int i = 1; i < 16; ++i) mx = fmaxf(fmaxf(sA[i], sB[i]), mx); \
        mx = fmaxf(mx, __shfl_xor(mx, 32)); \
        if (__any(mx > mrun[c] + THR)) { \
            const float mn = fmaxf(mrun[c], mx); const float al = __builtin_amdgcn_exp2f(mrun[c] - mn); mrun[c] = mn; lrun[c] *= al; \
            _Pragma("unroll") for (int d = 0; d < NDB; ++d) _Pragma("unroll") for (int i = 0; i < 16; ++i) o[c][d][i] *= al; } \
        const float mm = mrun[c]; float ps = 0.f; \
        _Pragma("unroll") for (int i = 0; i < 16; ++i) { sA[i] = __builtin_amdgcn_exp2f(sA[i] - mm); sB[i] = __builtin_amdgcn_exp2f(sB[i] - mm); ps += sA[i] + sB[i]; } \
        lrun[c] += ps; \
        pf[c][0][0] = pack8(sA, 0); pf[c][0][1] = pack8(sA, 8); pf[c][1][0] = pack8(sB, 0); pf[c][1][1] = pack8(sB, 8); } while (0)
#define AT_VRD(tt, d0) do { const LAS unsigned char* vp0_ = lds + (3 * KBY + ((tt) & 3) * VBY + vroff); \
        _Pragma("unroll") for (int dd = 0; dd < NDH; ++dd) _Pragma("unroll") for (int kb = 0; kb < 2; ++kb) _Pragma("unroll") for (int sp = 0; sp < 2; ++sp) { \
            const LAS unsigned char* vp = vp0_ + ((kb * 32 + sp * 16) * VSTR + ((d0) + dd) * 64); \
            vlo_[dd * 4 + kb * 2 + sp] = vtr(vp); vhi_[dd * 4 + kb * 2 + sp] = vtr(vp + 8 * VSTR); } } while (0)
#define AT_PVM(d0) do { _Pragma("unroll") for (int dd = 0; dd < NDH; ++dd) _Pragma("unroll") for (int kb = 0; kb < 2; ++kb) _Pragma("unroll") for (int sp = 0; sp < 2; ++sp) { \
            const s16x4 lo = vlo_[dd * 4 + kb * 2 + sp], hi = vhi_[dd * 4 + kb * 2 + sp]; \
            const bf16x8 vf = (bf16x8){lo[0], lo[1], lo[2], lo[3], hi[0], hi[1], hi[2], hi[3]}; \
            _Pragma("unroll") for (int c = 0; c < NS; ++c) o[c][(d0) + dd] = __builtin_amdgcn_mfma_f32_32x32x16_bf16(vf, pf[c][kb][sp], o[c][(d0) + dd], 0, 0, 0); } } while (0)
#define AT_PHA(tt) do { AT_QKC(tt, 0); if (MODE == 1) { AT_SM(0); } } while (0)
#define AT_PHB(tt) do { s16x4 vlo_[NDH * 4], vhi_[NDH * 4]; \
        AT_VRD(tt, 0); \
        __builtin_amdgcn_sched_barrier(0); \
        if (MODE == 1) { AT_QKC(tt, 1); AT_SM(NS - 1); } else { AT_SM(0); } \
        __builtin_amdgcn_sched_barrier(0); \
        AT_PVM(0); \
        _Pragma("unroll") for (int d0 = NDH; d0 < NDB; d0 += NDH) { __builtin_amdgcn_sched_barrier(0); AT_VRD(tt, d0); __builtin_amdgcn_sched_barrier(0); AT_PVM(d0); } } while (0)
#define AT_BAR() asm volatile("s_waitcnt lgkmcnt(0)\n\ts_barrier" ::: "memory")
    AT_LOAD(0); AT_COMMIT(0);
    if (NT > 1) { AT_LOAD(1); AT_COMMIT(1); }
    AT_BAR();
    if (late) AT_BAR();
    for (int t = 0; t < NT; ++t) {
        if (PREF && t + 2 < NT) AT_LOAD(t + 2);
        if (PVA) {
            const bool pvok = t >= 1 && t - 1 < ntw;
            s16x4 vlo_[NDH * 4], vhi_[NDH * 4];
            if (pvok) AT_VRD(t - 1, 0);
            __builtin_amdgcn_sched_barrier(0);
            if (t < ntw) AT_QKC(t, 0);
            if (pvok) { AT_PVM(0);
#pragma unroll
                for (int d0 = NDH; d0 < NDB; d0 += NDH) { __builtin_amdgcn_sched_barrier(0); AT_VRD(t - 1, d0); __builtin_amdgcn_sched_barrier(0); AT_PVM(d0); } }
        } else { if (t < ntw) AT_PHA(t); }
        AT_BAR();
        if (t < ntw) { if (PVA) { AT_SM(0); } else { AT_PHB(t); } }
        if (t + 2 < NT) { if (!PREF) AT_LOAD(t + 2); AT_COMMIT(t + 2); }
        AT_BAR();
    }
    if (PVA && ntw == NT && ntw > 0) {
        s16x4 vlo_[NDH * 4], vhi_[NDH * 4];
#pragma unroll
        for (int d0 = 0; d0 < NDB; d0 += NDH) { AT_VRD(NT - 1, d0); __builtin_amdgcn_sched_barrier(0); AT_PVM(d0); __builtin_amdgcn_sched_barrier(0); }
    }
    if (!late) AT_BAR();
    AT_BAR();
#undef AT_LOAD
#undef AT_COMMIT
#undef AT_QKC
#undef AT_SM
#undef AT_PHA
#undef AT_PHB
#undef AT_VRD
#undef AT_PVM
#undef AT_BAR
    if (active) {
        const int qi = wave * 32 + r;
        float inv[NS];
#pragma unroll
        for (int c = 0; c < NS; ++c) { const float lt = lrun[c] + __shfl_xor(lrun[c], 32); inv[c] = 1.f / lt; }
        float rs = 1.f;
        if (MODE == 1) {
            float ss = 0.f;
#pragma unroll
            for (int d = 0; d < NDB; ++d)
#pragma unroll
                for (int i = 0; i < 16; ++i) { const float v = o[0][d][i] * inv[0] - a.lam * (o[NS - 1][d][i] * inv[NS - 1]); o[0][d][i] = v; ss += v * v; }
            ss += __shfl_xor(ss, 32);
            rs = rsqrtf(ss * (1.f / 64.f) + EPSN) * (1.f - LAM_INIT);
        } else rs = inv[0];
        bf16* op = a.O + (size_t)(a.qrow0 + qi) * 512;
#pragma unroll
        for (int d = 0; d < NDB; ++d)
#pragma unroll
            for (int g4 = 0; g4 < 4; ++g4) {
                const int dc = d * 32 + 8 * g4 + 4 * h;
                float w0 = o[0][d][4 * g4] * rs, w1 = o[0][d][4 * g4 + 1] * rs, w2 = o[0][d][4 * g4 + 2] * rs, w3 = o[0][d][4 * g4 + 3] * rs;
                if (MODE == 1) { const f32x4 gg = *(const f32x4*)(a.subg + dc); w0 *= gg[0]; w1 *= gg[1]; w2 *= gg[2]; w3 *= gg[3]; }
                u32x2 w; w.x = pk2(w0, w1); w.y = pk2(w2, w3);
                if (qi < a.nq) *(u32x2*)(op + dc) = w;
            }
    }
}

DI void p0_transpose_item(const float* W, int K, int N, bf16* WT, int row_off, LAS float* scr, int item, int lane) {
    const int nblk = N / 32, kb = item / nblk, nb = item % nblk, k0 = 64 * kb, n0 = 32 * nb;
#pragma unroll 8
    for (int i = 0; i < 32; ++i) { const int kk = 2 * i + (lane >> 5); scr[kk * 33 + (lane & 31)] = W[(size_t)(k0 + kk) * N + n0 + (lane & 31)]; }
    asm volatile("s_waitcnt lgkmcnt(0)" ::: "memory");
    const int c = lane & 7;
#pragma unroll
    for (int j = 0; j < 4; ++j) { const int n = (lane >> 3) + 8 * j; const LAS float* s = scr + (8 * c) * 33 + n;
        u32x4 o; o.x = pk2(s[0 * 33], s[1 * 33]); o.y = pk2(s[2 * 33], s[3 * 33]); o.z = pk2(s[4 * 33], s[5 * 33]); o.w = pk2(s[6 * 33], s[7 * 33]);
        *(u32x4*)(WT + (size_t)(row_off + n0 + n) * K + k0 + 8 * c) = o; }
    asm volatile("s_waitcnt lgkmcnt(0)" ::: "memory");
}
DI void rms_row_1024(const float* xrow, const float* g, bf16* orow, int lane) {
    const f32x4* xr = (const f32x4*)xrow + lane; const f32x4* gr = (const f32x4*)g + lane;
    f32x4 v[4]; float s = 0.f;
#pragma unroll
    for (int j = 0; j < 4; ++j) { v[j] = xr[64 * j]; s += (v[j].x * v[j].x + v[j].y * v[j].y) + (v[j].z * v[j].z + v[j].w * v[j].w); }
    const float rstd = rsqrtf(wave_sum(s) * (1.f / 1024.f) + EPSN);
    u32x2* o8 = (u32x2*)orow + lane;
#pragma unroll
    for (int j = 0; j < 4; ++j) { const f32x4 gg = gr[64 * j]; u32x2 w; w.x = pk2(v[j].x * rstd * gg.x, v[j].y * rstd * gg.y); w.y = pk2(v[j].z * rstd * gg.z, v[j].w * rstd * gg.w); o8[64 * j] = w; }
}


template <int K> DI const float* inp_ld() {
    auto kp = __builtin_amdgcn_kernarg_segment_ptr();
    unsigned long long v;
    asm volatile("s_load_dwordx2 %0, %1, %2\n\ts_waitcnt lgkmcnt(0)" : "=s"(v) : "s"(kp), "n"(K * 8));
    return (const float*)(const __attribute__((address_space(1))) float*)v;
}
#define INP(k) inp_ld<k>()

struct Args { const float* in[35]; float* out; unsigned char* ws; int ph_lo, ph_hi; };

constexpr int NPHASE = 11;
constexpr int LDS_BYTES = 147456;

__global__ void __launch_bounds__(512, 2) fwd_kernel(Args args) {
    extern __shared__ __attribute__((aligned(16))) unsigned char lds_raw[];
    LAS unsigned char* lds = (LAS unsigned char*)lds_raw;
    cg::grid_group grid = cg::this_grid();
    const int G = gridDim.x, bid = blockIdx.x;
    const int NGW = G * 8;
#define PHASE_IDS int tid = threadIdx.x; asm volatile("" : "+v"(tid)); const int lane = tid & 63, wave = __builtin_amdgcn_readfirstlane(tid >> 6); const int gw = bid * 8 + wave; (void)lane; (void)gw;
    unsigned char* ws = args.ws; float* out = args.out;
    const int lo = args.ph_lo, hi = args.ph_hi;
#ifndef PHM
#define PHM 0x7ff
#endif
#define IN(k) (((PHM >> (k)) & 1) && lo <= (k) && (k) < hi)
#define SEAM(k) do { if (IN(k) && IN((k) + 1)) grid.sync(); } while (0)
#define XN ((bf16*)(ws + WS_XN))
#define GB ((bf16*)(ws + WS_G))
#define CQ ((bf16*)(ws + WS_CQ))
#define CQN ((bf16*)(ws + WS_CQN))
#define QM ((bf16*)(ws + WS_QM))
#define DQ ((bf16*)(ws + WS_DQ))
#define MQ ((bf16*)(ws + WS_MQ))
#define DKP ((bf16*)(ws + WS_DKP))
#define DVP ((bf16*)(ws + WS_DVP))
#define KR ((bf16*)(ws + WS_KR))
#define MKB ((bf16*)(ws + WS_MK))
#define MVB ((bf16*)(ws + WS_MV))
#define LAT ((bf16*)(ws + WS_LAT))
#define KN ((bf16*)(ws + WS_KN))
#define VM ((bf16*)(ws + WS_VM))
#define OA ((bf16*)(ws + WS_OA))
#define MRG ((float*)(ws + WS_MRG))
#define MRGB ((bf16*)(ws + WS_MRGB))
#define MIX ((float*)(ws + WS_MIX))
#define UB ((bf16*)(ws + WS_U))
#define TABM ((float*)(ws + WS_TABM))
#define TABD ((float*)(ws + WS_TABD))

    if (IN(0)) {
        PHASE_IDS
        LAS float* scr = (LAS float*)(lds + wave * 16384);
        {
            constexpr int I_IN = 16 * 85, I_G = 16 * 96, I_UQ = 6 * 24, I_UK = 4 * 16, I_MK = 16 * 16, I_O = 8 * 32, I_OUT = 16 * 32, I_UP = 16 * 128, I_DN = 64 * 32;
            constexpr int NITEMS = I_IN + I_G + I_UQ + 2 * I_UK + 2 * I_MK + 3 * I_O + I_OUT + I_UP + I_DN;
            for (int it = gw; it < NITEMS; it += NGW) {
                int r = it;
                if (r < I_IN) { p0_transpose_item(INP(10), 1024, 2720, (bf16*)(ws + W_ING), 0, scr, r, lane); continue; } r -= I_IN;
                if (r < I_G) { p0_transpose_item(INP(27), 1024, 3072, (bf16*)(ws + W_ING), INWP, scr, r, lane); continue; } r -= I_G;
                if (r < I_UQ) { p0_transpose_item(INP(12), 384, 768, (bf16*)(ws + W_UQ), 0, scr, r, lane); continue; } r -= I_UQ;
                if (r < I_UK) { p0_transpose_item(INP(14), 256, 512, (bf16*)(ws + W_UKV), 0, scr, r, lane); continue; } r -= I_UK;
                if (r < I_UK) { p0_transpose_item(INP(15), 256, 512, (bf16*)(ws + W_UKV), 512, scr, r, lane); continue; } r -= I_UK;
                if (r < I_MK) { p0_transpose_item(INP(22), 1024, 512, (bf16*)(ws + W_MEM), 0, scr, r, lane); continue; } r -= I_MK;
                if (r < I_MK) { p0_transpose_item(INP(23), 1024, 512, (bf16*)(ws + W_MEM), 512, scr, r, lane); continue; } r -= I_MK;
                if (r < I_O) { p0_transpose_item(INP(24), 512, 1024, (bf16*)(ws + W_OM), 0, scr, r, lane); continue; } r -= I_O;
                if (r < I_O) { p0_transpose_item(INP(25), 512, 1024, (bf16*)(ws + W_OM), 1024, scr, r, lane); continue; } r -= I_O;
                if (r < I_O) { p0_transpose_item(INP(26), 512, 1024, (bf16*)(ws + W_OM), 2048, scr, r, lane); continue; } r -= I_O;
                if (r < I_OUT) { p0_transpose_item(INP(29), 1024, 1024, (bf16*)(ws + W_OUT), 0, scr, r, lane); continue; } r -= I_OUT;
                if (r < I_UP) { p0_transpose_item(INP(32), 1024, 4096, (bf16*)(ws + W_UP), 0, scr, r, lane); continue; } r -= I_UP;
                p0_transpose_item(INP(33), 4096, 1024, (bf16*)(ws + W_DN), 0, scr, r, lane);
            }
        }
        for (int i = gw * 64 + lane; i < 96 * 1024 / 8; i += NGW * 64) *(u32x4*)((bf16*)(ws + W_ING) + (size_t)2720 * 1024 + (size_t)i * 8) = (u32x4){0u, 0u, 0u, 0u};
        for (int m = gw; m < MROWS + NMEM; m += NGW) {
            if (m < SEQ) rms_row_1024(INP(0) + (size_t)m * DM, INP(9), XN + (size_t)m * DM, lane);
            else if (m < MROWS) rms_row_1024(INP(1) + (size_t)(m - SEQ) * DM, INP(9), XN + (size_t)m * DM, lane);
            else rms_row_1024(INP(8) + (size_t)(m - MROWS) * DM, INP(21), MRGB + (size_t)(m - MROWS) * DM, lane);
        }
        for (int i = gw; i < NSB * PAST; i += NGW) {
            const int b = i >> 12, s = i & 4095;
            const f32x4 v = *((const f32x4*)(INP(2) + (size_t)i * 256) + lane);
            u32x2 w; w.x = pk2(v.x, v.y); w.y = pk2(v.z, v.w);
            *((u32x2*)(LAT + (size_t)(SEQ + b * SKEYS + s) * 256) + lane) = w;
        }
        for (int i = gw; i < NSB * PAST / 8; i += NGW) {
            const int rowi = i * 8 + (lane >> 3); const int b = rowi >> 12, s = rowi & 4095;
            const f32x4 v = *((const f32x4*)(INP(3) + (size_t)rowi * 32) + (lane & 7));
            u32x2 w; w.x = pk2(v.x, v.y); w.y = pk2(v.z, v.w);
            *((u32x2*)(KR + (size_t)(SEQ + b * SKEYS + s) * 32) + (lane & 7)) = w;
        }
        for (int i = gw * 64 + lane; i < NSB * NMEM * 512 / 4; i += NGW * 64) {
            const f32x4 a = *((const f32x4*)INP(6) + i), b = *((const f32x4*)INP(7) + i);
            u32x2 w; w.x = pk2(a.x, a.y); w.y = pk2(a.z, a.w); *((u32x2*)(MKB + (size_t)NMEM * 512) + i) = w;
            w.x = pk2(b.x, b.y); w.y = pk2(b.z, b.w); *((u32x2*)(MVB + (size_t)NMEM * 512) + i) = w;
        }
        for (int i = gw * 64 + lane; i < SEQ * 16; i += NGW * 64) {
            const int pos = i >> 4, f = i & 15;
            const float inv = powf(10000.0f, -(float)f * (2.0f / 32.0f)); const float ang = (float)pos * inv;
            TABM[(size_t)pos * 32 + f] = cosf(ang); TABM[(size_t)pos * 32 + 16 + f] = sinf(ang);
        }
        for (int i = gw * 64 + lane; i < SEQ * 4; i += NGW * 64) {
            const int pos = i >> 2, f = i & 3;
            const float inv = powf(500000.0f, -(float)f * (2.0f / 8.0f)); const float ang = (float)pos * inv;
            TABD[(size_t)pos * 8 + f] = cosf(ang); TABD[(size_t)pos * 8 + 4 + f] = sinf(ang);
        }
        asm volatile("s_waitcnt vmcnt(0) lgkmcnt(0)" ::: "memory");
        __syncthreads();
    }
    SEAM(0);

    if (IN(1)) {
        {
            pg8::Gemm g{MRGB, (const bf16*)(ws + W_MEM), NMEM, 1024, 1024}; pg8::StaticOrder S; S.init(NMEM, 1024, G, (bid + 4) % G);
            EpiMemKV E{out, MKB, MVB};
            pg8::gemm_phase<EpiMemKV, pg8::StaticOrder, true, true>(lds, g, S, E);
        }
        {
            pg8::Gemm g{XN, (const bf16*)(ws + W_ING), MROWS, NING, 1024}; pg8::StaticOrder S; S.init(MROWS, NING, G, bid);
            EpiP1 E{CQ, KR, DQ, DKP, DVP, MQ, GB, out, INP(28), TABM, TABD};
            pg8::gemm_phase<EpiP1, pg8::StaticOrder, true, true>(lds, g, S, E);
        }
    }
    SEAM(1);

    if (IN(2)) {
        PHASE_IDS
        for (int row = gw; row < MROWS; row += NGW) {
            {
                u32x4 raw = (u32x4){0u, 0u, 0u, 0u};
                if (lane < 48) raw = *((const u32x4*)(CQ + (size_t)row * 384) + lane);
                float v[8] = {bf_lo(raw.x), bf_hi(raw.x), bf_lo(raw.y), bf_hi(raw.y), bf_lo(raw.z), bf_hi(raw.z), bf_lo(raw.w), bf_hi(raw.w)};
                float s = 0.f;
#pragma unroll
                for (int e = 0; e < 8; ++e) s += v[e] * v[e];
                const float rstd = rsqrtf(wave_sum(s) * (1.f / 384.f) + EPSN);
                if (lane < 48) {
                    const f32x4 g0 = *((const f32x4*)INP(11) + 2 * lane), g1 = *((const f32x4*)INP(11) + 2 * lane + 1);
                    u32x4 w; w.x = pk2(v[0] * rstd * g0.x, v[1] * rstd * g0.y); w.y = pk2(v[2] * rstd * g0.z, v[3] * rstd * g0.w);
                    w.z = pk2(v[4] * rstd * g1.x, v[5] * rstd * g1.y); w.w = pk2(v[6] * rstd * g1.z, v[7] * rstd * g1.w);
                    *((u32x4*)(CQN + (size_t)row * 384) + lane) = w;
                }
            }
            {
                float* p = out_row(out, row, O_PCKV, O_SCKV, 256);
                f32x4 v = *((const f32x4*)p + lane);
                const float s = (v.x * v.x + v.y * v.y) + (v.z * v.z + v.w * v.w);
                const float rstd = rsqrtf(wave_sum(s) * (1.f / 256.f) + EPSN);
                const f32x4 gg = *((const f32x4*)INP(13) + lane);
                v.x *= rstd * gg.x; v.y *= rstd * gg.y; v.z *= rstd * gg.z; v.w *= rstd * gg.w;
                *((f32x4*)p + lane) = v;
                u32x2 w; w.x = pk2(v.x, v.y); w.y = pk2(v.z, v.w);
                *((u32x2*)(LAT + (size_t)row_krow(row) * 256) + lane) = w;
            }
        }
    }
    SEAM(2);

    if (IN(3)) {
#ifndef NO_P3A
        {
            pg8::Gemm g{CQN, (const bf16*)(ws + W_UQ), MROWS, 768, 384}; pg8::StaticOrder S; S.init(MROWS, 768, G, bid);
            EpiUQ E{QM, TABM};
            pg8::gemm_phase<EpiUQ, pg8::StaticOrder, true, true>(lds, g, S, E);
        }
#endif
#ifndef NO_P3B
        {
            pg8::Gemm g{LAT, (const bf16*)(ws + W_UKV), MKROWS, 1024, 256}; pg8::StaticOrder S; S.init(MKROWS, 1024, G, bid);
            EpiBf16Split E{KN, VM};
            pg8::gemm_phase<EpiBf16Split, pg8::StaticOrder, true, true>(lds, g, S, E);
        }
#endif
    }
    SEAM(3);

#ifndef REP_P4
#define REP_P4 1
#endif
    if (IN(4)) for (int rep_ = 0; rep_ < REP_P4; ++rep_) {
        PHASE_IDS
        float lam;
        {
            float sa = 0.f, sb = 0.f;
            if (lane < 32) { sa = INP(16)[lane] * INP(17)[lane]; sb = INP(18)[lane] * INP(19)[lane]; }
            sa = wave_sum(sa); sb = wave_sum(sb);
            lam = expf(sa) - expf(sb) + LAM_INIT;
        }
        constexpr int BIG = 1 << 30;
#define O_MLA OA
#define O_DIFF (OA + (size_t)MROWS * 512)
#define O_MEM (OA + (size_t)2 * MROWS * 512)
#ifndef KMASK
#define KMASK 15
#endif
#define AU_INIT(a) AU a; a.lam = lam; a.subg = INP(20); a.ldo = 512; a.Kb = nullptr; a.Vb = nullptr; a.Kr = KR; a.ldkr = 32; a.nsplit = BIG; a.ldk = 512; a.ldv = 512; a.limbase = BIG / 2;
        if (KMASK & 1) for (int it = bid; it < 384; it += G) {
            const int ne = it < 256 ? 2 : 1;
#pragma unroll 1
            for (int e = 0; e < ne; ++e) {
                AU_INIT(a)
                if (it < 256) { const int head = it & 7, pair = it >> 3, qb = e == 0 ? 63 - pair : pair;
                    a.qrow0 = qb * 256; a.nq = 256; a.nkeys = (qb + 1) * 256; a.limbase = 4 * qb;
                    a.Q = QM + head * 96; a.ldq = 768; a.Ka = KN + head * 64; a.Va = VM + head * 64; a.O = O_MLA + head * 64;
                } else { const int jj = it - 256, b = jj >> 3, head = jj & 7; const size_t k0 = (size_t)SEQ + (size_t)b * SKEYS;
                    a.qrow0 = SEQ + b * 32; a.nq = 32; a.nkeys = SKEYS;
                    a.Q = QM + head * 96; a.ldq = 768; a.Ka = KN + k0 * 512 + head * 64; a.Kr = KR + k0 * 32; a.Va = VM + k0 * 512 + head * 64; a.O = O_MLA + head * 64; }
                attn_unit<0, false>(lds, a, tid);
            }
        }
        if (KMASK & 2) for (int it = bid; it < 256; it += G) {
#pragma unroll 1
            for (int e = 0; e < 2; ++e) {
                AU_INIT(a)
                const int head = it & 7, pair = it >> 3, qb = e == 0 ? 63 - pair : pair;
                a.qrow0 = qb * 256; a.nq = 256; a.nkeys = (qb + 1) * 256; a.limbase = 4 * qb;
                a.Q = DQ + head * 64; a.ldq = 512; a.Ka = DKP + head * 64; a.Va = DVP + head * 64; a.O = O_DIFF + head * 64;
                attn_unit<1, false>(lds, a, tid);
            }
        }
        if (KMASK & 4) for (int it = (bid + G / 2) % G; it < 128; it += G) {
            AU_INIT(a)
            const int b = it >> 3, head = it & 7;
            a.qrow0 = SEQ + b * 32; a.nq = 32; a.nkeys = SKEYS; a.Q = DQ + head * 64; a.ldq = 512; a.nsplit = PAST;
            a.Ka = INP(4) + (size_t)b * PAST * 512 + head * 64; a.Kb = out + O_SDK + (size_t)b * 32 * 512 + head * 64;
            a.Va = INP(5) + (size_t)b * PAST * 512 + head * 64; a.Vb = out + O_SDV + (size_t)b * 32 * 512 + head * 64;
            a.O = O_DIFF + head * 64;
            attn_unit<1, true>(lds, a, tid);
        }
        if (KMASK & 8) for (int it = bid; it < 320; it += G) {
            AU_INIT(a)
            a.nkeys = NMEM; a.ldq = 512;
            if (it < 256) { const int qb = it >> 2, hm = it & 3; a.qrow0 = qb * 256; a.nq = 256; a.Q = MQ + hm * 128; a.Ka = MKB + hm * 128; a.Va = MVB + hm * 128; a.O = O_MEM + hm * 128; }
            else { const int jj = it - 256, b = jj >> 2, hm = jj & 3; a.qrow0 = SEQ + b * 32; a.nq = 32; a.Q = MQ + hm * 128;
                a.Ka = MKB + (size_t)(1 + b) * NMEM * 512 + hm * 128; a.Va = MVB + (size_t)(1 + b) * NMEM * 512 + hm * 128; a.O = O_MEM + hm * 128; }
            attn_unit<2, false>(lds, a, tid);
        }
#undef AU_INIT
    }
    SEAM(4);

    if (IN(5)) {
        const bf16* WOM = (const bf16*)(ws + W_OM);
        { pg8::Gemm g{OA, WOM, MROWS, 1024, 512}; pg8::StaticOrder S; S.init(MROWS, 1024, G, bid); EpiMerge<0> E{GB, MRG, MRGB};
          pg8::gemm_phase<EpiMerge<0>, pg8::StaticOrder, true, true>(lds, g, S, E); }
        { pg8::Gemm g{OA + (size_t)MROWS * 512, WOM + (size_t)1024 * 512, MROWS, 1024, 512}; pg8::StaticOrder S; S.init(MROWS, 1024, G, bid); EpiMerge<1> E{GB, MRG, MRGB};
          pg8::gemm_phase<EpiMerge<1>, pg8::StaticOrder, true, true>(lds, g, S, E); }
        { pg8::Gemm g{OA + (size_t)2 * MROWS * 512, WOM + (size_t)2048 * 512, MROWS, 1024, 512}; pg8::StaticOrder S; S.init(MROWS, 1024, G, bid); EpiMerge<2> E{GB, MRG, MRGB};
          pg8::gemm_phase<EpiMerge<2>, pg8::StaticOrder, true, true>(lds, g, S, E); }
    }
    SEAM(5);

    if (IN(6)) {
        pg8::Gemm g{MRGB, (const bf16*)(ws + W_OUT), MROWS, 1024, 1024}; pg8::StaticOrder S; S.init(MROWS, 1024, G, bid); EpiF32 E{MIX, 1024};
        pg8::gemm_phase<EpiF32, pg8::StaticOrder, true, true>(lds, g, S, E);
    }
    SEAM(6);

    if (IN(7)) {
        PHASE_IDS
        for (int row = gw; row < MROWS; row += NGW) {
            const float* xr = row < SEQ ? INP(0) + (size_t)row * DM : INP(1) + (size_t)(row - SEQ) * DM;
            const f32x4* mr = (const f32x4*)(MIX + (size_t)row * DM) + lane;
            f32x4 v[4]; float s = 0.f;
#pragma unroll
            for (int j = 0; j < 4; ++j) { v[j] = mr[64 * j]; s += (v[j].x * v[j].x + v[j].y * v[j].y) + (v[j].z * v[j].z + v[j].w * v[j].w); }
            const float rstd = rsqrtf(wave_sum(s) * (1.f / 1024.f) + EPSN);
            float s2 = 0.f;
#pragma unroll
            for (int j = 0; j < 4; ++j) { const f32x4 gg = *((const f32x4*)INP(30) + lane + 64 * j); const f32x4 xx = *((const f32x4*)xr + lane + 64 * j);
                v[j].x = xx.x + v[j].x * rstd * gg.x; v[j].y = xx.y + v[j].y * rstd * gg.y; v[j].z = xx.z + v[j].z * rstd * gg.z; v[j].w = xx.w + v[j].w * rstd * gg.w;
                s2 += (v[j].x * v[j].x + v[j].y * v[j].y) + (v[j].z * v[j].z + v[j].w * v[j].w);
                *((f32x4*)(out + O_Y + (size_t)row * DM) + lane + 64 * j) = v[j]; }
            const float rstd2 = rsqrtf(wave_sum(s2) * (1.f / 1024.f) + EPSN);
#pragma unroll
            for (int j = 0; j < 4; ++j) { const f32x4 gg = *((const f32x4*)INP(31) + lane + 64 * j);
                u32x2 w; w.x = pk2(v[j].x * rstd2 * gg.x, v[j].y * rstd2 * gg.y); w.y = pk2(v[j].z * rstd2 * gg.z, v[j].w * rstd2 * gg.w);
                *((u32x2*)(XN + (size_t)row * DM) + lane + 64 * j) = w; }
        }
    }
    SEAM(7);

    if (IN(8)) {
        pg8::Gemm g{XN, (const bf16*)(ws + W_UP), MROWS, DFF, 1024}; pg8::StaticOrder S; S.init(MROWS, DFF, G, bid); EpiUp E{UB};
        pg8::gemm_phase<EpiUp, pg8::StaticOrder, true, true>(lds, g, S, E);
    }
    SEAM(8);

    if (IN(9)) {
        pg8::Gemm g{UB, (const bf16*)(ws + W_DN), MROWS, 1024, DFF}; pg8::StaticOrder S; S.init(MROWS, 1024, G, bid); EpiF32 E{MIX, 1024};
        pg8::gemm_phase<EpiF32, pg8::StaticOrder, true, true>(lds, g, S, E);
    }
    SEAM(9);

    if (IN(10)) {
        PHASE_IDS
        for (int row = gw; row < MROWS; row += NGW) {
            const f32x4* fr_ = (const f32x4*)(MIX + (size_t)row * DM) + lane;
            f32x4 v[4]; float s = 0.f;
#pragma unroll
            for (int j = 0; j < 4; ++j) { v[j] = fr_[64 * j]; s += (v[j].x * v[j].x + v[j].y * v[j].y) + (v[j].z * v[j].z + v[j].w * v[j].w); }
            const float rstd = rsqrtf(wave_sum(s) * (1.f / 1024.f) + EPSN);
#pragma unroll
            for (int j = 0; j < 4; ++j) { const f32x4 gg = *((const f32x4*)INP(34) + lane + 64 * j); f32x4* yp = (f32x4*)(out + O_Y + (size_t)row * DM) + lane + 64 * j; const f32x4 xx = *yp;
                f32x4 y; y.x = xx.x + v[j].x * rstd * gg.x; y.y = xx.y + v[j].y * rstd * gg.y; y.z = xx.z + v[j].z * rstd * gg.z; y.w = xx.w + v[j].w * rstd * gg.w; *yp = y; }
        }
    }
#undef IN
#undef SEAM
}

#ifndef MK_N_LAUNCHES
#define MK_N_LAUNCHES 1
#endif

extern "C" void kernel_launch(void* const* d_in, const int* in_sizes, int n_in, void* d_out, int out_size, void* d_ws, size_t ws_size, hipStream_t stream) {
    static int grid = 0;
    if (grid == 0) {
        if (n_in != 35 || out_size != (int)O_END || ws_size < WS_END) { fprintf(stderr, "kernel_launch: unexpected shapes: n_in %d out %d ws %zu\n", n_in, out_size, ws_size); grid = -1; return; }
        int dev = 0, cus = 0, per_cu = 0;
        hipGetDevice(&dev); hipDeviceGetAttribute(&cus, hipDeviceAttributeMultiprocessorCount, dev);
        if (hipFuncSetAttribute((const void*)fwd_kernel, hipFuncAttributeMaxDynamicSharedMemorySize, LDS_BYTES) != hipSuccess) { fprintf(stderr, "kernel_launch: hipFuncSetAttribute failed\n"); grid = -1; return; }
        hipOccupancyMaxActiveBlocksPerMultiprocessor(&per_cu, (const void*)fwd_kernel, 512, LDS_BYTES);
        (void)hipGetLastError();
        if (per_cu < 1) per_cu = 1;
        grid = cus;
    }
    if (grid < 0) return;
    Args a{};
    for (int i = 0; i < 35; ++i) a.in[i] = (const float*)d_in[i];
    a.out = (float*)d_out; a.ws = (unsigned char*)d_ws;
#if MK_N_LAUNCHES == 1
    a.ph_lo = 0; a.ph_hi = NPHASE;
    void* kargs[] = {&a};
    hipError_t e = hipLaunchCooperativeKernel((const void*)fwd_kernel, dim3(grid), dim3(512), kargs, LDS_BYTES, stream);
    if (e != hipSuccess) fprintf(stderr, "cooperative launch failed: %s (grid %d)\n", hipGetErrorString(e), grid);
#else
    for (int p = 0; p < NPHASE; ++p) { a.ph_lo = p; a.ph_hi = p + 1; hipLaunchKernelGGL(fwd_kernel, dim3(grid), dim3(512), LDS_BYTES, stream, a); }
#endif
}
```

```cpp
#include <hip/hip_runtime.h>
#include <hip/hip_cooperative_groups.h>
#include <cstdio>
#include <cstdint>
namespace cg = cooperative_groups;
namespace pg8 {
#define PG8_LAS __attribute__((address_space(3)))
typedef unsigned short bf16_t;
typedef short bf16x8 __attribute__((ext_vector_type(8)));
typedef float f32x4 __attribute__((ext_vector_type(4)));
typedef unsigned u32x4 __attribute__((ext_vector_type(4)));
constexpr int BM = 256, BK = 64, HALF = 128, HTB = HALF * BK * 2  , STAGE_BYTES = 8 * HTB, NXCD = 8, WGM = 8;

__host__ __device__ __forceinline__ int lds_byte(int r, int c) { const int st = (r >> 4) * 2 + (c >> 5), rr = r & 15, cc = c & 31, ob = rr * 64 + cc * 2; return st * 1024 + (ob ^ (((ob >> 9) & 1) << 5)); }
__host__ __device__ __forceinline__ void stage_rc(int b, int& R, int& C) { const int st = b / 1024, sb = b % 1024, swz = sb ^ (((sb >> 9) & 1) << 5); R = (st >> 1) * 16 + swz / 64; C = (st & 1) * 32 + (swz % 64) / 2; }
__host__ __device__ __forceinline__ int perm32(int rho) { const int n = rho >> 4, i = rho & 15; return 8 * (i >> 2) + 4 * n + (i & 3); }

struct Unit { int pm, pn; };
struct Gemm { const bf16_t* A; const bf16_t* Bt; int M, N, K; };

struct StaticOrder {
    int nM, nN, nwg, G, c;
    __host__ __device__ void init(int M, int N, int G_, int c_) { nM = M / BM; nN = N / BM; nwg = nM * nN; G = G_; c = c_; }
    __host__ __device__ bool next(int i, Unit& u) const {
        const long L = (long)i * G + c; if (L >= nwg) return false;
        int wgid = (int)L; { const int q = nwg / NXCD, r = nwg % NXCD, xcd = wgid % NXCD, off = wgid / NXCD; wgid = (xcd < r ? xcd * (q + 1) : r * (q + 1) + (xcd - r) * q) + off; }
        const int nig = WGM * nN, gid = wgid / nig, fm = gid * WGM, gsz = (nM - fm) < WGM ? (nM - fm) : WGM;
        u.pm = fm + ((wgid % nig) % gsz); u.pn = (wgid % nig) / gsz; return true;
    }
    __device__ __forceinline__ void a_ready(const Unit&) const {}
    __device__ __forceinline__ void done(const Unit&) const {}
};

__device__ __forceinline__ unsigned cvt_pk_bf16(float lo, float hi) { unsigned r; asm volatile("v_cvt_pk_bf16_f32 %0, %1, %2" : "=v"(r) : "v"(lo), "v"(hi)); return r; }
template <class Epi, class Sched, bool ALIGN_EPI = false, bool SP2 = false>
__device__ __forceinline__ void gemm_phase(PG8_LAS unsigned char* lds, const Gemm g, const Sched& S, const Epi& E) {
    int tid_l = threadIdx.x; asm volatile("" : "+v"(tid_l));
    const int tid = tid_l, wid = __builtin_amdgcn_readfirstlane(tid >> 6), lane = tid & 63, wr = wid >> 2, wc = wid & 3, fr = lane & 15, fq = lane >> 4;
    const int K = g.K, nt = K / BK;
    unsigned voffA[2], voffB[2];
#pragma unroll
    for (int i = 0; i < 2; ++i) { int R, C; stage_rc(tid * 16 + i * 8192, R, C); const int Rb = Epi::PERM ? ((R & ~31) + perm32(R & 31)) : R;
        voffA[i] = (unsigned)(R * K + C) * 2u; voffB[i] = (unsigned)(Rb * K + C) * 2u; }
    const size_t kstep = (size_t)(BK * 2);
    const size_t hstep = (size_t)HALF * K * 2;
    const size_t tstep = 2 * hstep;
    const unsigned ldsw = (unsigned)wid * 1024u;
    const int aoff = lds_byte(wr * 64 + fr, fq * 8), boff = lds_byte(wc * 32 + fr, fq * 8);
#define PG8_SA(b, h) (((b) * 2 + (h)) * HTB)
#define PG8_SB(b, h) ((4 + (b) * 2 + (h)) * HTB)
#define PG8_STAGE(bufoff, gbase, voff) do { _Pragma("unroll") for (int _i = 0; _i < 2; ++_i) \
        __builtin_amdgcn_global_load_lds((const unsigned*)((const char*)(gbase) + (voff)[_i]), (PG8_LAS unsigned*)(lds + (bufoff) + ldsw + _i * 8192), 16, 0, 0); } while (0)
#define PG8_LDA(dst, b, h) do { _Pragma("unroll") for (int m = 0; m < 4; ++m) _Pragma("unroll") for (int k = 0; k < 2; ++k) dst[m][k] = *(const PG8_LAS bf16x8*)(lds + PG8_SA(b, h) + aoff + m * 2048 + k * 1024); } while (0)
#define PG8_LDB(dst, b, h) do { _Pragma("unroll") for (int n = 0; n < 2; ++n) _Pragma("unroll") for (int k = 0; k < 2; ++k) dst[n][k] = *(const PG8_LAS bf16x8*)(lds + PG8_SB(b, h) + boff + n * 2048 + k * 1024); } while (0)
#define PG8_MMA(ai, bj, At, Bt) do { __builtin_amdgcn_s_setprio(1); _Pragma("unroll") for (int m = 0; m < 4; ++m) _Pragma("unroll") for (int n = 0; n < 2; ++n) _Pragma("unroll") for (int k = 0; k < 2; ++k) \
        acc[ai][bj][m][n] = __builtin_amdgcn_mfma_f32_16x16x32_bf16(Bt[n][k], At[m][k], acc[ai][bj][m][n], 0, 0, 0); __builtin_amdgcn_s_setprio(0); } while (0)
#define PG8_WAIT_V(n) asm volatile("s_waitcnt vmcnt(" #n ")" ::: "memory")
#define PG8_WAIT_L(n) asm volatile("s_waitcnt lgkmcnt(" #n ")" ::: "memory")
#define PG8_BAR __builtin_amdgcn_s_barrier()
#define PG8_SCHED __builtin_amdgcn_sched_barrier(0)
    Unit cur, nxt; int ui = 0;
    if (!S.next(0, cur)) return;
    f32x4 acc[2][2][4][2];
#pragma unroll
    for (int a = 0; a < 2; ++a)
#pragma unroll
        for (int b = 0; b < 2; ++b)
#pragma unroll
            for (int m = 0; m < 4; ++m)
#pragma unroll
                for (int n = 0; n < 2; ++n) acc[a][b][m][n] = (f32x4){0.f, 0.f, 0.f, 0.f};
    bf16x8 At[4][2], B0[2][2], B1[2][2];
    const char* cA = (const char*)g.A + (size_t)cur.pm * tstep; const char* cB = (const char*)g.Bt + (size_t)cur.pn * tstep;
    S.a_ready(cur);
    if constexpr (SP2) {
        PG8_STAGE(PG8_SB(0, 0), cB, voffB); PG8_STAGE(PG8_SB(0, 1), cB + hstep, voffB); PG8_STAGE(PG8_SA(0, 0), cA, voffA); PG8_STAGE(PG8_SA(0, 1), cA + hstep, voffA);
        if (wr == 1) PG8_BAR;
        PG8_WAIT_V(2); PG8_BAR;
        PG8_STAGE(PG8_SB(1, 0), cB + kstep, voffB); PG8_STAGE(PG8_SA(1, 0), cA + kstep, voffA); PG8_STAGE(PG8_SB(1, 1), cB + hstep + kstep, voffB);
        PG8_WAIT_V(6); PG8_BAR;
    } else {
        PG8_STAGE(PG8_SB(0, 0), cB, voffB); PG8_STAGE(PG8_SA(0, 0), cA, voffA); PG8_STAGE(PG8_SB(0, 1), cB + hstep, voffB); PG8_STAGE(PG8_SA(0, 1), cA + hstep, voffA);
        if (wr == 1) PG8_BAR;
        PG8_WAIT_V(4); PG8_BAR;
        PG8_STAGE(PG8_SB(1, 0), cB + kstep, voffB); PG8_STAGE(PG8_SA(1, 0), cA + kstep, voffA); PG8_STAGE(PG8_SB(1, 1), cB + hstep + kstep, voffB);
        PG8_WAIT_V(6); PG8_BAR;
    }
    for (;;) {
        const bool has_next = S.next(ui + 1, nxt);
        const char* nA = has_next ? (const char*)g.A + (size_t)nxt.pm * tstep : cA; const char* nB = has_next ? (const char*)g.Bt + (size_t)nxt.pn * tstep : cB;
        _Pragma("unroll 1") for (int t = 0; t < nt; t += 2) {
            const bool last = (t == nt - 2);
            const char* a1 = cA + (size_t)(t + 1) * kstep;
            const char* a2 = last ? nA : cA + (size_t)(t + 2) * kstep; const char* b2 = last ? nB : cB + (size_t)(t + 2) * kstep;
            const char* a3 = a2 + kstep; const char* b3 = b2 + kstep;
            if (last && has_next) S.a_ready(nxt);
            if constexpr (SP2) {
            PG8_LDB(B0, 0, 0); PG8_LDB(B1, 0, 1); PG8_SCHED; PG8_LDA(At, 0, 0); PG8_STAGE(PG8_SA(1, 1), a1 + hstep, voffA);
            PG8_WAIT_V(8); PG8_WAIT_L(0); PG8_BAR; PG8_MMA(0, 0, At, B0); PG8_MMA(0, 1, At, B1); PG8_BAR; PG8_SCHED;
            PG8_LDA(At, 0, 1); PG8_STAGE(PG8_SB(0, 0), b2, voffB); PG8_STAGE(PG8_SB(0, 1), b2 + hstep, voffB); PG8_STAGE(PG8_SA(0, 0), a2, voffA);
            PG8_WAIT_V(8); PG8_WAIT_L(0); PG8_BAR; PG8_MMA(1, 0, At, B0); PG8_MMA(1, 1, At, B1); PG8_BAR; PG8_SCHED;
            PG8_LDB(B0, 1, 0); PG8_LDB(B1, 1, 1); PG8_SCHED; PG8_LDA(At, 1, 0); PG8_STAGE(PG8_SA(0, 1), a2 + hstep, voffA);
            PG8_WAIT_V(8); PG8_WAIT_L(0); PG8_BAR; PG8_MMA(0, 0, At, B0); PG8_MMA(0, 1, At, B1); PG8_BAR; PG8_SCHED;
            PG8_LDA(At, 1, 1); PG8_STAGE(PG8_SB(1, 0), b3, voffB); PG8_STAGE(PG8_SB(1, 1), b3 + hstep, voffB); PG8_STAGE(PG8_SA(1, 0), a3, voffA);
            PG8_WAIT_V(8); PG8_WAIT_L(0); PG8_BAR; PG8_MMA(1, 0, At, B0); PG8_MMA(1, 1, At, B1); PG8_BAR; PG8_SCHED;
            } else {
            PG8_LDB(B0, 0, 0); PG8_SCHED; PG8_LDA(At, 0, 0); PG8_STAGE(PG8_SA(1, 1), a1 + hstep, voffA);
            PG8_WAIT_L(8); PG8_BAR; PG8_WAIT_L(0); PG8_MMA(0, 0, At, B0); PG8_BAR; PG8_SCHED;
            PG8_LDB(B1, 0, 1); PG8_STAGE(PG8_SB(0, 0), b2, voffB);
            PG8_BAR; PG8_WAIT_L(0); PG8_MMA(0, 1, At, B1); PG8_BAR;
            PG8_LDA(At, 0, 1); PG8_STAGE(PG8_SA(0, 0), a2, voffA);
            PG8_BAR; PG8_WAIT_L(0); PG8_MMA(1, 0, At, B0); PG8_BAR; PG8_SCHED;
            PG8_STAGE(PG8_SB(0, 1), b2 + hstep, voffB);
            PG8_WAIT_V(6); PG8_BAR; PG8_MMA(1, 1, At, B1); PG8_BAR;
            PG8_LDB(B0, 1, 0); PG8_SCHED; PG8_LDA(At, 1, 0); PG8_STAGE(PG8_SA(0, 1), a2 + hstep, voffA);
            PG8_WAIT_L(8); PG8_BAR; PG8_WAIT_L(0); PG8_MMA(0, 0, At, B0); PG8_BAR; PG8_SCHED;
            PG8_LDB(B1, 1, 1); PG8_STAGE(PG8_SB(1, 0), b3, voffB);
            PG8_BAR; PG8_WAIT_L(0); PG8_MMA(0, 1, At, B1); PG8_BAR;
            PG8_LDA(At, 1, 1); PG8_STAGE(PG8_SA(1, 0), a3, voffA);
            PG8_BAR; PG8_WAIT_L(0); PG8_MMA(1, 0, At, B0); PG8_BAR; PG8_SCHED;
            PG8_STAGE(PG8_SB(1, 1), b3 + hstep, voffB);
            PG8_WAIT_V(6); PG8_BAR; PG8_MMA(1, 1, At, B1); PG8_BAR;
            }
        }
        if constexpr (ALIGN_EPI) { if (wr == 0) PG8_BAR; }
        if constexpr (!Epi::AFTER_DRAIN) { E(acc, cur, wr, wc, fr, fq); S.done(cur); }
        if (!has_next) break;
#pragma unroll
        for (int a = 0; a < 2; ++a)
#pragma unroll
            for (int b = 0; b < 2; ++b)
#pragma unroll
                for (int m = 0; m < 4; ++m)
#pragma unroll
                    for (int n = 0; n < 2; ++n) acc[a][b][m][n] = (f32x4){0.f, 0.f, 0.f, 0.f};
        cur = nxt; cA = nA; cB = nB; ++ui;
        if constexpr (ALIGN_EPI) { if (wr == 1) PG8_BAR; }
    }
    PG8_WAIT_V(0);
    if constexpr (!ALIGN_EPI) { if (wr == 0) PG8_BAR; }
    PG8_BAR;
    if constexpr (Epi::AFTER_DRAIN) { E.fused(acc, cur, wr, wc, fr, fq, lds, wid, lane); S.done(cur); }
#undef PG8_SA
#undef PG8_SB
#undef PG8_STAGE
#undef PG8_LDA
#undef PG8_LDB
#undef PG8_MMA
#undef PG8_WAIT_V
#undef PG8_WAIT_L
#undef PG8_BAR
#undef PG8_SCHED
}
}

#define LAS __attribute__((address_space(3)))
#define DI __device__ __forceinline__
typedef unsigned short bf16;
typedef unsigned u32x4 __attribute__((ext_vector_type(4)));
typedef unsigned u32x2 __attribute__((ext_vector_type(2)));
typedef float f32x4 __attribute__((ext_vector_type(4)));
typedef float f32x2 __attribute__((ext_vector_type(2)));
typedef float f32x16 __attribute__((ext_vector_type(16)));
typedef short bf16x8 __attribute__((ext_vector_type(8)));
typedef short s16x4 __attribute__((ext_vector_type(4)));
typedef __bf16 bf16x2_t __attribute__((ext_vector_type(2)));

constexpr int DM = 1024, SEQ = 16384, NSB = 16, NST = 32, PAST = 4096, NMEM = 256;
constexpr int MROWS = SEQ + NSB * NST;
constexpr int SKEYS = PAST + NST;
constexpr int MKROWS = SEQ + NSB * SKEYS;
constexpr int INWP = 2816, NING = INWP + 3072;
constexpr int DFF = 4096;
constexpr float EPSN = 1e-6f;
constexpr float LOG2E = 1.4426950408889634f;
constexpr float C_MLA = 0.10206207261596575f * LOG2E;
constexpr float C_DIFF = 0.17677669529663687f * LOG2E;
constexpr float C_MEM = 0.08838834764831845f * LOG2E;
constexpr float LAM_INIT = 0.2f;

constexpr size_t O_Y = 0;
constexpr size_t O_PCKV = (size_t)MROWS * DM;
constexpr size_t O_PKR = O_PCKV + (size_t)SEQ * 256;
constexpr size_t O_PDK = O_PKR + (size_t)SEQ * 32;
constexpr size_t O_PDV = O_PDK + (size_t)SEQ * 512;
constexpr size_t O_PMK = O_PDV + (size_t)SEQ * 512;
constexpr size_t O_PMV = O_PMK + (size_t)NMEM * 512;
constexpr size_t O_SCKV = O_PMV + (size_t)NMEM * 512;
constexpr size_t O_SKR = O_SCKV + (size_t)512 * 256;
constexpr size_t O_SDK = O_SKR + (size_t)512 * 32;
constexpr size_t O_SDV = O_SDK + (size_t)512 * 512;
constexpr size_t O_END = O_SDV + (size_t)512 * 512;

constexpr size_t MiB = 1u << 20;
constexpr size_t WS_TABM = 1 * MiB;
constexpr size_t WS_TABD = 3 * MiB;
constexpr size_t WS_W = 4 * MiB;
constexpr size_t W_ING = WS_W;
constexpr size_t W_UQ = W_ING + (size_t)NING * 1024 * 2;
constexpr size_t W_UKV = W_UQ + (size_t)768 * 384 * 2;
constexpr size_t W_MEM = W_UKV + (size_t)1024 * 256 * 2;
constexpr size_t W_OM = W_MEM + (size_t)1024 * 1024 * 2;
constexpr size_t W_OUT = W_OM + (size_t)3 * 1024 * 512 * 2;
constexpr size_t W_UP = W_OUT + (size_t)1024 * 1024 * 2;
constexpr size_t W_DN = W_UP + (size_t)4096 * 1024 * 2;
constexpr size_t W_END = W_DN + (size_t)1024 * 4096 * 2;
static_assert(W_END <= 44 * MiB, "weights");
constexpr size_t WS_G = 44 * MiB;
constexpr size_t WS_MIX = 44 * MiB;
constexpr size_t WS_DQ = 148 * MiB;
constexpr size_t WS_MQ = 165 * MiB;
constexpr size_t WS_QM = 182 * MiB;
constexpr size_t WS_DKP = 208 * MiB;
constexpr size_t WS_DVP = 225 * MiB;
constexpr size_t WS_KR = 242 * MiB;
constexpr size_t WS_MK = 248 * MiB;
constexpr size_t WS_MV = 253 * MiB;
constexpr size_t WS_LAT = 258 * MiB;
constexpr size_t WS_CQN = 299 * MiB;
constexpr size_t WS_OA = 258 * MiB;
constexpr size_t WS_XN = 312 * MiB;
constexpr size_t WS_CQ = 346 * MiB;
constexpr size_t WS_KN = 312 * MiB;
constexpr size_t WS_VM = 393 * MiB;
constexpr size_t WS_MRG = 348 * MiB;
constexpr size_t WS_MRGB = 416 * MiB;
constexpr size_t WS_U = 348 * MiB;
constexpr size_t WS_END = 480 * MiB;
static_assert(WS_KR + (size_t)MKROWS * 32 * 2 <= WS_MK && WS_LAT + (size_t)MKROWS * 256 * 2 <= WS_CQN && WS_CQN + (size_t)MROWS * 384 * 2 <= WS_XN, "ws map 1");
static_assert(WS_OA + (size_t)3 * MROWS * 512 * 2 <= WS_XN && WS_XN + (size_t)MROWS * 1024 * 2 <= WS_CQ && WS_KN + (size_t)MKROWS * 512 * 2 <= WS_VM, "ws map 2");
static_assert(WS_VM + (size_t)MKROWS * 512 * 2 <= WS_END && WS_MRG + (size_t)MROWS * 1024 * 4 <= WS_MRGB && WS_U + (size_t)MROWS * 4096 * 2 <= WS_END, "ws map 3");
static_assert(WS_G + (size_t)MROWS * 3072 * 2 <= WS_DQ && WS_QM + (size_t)MROWS * 768 * 2 <= WS_DKP && WS_MK + (size_t)17 * 256 * 512 * 2 <= WS_MV && WS_MV + (size_t)17 * 256 * 512 * 2 <= WS_LAT, "ws map 4");

DI unsigned pk2(float lo, float hi) { f32x2 v = {lo, hi}; bf16x2_t b = __builtin_convertvector(v, bf16x2_t); return __builtin_bit_cast(unsigned, b); }
DI u32x4 pk8(f32x4 a, f32x4 b) { u32x4 w; w.x = pk2(a[0], a[1]); w.y = pk2(a[2], a[3]); w.z = pk2(b[0], b[1]); w.w = pk2(b[2], b[3]); return w; }
DI float bf_lo(unsigned u) { return __uint_as_float(u << 16); }
DI float bf_hi(unsigned u) { return __uint_as_float(u & 0xffff0000u); }
DI float wave_sum(float v) {
#pragma unroll
    for (int o = 1; o < 64; o <<= 1) v += __shfl_xor(v, o);
    return v;
}
DI int row_pos(int row) { return row < SEQ ? row : PAST + ((row - SEQ) & 31); }
DI int row_krow(int row) { if (row < SEQ) return row; const int rs = row - SEQ; return SEQ + (rs >> 5) * SKEYS + PAST + (rs & 31); }
DI float* out_row(float* out, int row, size_t offP, size_t offS, int W) { return row < SEQ ? out + offP + (size_t)row * W : out + offS + (size_t)(row - SEQ) * W; }

#define EPI_ROWS_BEGIN _Pragma("unroll") for (int ai = 0; ai < 2; ++ai) _Pragma("unroll") for (int m = 0; m < 4; ++m) { int row = row0 + ai * 128 + m * 16; asm volatile("" : "+v"(row)); f32x4 v0 = acc[ai][bj][m][0], v1 = acc[ai][bj][m][1];
#define EPI_ROWS_END asm volatile("" ::: "memory"); }

#ifndef TST_GATE
#define TST_GATE 1
#endif
#ifndef TST_KR
#define TST_KR 1
#endif
#ifndef TST_DQ
#define TST_DQ 1
#endif
struct EpiP1 {
    static constexpr bool PERM = true, AFTER_DRAIN = false;
    bf16* CQ; bf16* KR; bf16* DQ; bf16* DKP; bf16* DVP; bf16* MQ; bf16* G; float* out; const float* bgate; const float* tabm; const float* tabd;
    DI void operator()(const f32x4 (&acc)[2][2][4][2], const pg8::Unit& u, int wr, int wc, int fr, int fq) const {
        const int row0 = u.pm * 256 + wr * 64 + fr;
#pragma unroll
        for (int bj = 0; bj < 2; ++bj) {
            const int cgp = u.pn * 256 + bj * 128 + wc * 32;
            const int c = cgp + 8 * fq;
            if (TST_GATE && cgp >= INWP) {
                const int gc = c - INWP;
                EPI_ROWS_BEGIN
                    v0 += *(const f32x4*)(bgate + gc); v1 += *(const f32x4*)(bgate + gc + 4);
#pragma unroll
                    for (int e = 0; e < 4; ++e) { v0[e] = 1.f / (1.f + __expf(-v0[e])); v1[e] = 1.f / (1.f + __expf(-v1[e])); }
                    *(u32x4*)(G + (size_t)row * 3072 + gc) = pk8(v0, v1);
                EPI_ROWS_END
            } else if (cgp < 384) {
                EPI_ROWS_BEGIN
                    *(u32x4*)(CQ + (size_t)row * 384 + c) = pk8(v0, v1);
                EPI_ROWS_END
            } else if (cgp < 640) {
                EPI_ROWS_BEGIN
                    float* p = out_row(out, row, O_PCKV, O_SCKV, 256) + (c - 384);
                    *(f32x4*)p = v0; *(f32x4*)(p + 4) = v1;
                EPI_ROWS_END
            } else if (TST_KR && cgp < 672) {
                EPI_ROWS_BEGIN
                    const float* tb = tabm + (size_t)row_pos(row) * 32 + 8 * (fq & 1);
                    float* p = out_row(out, row, O_PKR, O_SKR, 32) + (c - 640);
                    const float sg = fq < 2 ? -1.f : 1.f;
                    f32x4 pv;
#pragma unroll
                    for (int e = 0; e < 4; ++e) pv[e] = __shfl_xor(v0[e], 32);
                    const f32x4 o0 = v0 * *(const f32x4*)tb + pv * (*(const f32x4*)(tb + 16) * sg);
                    asm volatile("" ::: "memory");
#pragma unroll
                    for (int e = 0; e < 4; ++e) pv[e] = __shfl_xor(v1[e], 32);
                    const f32x4 o1 = v1 * *(const f32x4*)(tb + 4) + pv * (*(const f32x4*)(tb + 20) * sg);
                    *(f32x4*)p = o0; *(f32x4*)(p + 4) = o1;
                    *(u32x4*)(KR + (size_t)row_krow(row) * 32 + (c - 640)) = pk8(o0, o1);
                EPI_ROWS_END
            } else if (TST_DQ && cgp < 1696) {
                const bool isq = cgp < 1184;
                EPI_ROWS_BEGIN
                    if (fq == 0) {
                        const float* tb = tabd + (size_t)row_pos(row) * 8;
                        const f32x4 cc = *(const f32x4*)tb, ss = *(const f32x4*)(tb + 4);
                        const f32x4 n0 = v0 * cc - v1 * ss, n1 = v1 * cc + v0 * ss; v0 = n0; v1 = n1;
                    }
                    if (isq) { v0 *= C_DIFF; v1 *= C_DIFF; *(u32x4*)(DQ + (size_t)row * 512 + (c - 672)) = pk8(v0, v1); }
                    else {
                        float* p = out_row(out, row, O_PDK, O_SDK, 512) + (c - 1184);
                        *(f32x4*)p = v0; *(f32x4*)(p + 4) = v1;
                        if (row < SEQ) *(u32x4*)(DKP + (size_t)row * 512 + (c - 1184)) = pk8(v0, v1);
                    }
                EPI_ROWS_END
            } else if (cgp < 2208) {
                EPI_ROWS_BEGIN
                    float* p = out_row(out, row, O_PDV, O_SDV, 512) + (c - 1696);
                    *(f32x4*)p = v0; *(f32x4*)(p + 4) = v1;
                    if (row < SEQ) *(u32x4*)(DVP + (size_t)row * 512 + (c - 1696)) = pk8(v0, v1);
                EPI_ROWS_END
            } else if (cgp < 2720) {
                EPI_ROWS_BEGIN
                    v0 *= C_MEM; v1 *= C_MEM;
                    *(u32x4*)(MQ + (size_t)row * 512 + (c - 2208)) = pk8(v0, v1);
                EPI_ROWS_END
            }
        }
    }
};

struct EpiMemKV {
    static constexpr bool PERM = true, AFTER_DRAIN = false;
    float* out; bf16* MK; bf16* MV;
    DI void operator()(const f32x4 (&acc)[2][2][4][2], const pg8::Unit& u, int wr, int wc, int fr, int fq) const {
        const int row0 = u.pm * 256 + wr * 64 + fr;
#pragma unroll
        for (int bj = 0; bj < 2; ++bj) {
            const int c = u.pn * 256 + bj * 128 + wc * 32 + 8 * fq;
            const bool isk = c < 512; const int cc = isk ? c : c - 512;
            float* ob = out + (isk ? O_PMK : O_PMV); bf16* bb = isk ? MK : MV;
            EPI_ROWS_BEGIN
                float* p = ob + (size_t)row * 512 + cc; *(f32x4*)p = v0; *(f32x4*)(p + 4) = v1;
                *(u32x4*)(bb + (size_t)row * 512 + cc) = pk8(v0, v1);
            EPI_ROWS_END
        }
    }
};

struct EpiUQ {
    static constexpr bool PERM = true, AFTER_DRAIN = false;
    bf16* QM; const float* tabm;
    DI void operator()(const f32x4 (&acc)[2][2][4][2], const pg8::Unit& u, int wr, int wc, int fr, int fq) const {
        const int row0 = u.pm * 256 + wr * 64 + fr;
#pragma unroll
        for (int bj = 0; bj < 2; ++bj) {
            const int cgp = u.pn * 256 + bj * 128 + wc * 32; const int c = cgp + 8 * fq;
            const bool isrope = ((cgp >> 5) % 3) == 2;
            if (isrope) {
                EPI_ROWS_BEGIN
                    f32x4 p0, p1;
#pragma unroll
                    for (int e = 0; e < 4; ++e) { p0[e] = __shfl_xor(v0[e], 32); p1[e] = __shfl_xor(v1[e], 32); }
                    const float* tb = tabm + (size_t)row_pos(row) * 32 + 8 * (fq & 1);
                    const f32x4 c0 = *(const f32x4*)tb, c1 = *(const f32x4*)(tb + 4), s0 = *(const f32x4*)(tb + 16), s1 = *(const f32x4*)(tb + 20);
                    f32x4 o0, o1;
                    if (fq < 2) { o0 = v0 * c0 - p0 * s0; o1 = v1 * c1 - p1 * s1; } else { o0 = v0 * c0 + p0 * s0; o1 = v1 * c1 + p1 * s1; }
                    o0 *= C_MLA; o1 *= C_MLA;
                    *(u32x4*)(QM + (size_t)row * 768 + c) = pk8(o0, o1);
                    asm volatile("" ::: "memory");
                EPI_ROWS_END
            } else {
                EPI_ROWS_BEGIN
                    v0 *= C_MLA; v1 *= C_MLA;
                    *(u32x4*)(QM + (size_t)row * 768 + c) = pk8(v0, v1);
                EPI_ROWS_END
            }
        }
    }
};

struct EpiBf16Split {
    static constexpr bool PERM = true, AFTER_DRAIN = false;
    bf16* A; bf16* B;
    DI void operator()(const f32x4 (&acc)[2][2][4][2], const pg8::Unit& u, int wr, int wc, int fr, int fq) const {
        const int row0 = u.pm * 256 + wr * 64 + fr;
#pragma unroll
        for (int bj = 0; bj < 2; ++bj) {
            const int c = u.pn * 256 + bj * 128 + wc * 32 + 8 * fq;
            bf16* bb = c < 512 ? A + c : B + (c - 512);
            EPI_ROWS_BEGIN
                *(u32x4*)(bb + (size_t)row * 512) = pk8(v0, v1);
            EPI_ROWS_END
        }
    }
};

template <int BR> struct EpiMerge {
    static constexpr bool PERM = true, AFTER_DRAIN = false;
    const bf16* G; float* MRG; bf16* MRGB;
    DI void operator()(const f32x4 (&acc)[2][2][4][2], const pg8::Unit& u, int wr, int wc, int fr, int fq) const {
        const int row0 = u.pm * 256 + wr * 64 + fr;
#pragma unroll
        for (int bj = 0; bj < 2; ++bj) {
            const int c = u.pn * 256 + bj * 128 + wc * 32 + 8 * fq;
            EPI_ROWS_BEGIN
                const u32x4 g = *(const u32x4*)(G + (size_t)row * 3072 + BR * 1024 + c);
                const f32x4 g0 = {bf_lo(g.x), bf_hi(g.x), bf_lo(g.y), bf_hi(g.y)}, g1 = {bf_lo(g.z), bf_hi(g.z), bf_lo(g.w), bf_hi(g.w)};
                v0 *= g0; v1 *= g1;
                float* p = MRG + (size_t)row * 1024 + c;
                if (BR > 0) { v0 += *(const f32x4*)p; v1 += *(const f32x4*)(p + 4); }
                if (BR < 2) { *(f32x4*)p = v0; *(f32x4*)(p + 4) = v1; }
                else *(u32x4*)(MRGB + (size_t)row * 1024 + c) = pk8(v0, v1);
            EPI_ROWS_END
        }
    }
};

struct EpiF32 {
    static constexpr bool PERM = true, AFTER_DRAIN = false;
    float* O; int ldc;
    DI void operator()(const f32x4 (&acc)[2][2][4][2], const pg8::Unit& u, int wr, int wc, int fr, int fq) const {
        const int row0 = u.pm * 256 + wr * 64 + fr;
#pragma unroll
        for (int bj = 0; bj < 2; ++bj) {
            const int c = u.pn * 256 + bj * 128 + wc * 32 + 8 * fq;
            EPI_ROWS_BEGIN
                float* p = O + (size_t)row * ldc + c; *(f32x4*)p = v0; *(f32x4*)(p + 4) = v1;
            EPI_ROWS_END
        }
    }
};

struct EpiUp {
    static constexpr bool PERM = true, AFTER_DRAIN = false;
    bf16* U;
    DI void operator()(const f32x4 (&acc)[2][2][4][2], const pg8::Unit& u, int wr, int wc, int fr, int fq) const {
        const int row0 = u.pm * 256 + wr * 64 + fr;
#pragma unroll
        for (int bj = 0; bj < 2; ++bj) {
            const int c = u.pn * 256 + bj * 128 + wc * 32 + 8 * fq;
            EPI_ROWS_BEGIN
#pragma unroll
                for (int e = 0; e < 4; ++e) { const float a = fmaxf(v0[e], 0.f), b = fmaxf(v1[e], 0.f); v0[e] = a * a; v1[e] = b * b; }
                *(u32x4*)(U + (size_t)row * DFF + c) = pk8(v0, v1);
            EPI_ROWS_END
        }
    }
};

struct Chunk { u32x4 a, b; };
template <bool F32> DI void ld_chunk(Chunk& c, const void* base, size_t eoff, bool valid) {
    c.a = (u32x4){0u, 0u, 0u, 0u}; c.b = (u32x4){0u, 0u, 0u, 0u};
    if (valid) {
        if (F32) { const __attribute__((address_space(1))) float* p = (const __attribute__((address_space(1))) float*)base + eoff; c.a = *(const __attribute__((address_space(1))) u32x4*)p; c.b = *(const __attribute__((address_space(1))) u32x4*)(p + 4); }
        else { c.a = *(const __attribute__((address_space(1))) u32x4*)((const __attribute__((address_space(1))) bf16*)base + eoff); }
    }
}
#define GASP __attribute__((address_space(1)))
template <bool F32> DI void ld_chunk2(Chunk& c, const GASP unsigned char* p, bool valid) {
    c.a = (u32x4){0u, 0u, 0u, 0u}; c.b = (u32x4){0u, 0u, 0u, 0u};
    if (valid) { c.a = *(const GASP u32x4*)p; if (F32) c.b = *(const GASP u32x4*)(p + 16); }
}
template <bool F32> DI u32x4 cvt_chunk(const Chunk& c) {
    if (!F32) return c.a;
    u32x4 w;
    w.x = pk2(__uint_as_float(c.a.x), __uint_as_float(c.a.y)); w.y = pk2(__uint_as_float(c.a.z), __uint_as_float(c.a.w));
    w.z = pk2(__uint_as_float(c.b.x), __uint_as_float(c.b.y)); w.w = pk2(__uint_as_float(c.b.z), __uint_as_float(c.b.w));
    return w;
}
typedef short v4i16_t __attribute__((ext_vector_type(4)));
DI s16x4 vtr(const LAS unsigned char* p) { return __builtin_bit_cast(s16x4, __builtin_amdgcn_ds_read_tr16_b64_v4i16((LAS v4i16_t*)p)); }
DI bf16x8 pack8(const f32x16& s, int b) {
    u32x4 w; w.x = pk2(s[b], s[b + 1]); w.y = pk2(s[b + 2], s[b + 3]); w.z = pk2(s[b + 4], s[b + 5]); w.w = pk2(s[b + 6], s[b + 7]);
    return __builtin_bit_cast(bf16x8, w);
}

struct AU {
    const bf16* Q; int ldq; int qrow0; int nq;
    const void* Ka; const void* Kb; int ldk; int nsplit;
    const bf16* Kr; int ldkr;
    const void* Va; const void* Vb; int ldv;
    int nkeys; int limbase;
    bf16* O; int ldo;
    float lam; const float* subg;
};

template <int MODE, bool F32>
DI void attn_unit(LAS unsigned char* lds, const AU& a, const int tid_in) {
    int tid = tid_in; asm volatile("" : "+v"(tid));
    constexpr int NS = (MODE == 1) ? 2 : 1;
    constexpr int DQK = (MODE == 0) ? 96 : (MODE == 1 ? 64 : 128);
    constexpr int DV = (MODE == 2) ? 128 : 64;
    constexpr int NKS = DQK / 16, NDB = DV / 32;
    constexpr int KSTR = DQK * 2 + 16, VSTR = DV * 2 + 16, KBY = 64 * KSTR, VBY = 64 * VSTR;
    constexpr int KC = (MODE == 0) ? 64 : DQK, KCH = KC / 8, NKJ = KC / 64, VCH = DV / 8, NVJ = DV / 64;
    constexpr bool PREF = (MODE != 2);
    constexpr int NDH = 1;
    constexpr bool PVA = (MODE != 1);
    constexpr float THR = 8.f;
    const int lane = tid & 63, wave = __builtin_amdgcn_readfirstlane(tid >> 6), r = lane & 31, h = lane >> 5;
    const int NT = (a.nkeys + 63) >> 6;
    int lim = a.limbase + (wave >> 1); if (lim > NT - 1) lim = NT - 1;
    const bool active = wave * 32 < a.nq;
    const int ntw = active ? lim + 1 : 0;
    const bool late = wave >= 4;
    bf16x8 qf[NKS];
#pragma unroll
    for (int s = 0; s < NKS; ++s) {
        qf[s] = (bf16x8){0, 0, 0, 0, 0, 0, 0, 0};
        if (active) qf[s] = *(const bf16x8*)(a.Q + (size_t)(a.qrow0 + wave * 32 + r) * a.ldq + 16 * s + 8 * h);
    }
    float mrun[NS], lrun[NS]; f32x16 o[NS][NDB]; f32x16 sA, sB; bf16x8 pf[NS][2][2];
#pragma unroll
    for (int c = 0; c < NS; ++c) { mrun[c] = -1e30f; lrun[c] = 0.f;
#pragma unroll
        for (int i = 0; i < 16; ++i) { sA[i] = 0.f; sB[i] = 0.f; }
#pragma unroll
        for (int x = 0; x < 4; ++x) pf[c][x >> 1][x & 1] = (bf16x8){0, 0, 0, 0, 0, 0, 0, 0};
#pragma unroll
        for (int d = 0; d < NDB; ++d)
#pragma unroll
            for (int i = 0; i < 16; ++i) o[c][d][i] = 0.f; }
    Chunk ck[NKJ], cr, cv[NVJ];
    constexpr int ESZ = F32 ? 4 : 2;
    int koff_[NKJ], krw_[NKJ], voff_[NVJ], vrw_[NVJ];
#pragma unroll
    for (int j = 0; j < NKJ; ++j) { const int q_ = tid + 512 * j; krw_[j] = q_ / KCH; koff_[j] = (krw_[j] * 512 + (q_ % KCH) * 8) * ESZ; }
#pragma unroll
    for (int j = 0; j < NVJ; ++j) { const int q_ = tid + 512 * j; vrw_[j] = q_ / VCH; voff_[j] = (vrw_[j] * 512 + (q_ % VCH) * 8) * ESZ; }
    cr.a = (u32x4){0u, 0u, 0u, 0u}; cr.b = cr.a;
    const int qq = (lane & 15) >> 2, pp = lane & 3, blk = (lane >> 4) & 1;
    const int kroff = r * KSTR + h * 16, vroff = (4 * h + qq) * VSTR + (16 * blk + 4 * pp) * 2;
#define AT_LOAD(t) do { const int kv0_ = (t) * 64; const bool fs_ = kv0_ < a.nsplit; const size_t tb_ = (size_t)(fs_ ? kv0_ : kv0_ - a.nsplit) * 512; \
        const GASP unsigned char* kbs_ = (const GASP unsigned char*)(fs_ ? a.Ka : a.Kb) + tb_ * ESZ; const GASP unsigned char* vbs_ = (const GASP unsigned char*)(fs_ ? a.Va : a.Vb) + tb_ * ESZ; \
        _Pragma("unroll") for (int j = 0; j < NKJ; ++j) ld_chunk2<F32>(ck[j], kbs_ + koff_[j], kv0_ + krw_[j] < a.nkeys); \
        if (MODE == 0) { if (tid < 256) ld_chunk2<false>(cr, (const GASP unsigned char*)a.Kr + (size_t)kv0_ * 64 + (size_t)((tid >> 2) * 64 + (tid & 3) * 16), kv0_ + (tid >> 2) < a.nkeys); } \
        _Pragma("unroll") for (int j = 0; j < NVJ; ++j) ld_chunk2<F32>(cv[j], vbs_ + voff_[j], kv0_ + vrw_[j] < a.nkeys); } while (0)
#define AT_COMMIT(t) do { LAS unsigned char* kb_ = lds + ((t) % 3) * KBY; LAS unsigned char* vb_ = lds + 3 * KBY + ((t) & 3) * VBY; \
        _Pragma("unroll") for (int j = 0; j < NKJ; ++j) { const int q_ = tid + 512 * j, rw_ = q_ / KCH, ch_ = q_ % KCH; *(LAS u32x4*)(kb_ + rw_ * KSTR + ch_ * 16) = cvt_chunk<F32>(ck[j]); } \
        if (MODE == 0) { if (tid < 256) { const int rw_ = tid >> 2, ch_ = tid & 3; *(LAS u32x4*)(kb_ + rw_ * KSTR + 128 + ch_ * 16) = cr.a; } } \
        _Pragma("unroll") for (int j = 0; j < NVJ; ++j) { const int q_ = tid + 512 * j, rw_ = q_ / VCH, ch_ = q_ % VCH; *(LAS u32x4*)(vb_ + rw_ * VSTR + ch_ * 16) = cvt_chunk<F32>(cv[j]); } } while (0)
#define AT_QKC(tt, c) do { const LAS unsigned char* kp_ = lds + (((tt) % 3) * KBY + kroff); const bool halft_ = (a.nkeys - (tt) * 64) <= 32; \
        f32x16 s0_, s1_; \
        _Pragma("unroll") for (int i = 0; i < 16; ++i) { s0_[i] = 0.f; s1_[i] = 0.f; } \
        constexpr int KSN_ = (MODE == 1) ? 2 : NKS; constexpr int KBT_ = (KSN_ > 4) ? ((KSN_ % 4 == 0) ? 4 : 3) : KSN_; \
        _Pragma("unroll") for (int kb0 = 0; kb0 < KSN_; kb0 += KBT_) { \
            bf16x8 kf_[2 * KBT_]; \
            _Pragma("unroll") for (int ks = 0; ks < KBT_; ++ks) { const int kk = ((MODE == 1) ? 2 * (c) : 0) + kb0 + ks; \
                kf_[2 * ks] = *(const LAS bf16x8*)(kp_ + kk * 32); kf_[2 * ks + 1] = *(const LAS bf16x8*)(kp_ + 32 * KSTR + kk * 32); } \
            __builtin_amdgcn_sched_barrier(0); \
            _Pragma("unroll") for (int ks = 0; ks < KBT_; ++ks) { const int kk = ((MODE == 1) ? 2 * (c) : 0) + kb0 + ks; \
                s0_ = __builtin_amdgcn_mfma_f32_32x32x16_bf16(kf_[2 * ks], qf[kk], s0_, 0, 0, 0); \
                s1_ = __builtin_amdgcn_mfma_f32_32x32x16_bf16(kf_[2 * ks + 1], qf[kk], s1_, 0, 0, 0); } \
            __builtin_amdgcn_sched_barrier(0); } \
        if (halft_) { _Pragma("unroll") for (int i = 0; i < 16; ++i) s1_[i] = -1e30f; } \
        sA = s0_; sB = s1_; } while (0)
#define AT_SM(c) do { \
        float mx = fmaxf(sA[0], sB[0]); \
        _Pragma("unroll") for (int i = 1; i < 16; ++i) mx = fmaxf(fmaxf(sA[i], sB[i]), mx); \
        mx = fmaxf(mx, __shfl_xor(mx, 32)); \
        if (__any(mx > mrun[c] + THR)) { \
            const float mn = fmaxf(mrun[c], mx); const float al = __builtin_amdgcn_exp2f(mrun[c] - mn); mrun[c] = mn; lrun[c] *= al; \
            _Pragma("unroll") for (int d = 0; d < NDB; ++d) _Pragma("unroll") for (int i = 0; i < 16; ++i) o[c][d][i] *= al; } \
        const float mm = mrun[c]; float ps = 0.f; \
        _Pragma("unroll") for (int i = 0; i < 16; ++i) { sA[i] = __builtin_amdgcn_exp2f(sA[i] - mm); sB[i] = __builtin_amdgcn_exp2f(sB[i] - mm); ps += sA[i] + sB[i]; } \
        lrun[c] += ps; \
        pf[c][0][0] = pack8(sA, 0); pf[c][0][1] = pack8(sA, 8); pf[c][1][0] = pack8(sB, 0); pf[c][1][1] = pack8(sB, 8); } while (0)
#define AT_VRD(tt, d0) do { const LAS unsigned char* vp0_ = lds + (3 * KBY + ((tt) & 3) * VBY + vroff); \
        _Pragma("unroll") for (int dd = 0; dd < NDH; ++dd) _Pragma("unroll") for (int kb = 0; kb < 2; ++kb) _Pragma("unroll") for (int sp = 0; sp < 2; ++sp) { \
            const LAS unsigned char* vp = vp0_ + ((kb * 32 + sp * 16) * VSTR + ((d0) + dd) * 64); \
            vlo_[dd * 4 + kb * 2 + sp] = vtr(vp); vhi_[dd * 4 + kb * 2 + sp] = vtr(vp + 8 * VSTR); } } while (0)
#define AT_PVM(d0) do { _Pragma("unroll") for (int dd = 0; dd < NDH; ++dd) _Pragma("unroll") for (int kb = 0; kb < 2; ++kb) _Pragma("unroll") for (int sp = 0; sp < 2; ++sp) { \
            const s16x4 lo = vlo_[dd * 4 + kb * 2 + sp], hi = vhi_[dd * 4 + kb * 2 + sp]; \
            const bf16x8 vf = (bf16x8){lo[0], lo[1], lo[2], lo[3], hi[0], hi[1], hi[2], hi[3]}; \
            _Pragma("unroll") for (int c = 0; c < NS; ++c) o[c][(d0) + dd] = __builtin_amdgcn_mfma_f32_32x32x16_bf16(vf, pf[c][kb][sp], o[c][(d0) + dd], 0, 0, 0); } } while (0)
#define AT_PHA(tt) do { AT_QKC(tt, 0); if (MODE == 1) { AT_SM(0); } } while (0)
#define AT_PHB(tt) do { s16x4 vlo_[NDH * 4], vhi_[NDH * 4]; \
        AT_VRD(tt, 0); \
        __builtin_amdgcn_sched_barrier(0); \
        if (MODE == 1) { AT_QKC(tt, 1); AT_SM(NS - 1); } else { AT_SM(0); } \
        __builtin_amdgcn_sched_barrier(0); \
        AT_PVM(0); \
        _Pragma("unroll") for (int d0 = NDH; d0 < NDB; d0 += NDH) { __builtin_amdgcn_sched_barrier(0); AT_VRD(tt, d0); __builtin_amdgcn_sched_barrier(0); AT_PVM(d0); } } while (0)
#define AT_BAR() asm volatile("s_waitcnt lgkmcnt(0)\n\ts_barrier" ::: "memory")
    AT_LOAD(0); AT_COMMIT(0);
    if (NT > 1) { AT_LOAD(1); AT_COMMIT(1); }
    AT_BAR();
    if (late) AT_BAR();
    for (int t = 0; t < NT; ++t) {
        if (PREF && t + 2 < NT) AT_LOAD(t + 2);
        if (PVA) {
            const bool pvok = t >= 1 && t - 1 < ntw;
            s16x4 vlo_[NDH * 4], vhi_[NDH * 4];
            if (pvok) AT_VRD(t - 1, 0);
            __builtin_amdgcn_sched_barrier(0);
            if (t < ntw) AT_QKC(t, 0);
            if (pvok) { AT_PVM(0);
#pragma unroll
                for (int d0 = NDH; d0 < NDB; d0 += NDH) { __builtin_amdgcn_sched_barrier(0); AT_VRD(t - 1, d0); __builtin_amdgcn_sched_barrier(0); AT_PVM(d0); } }
        } else { if (t < ntw) AT_PHA(t); }
        AT_BAR();
        if (t < ntw) { if (PVA) { AT_SM(0); } else { AT_PHB(t); } }
        if (t + 2 < NT) { if (!PREF) AT_LOAD(t + 2); AT_COMMIT(t + 2); }
        AT_BAR();
    }
    if (PVA && ntw == NT && ntw > 0) {
        s16x4 vlo_[NDH * 4], vhi_[NDH * 4];
#pragma unroll
        for (int d0 = 0; d0 < NDB; d0 += NDH) { AT_VRD(NT - 1, d0); __builtin_amdgcn_sched_barrier(0); AT_PVM(d0); __builtin_amdgcn_sched_barrier(0); }
    }
    if (!late) AT_BAR();
    AT_BAR();
#undef AT_LOAD
#undef AT_COMMIT
#undef AT_QKC
#undef AT_SM
#undef AT_PHA
#undef AT_PHB
#undef AT_VRD
#undef AT_PVM
#undef AT_BAR
    if (active) {
        const int qi = wave * 32 + r;
        float inv[NS];
#pragma unroll
        for (int c = 0; c < NS; ++c) { const float lt = lrun[c] + __shfl_xor(lrun[c], 32); inv[c] = 1.f / lt; }
        float rs = 1.f;
        if (MODE == 1) {
            float ss = 0.f;
#pragma unroll
            for (int d = 0; d < NDB; ++d)
#pragma unroll
                for (int i = 0; i < 16; ++i) { const float v = o[0][d][i] * inv[0] - a.lam * (o[NS - 1][d][i] * inv[NS - 1]); o[0][d][i] = v; ss += v * v; }
            ss += __shfl_xor(ss, 32);
            rs = rsqrtf(ss * (1.f / 64.f) + EPSN) * (1.f - LAM_INIT);
        } else rs = inv[0];
        bf16* op = a.O + (size_t)(a.qrow0 + qi) * 512;
#pragma unroll
        for (int d = 0; d < NDB; ++d)
#pragma unroll
            for (int g4 = 0; g4 < 4; ++g4) {
                const int dc = d * 32 + 8 * g4 + 4 * h;
                float w0 = o[0][d][4 * g4] * rs, w1 = o[0][d][4 * g4 + 1] * rs, w2 = o[0][d][4 * g4 + 2] * rs, w3 = o[0][d][4 * g4 + 3] * rs;
                if (MODE == 1) { const f32x4 gg = *(const f32x4*)(a.subg + dc); w0 *= gg[0]; w1 *= gg[1]; w2 *= gg[2]; w3 *= gg[3]; }
                u32x2 w; w.x = pk2(w0, w1); w.y = pk2(w2, w3);
                if (qi < a.nq) *(u32x2*)(op + dc) = w;
            }
    }
}

DI void p0_transpose_item(const float* W, int K, int N, bf16* WT, int row_off, LAS float* scr, int item, int lane) {
    const int nblk = N / 32, kb = item / nblk, nb = item % nblk, k0 = 64 * kb, n0 = 32 * nb;
#pragma unroll 8
    for (int i = 0; i < 32; ++i) { const int kk = 2 * i + (lane >> 5); scr[kk * 33 + (lane & 31)] = W[(size_t)(k0 + kk) * N + n0 + (lane & 31)]; }
    asm volatile("s_waitcnt lgkmcnt(0)" ::: "memory");
    const int c = lane & 7;
#pragma unroll
    for (int j = 0; j < 4; ++j) { const int n = (lane >> 3) + 8 * j; const LAS float* s = scr + (8 * c) * 33 + n;
        u32x4 o; o.x = pk2(s[0 * 33], s[1 * 33]); o.y = pk2(s[2 * 33], s[3 * 33]); o.z = pk2(s[4 * 33], s[5 * 33]); o.w = pk2(s[6 * 33], s[7 * 33]);
        *(u32x4*)(WT + (size_t)(row_off + n0 + n) * K + k0 + 8 * c) = o; }
    asm volatile("s_waitcnt lgkmcnt(0)" ::: "memory");
}
DI void rms_row_1024(const float* xrow, const float* g, bf16* orow, int lane) {
    const f32x4* xr = (const f32x4*)xrow + lane; const f32x4* gr = (const f32x4*)g + lane;
    f32x4 v[4]; float s = 0.f;
#pragma unroll
    for (int j = 0; j < 4; ++j) { v[j] = xr[64 * j]; s += (v[j].x * v[j].x + v[j].y * v[j].y) + (v[j].z * v[j].z + v[j].w * v[j].w); }
    const float rstd = rsqrtf(wave_sum(s) * (1.f / 1024.f) + EPSN);
    u32x2* o8 = (u32x2*)orow + lane;
#pragma unroll
    for (int j = 0; j < 4; ++j) { const f32x4 gg = gr[64 * j]; u32x2 w; w.x = pk2(v[j].x * rstd * gg.x, v[j].y * rstd * gg.y); w.y = pk2(v[j].z * rstd * gg.z, v[j].w * rstd * gg.w); o8[64 * j] = w; }
}


template <int K> DI const float* inp_ld() {
    auto kp = __builtin_amdgcn_kernarg_segment_ptr();
    unsigned long long v;
    asm volatile("s_load_dwordx2 %0, %1, %2\n\ts_waitcnt lgkmcnt(0)" : "=s"(v) : "s"(kp), "n"(K * 8));
    return (const float*)(const __attribute__((address_space(1))) float*)v;
}
#define INP(k) inp_ld<k>()


#define RLX_AGENT __ATOMIC_RELAXED, __HIP_MEMORY_SCOPE_AGENT
#define XB_TMO      128
#define XB_XCNT(j)  (256  + 64 * (j))
#define XB_XSUB(j)  (1280 + 64 * (j))
#define XB_XGEN(j)  (2304 + 64 * (j))
#define XB_TOP      3328
#define XB_TOPGEN   3392
#define XCD_BAR_WORDS 3456
#define XB_SPIN_CAP (1u << 18)

__device__ __forceinline__ unsigned xb_ld(unsigned* p)              { return __hip_atomic_load(p, __ATOMIC_RELAXED, __HIP_MEMORY_SCOPE_AGENT); }
__device__ __forceinline__ unsigned xb_add(unsigned* p, unsigned v) { return __hip_atomic_fetch_add(p, v, __ATOMIC_RELAXED, __HIP_MEMORY_SCOPE_AGENT); }
__device__ __forceinline__ unsigned xb_xcc_id() { return (unsigned)__builtin_amdgcn_s_getreg((3 << 11) | 20) & 0xFu; }
#define XB_SPIN(cond, bar) do { unsigned _sp = 0; while (cond) { __builtin_amdgcn_s_sleep(1); \
    if ((++_sp & 255u) == 0u) { if (xb_ld(&(bar)[XB_TMO])) break; if (_sp > XB_SPIN_CAP) { atomicAdd(&(bar)[XB_TMO], 1u); break; } } } } while (0)

struct XcdBarrier {
    unsigned* bar; unsigned x;
    volatile LAS unsigned* st;
};

__device__ __forceinline__ XcdBarrier xcd_barrier_post(unsigned* bar, volatile LAS unsigned* st) {
    XcdBarrier b; b.bar = bar; b.x = xb_xcc_id(); b.st = st;
    if (threadIdx.x == 0) (void)xb_add(&bar[XB_XCNT(b.x)], 1u);
    return b;
}
__device__ __forceinline__ void xcd_barrier_complete(unsigned* bar, unsigned x, unsigned& nloc, unsigned& nx) {
    const unsigned G = gridDim.x * gridDim.y * gridDim.z;
    unsigned sum, cnt, mine, sp = 0u;
    for (;;) {
        sum = 0u; cnt = 0u; mine = 0u;
#pragma unroll
        for (unsigned j = 0; j < 16; ++j) { const unsigned c = xb_ld(&bar[XB_XCNT(j)]); sum += c; cnt += (c > 0u) ? 1u : 0u; mine = (j == x) ? c : mine; }
        if (sum == G) break;
        __builtin_amdgcn_s_sleep(1);
        if ((++sp & 255u) == 0u) { if (xb_ld(&bar[XB_TMO])) break; if (sp > XB_SPIN_CAP) { atomicAdd(&bar[XB_TMO], 1u); break; } }
    }
    nloc = mine > 0u ? mine : 1u; nx = cnt > 0u ? cnt : 1u;
}

__device__ __forceinline__ void xcd_barrier(const XcdBarrier& b) {
    asm volatile("s_waitcnt vmcnt(0)" ::: "memory");
    __syncthreads();
    if (threadIdx.x == 0) {
        unsigned* bar = b.bar;
        __builtin_amdgcn_s_waitcnt(0);
        unsigned nloc = b.st[0], nx = b.st[1];
        if (nloc == 0u) { xcd_barrier_complete(bar, b.x, nloc, nx); b.st[0] = nloc; b.st[1] = nx; }
        const unsigned old = xb_add(&bar[XB_XSUB(b.x)], 1u);
        const unsigned gen = old / nloc;
        if (old + 1u == (gen + 1u) * nloc) {
            __builtin_amdgcn_fence(__ATOMIC_RELEASE, "agent");
            asm volatile("s_waitcnt vmcnt(0)" ::: "memory");
            const unsigned og = xb_add(&bar[XB_TOP], 1u);
            const unsigned tg = og / nx;
            if (og + 1u == (tg + 1u) * nx) xb_add(&bar[XB_TOPGEN], 1u);
            else XB_SPIN(xb_ld(&bar[XB_TOPGEN]) == tg, bar);
            __builtin_amdgcn_fence(__ATOMIC_ACQUIRE, "agent");
            xb_add(&bar[XB_XGEN(b.x)], 1u);
            asm volatile("s_waitcnt vmcnt(0)" ::: "memory");
        } else {
            XB_SPIN(xb_ld(&bar[XB_XGEN(b.x)]) == gen, bar);
            __builtin_amdgcn_fence(__ATOMIC_ACQUIRE, "agent");
            asm volatile("s_waitcnt vmcnt(0)" ::: "memory");
        }
    }
    __syncthreads();
}

struct Args { const float* in[35]; float* out; unsigned char* ws; int ph_lo, ph_hi; };

constexpr int NPHASE = 11;
constexpr int LDS_BYTES = 147456;

__global__ void __launch_bounds__(512, 2) fwd_kernel(Args args) {
    extern __shared__ __attribute__((aligned(16))) unsigned char lds_raw[];
    LAS unsigned char* lds = (LAS unsigned char*)lds_raw;
    cg::grid_group grid = cg::this_grid();
    volatile LAS unsigned* MISC = (volatile LAS unsigned*)(lds + 131072 + 320);
    if (threadIdx.x < 64) MISC[threadIdx.x] = 0u;
    __syncthreads();
    XcdBarrier xbar; xbar.bar = (unsigned*)args.ws; xbar.x = 0; xbar.st = MISC + 8;
    const int G = gridDim.x, bid = blockIdx.x;
    const int NGW = G * 8;
#define PHASE_IDS int tid = threadIdx.x; asm volatile("" : "+v"(tid)); const int lane = tid & 63, wave = __builtin_amdgcn_readfirstlane(tid >> 6); const int gw = bid * 8 + wave; (void)lane; (void)gw;
    unsigned char* ws = args.ws; float* out = args.out;
    const int lo = args.ph_lo, hi = args.ph_hi;
#ifndef PHM
#define PHM 0x7ff
#endif
#define IN(k) (((PHM >> (k)) & 1) && lo <= (k) && (k) < hi)
#ifndef REPM
#define REPM 0
#endif
#define REPS(k) for (int rq_ = 0; rq_ < (((REPM >> (k)) & 1) ? 2 : 1); ++rq_)
#define SEAM(k) do { if (IN(k) && IN((k) + 1)) { if ((k) == 0) { grid.sync(); xbar = xcd_barrier_post((unsigned*)args.ws, MISC + 8); } else xcd_barrier(xbar); } } while (0)
#define XN ((bf16*)(ws + WS_XN))
#define GB ((bf16*)(ws + WS_G))
#define CQ ((bf16*)(ws + WS_CQ))
#define CQN ((bf16*)(ws + WS_CQN))
#define QM ((bf16*)(ws + WS_QM))
#define DQ ((bf16*)(ws + WS_DQ))
#define MQ ((bf16*)(ws + WS_MQ))
#define DKP ((bf16*)(ws + WS_DKP))
#define DVP ((bf16*)(ws + WS_DVP))
#define KR ((bf16*)(ws + WS_KR))
#define MKB ((bf16*)(ws + WS_MK))
#define MVB ((bf16*)(ws + WS_MV))
#define LAT ((bf16*)(ws + WS_LAT))
#define KN ((bf16*)(ws + WS_KN))
#define VM ((bf16*)(ws + WS_VM))
#define OA ((bf16*)(ws + WS_OA))
#define MRG ((float*)(ws + WS_MRG))
#define MRGB ((bf16*)(ws + WS_MRGB))
#define MIX ((float*)(ws + WS_MIX))
#define UB ((bf16*)(ws + WS_U))
#define TABM ((float*)(ws + WS_TABM))
#define TABD ((float*)(ws + WS_TABD))

    if (IN(0)) REPS(0) {
        PHASE_IDS
        LAS float* scr = (LAS float*)(lds + wave * 16384);
        {
            constexpr int I_IN = 16 * 85, I_G = 16 * 96, I_UQ = 6 * 24, I_UK = 4 * 16, I_MK = 16 * 16, I_O = 8 * 32, I_OUT = 16 * 32, I_UP = 16 * 128, I_DN = 64 * 32;
            constexpr int NITEMS = I_IN + I_G + I_UQ + 2 * I_UK + 2 * I_MK + 3 * I_O + I_OUT + I_UP + I_DN;
            for (int it = gw; it < NITEMS; it += NGW) {
                int r = it;
                if (r < I_IN) { p0_transpose_item(INP(10), 1024, 2720, (bf16*)(ws + W_ING), 0, scr, r, lane); continue; } r -= I_IN;
                if (r < I_G) { p0_transpose_item(INP(27), 1024, 3072, (bf16*)(ws + W_ING), INWP, scr, r, lane); continue; } r -= I_G;
                if (r < I_UQ) { p0_transpose_item(INP(12), 384, 768, (bf16*)(ws + W_UQ), 0, scr, r, lane); continue; } r -= I_UQ;
                if (r < I_UK) { p0_transpose_item(INP(14), 256, 512, (bf16*)(ws + W_UKV), 0, scr, r, lane); continue; } r -= I_UK;
                if (r < I_UK) { p0_transpose_item(INP(15), 256, 512, (bf16*)(ws + W_UKV), 512, scr, r, lane); continue; } r -= I_UK;
                if (r < I_MK) { p0_transpose_item(INP(22), 1024, 512, (bf16*)(ws + W_MEM), 0, scr, r, lane); continue; } r -= I_MK;
                if (r < I_MK) { p0_transpose_item(INP(23), 1024, 512, (bf16*)(ws + W_MEM), 512, scr, r, lane); continue; } r -= I_MK;
                if (r < I_O) { p0_transpose_item(INP(24), 512, 1024, (bf16*)(ws + W_OM), 0, scr, r, lane); continue; } r -= I_O;
                if (r < I_O) { p0_transpose_item(INP(25), 512, 1024, (bf16*)(ws + W_OM), 1024, scr, r, lane); continue; } r -= I_O;
                if (r < I_O) { p0_transpose_item(INP(26), 512, 1024, (bf16*)(ws + W_OM), 2048, scr, r, lane); continue; } r -= I_O;
                if (r < I_OUT) { p0_transpose_item(INP(29), 1024, 1024, (bf16*)(ws + W_OUT), 0, scr, r, lane); continue; } r -= I_OUT;
                if (r < I_UP) { p0_transpose_item(INP(32), 1024, 4096, (bf16*)(ws + W_UP), 0, scr, r, lane); continue; } r -= I_UP;
                p0_transpose_item(INP(33), 4096, 1024, (bf16*)(ws + W_DN), 0, scr, r, lane);
            }
        }
        if (bid == 0) for (int i = tid; i < XCD_BAR_WORDS; i += 512) __hip_atomic_store((unsigned*)ws + i, 0u, RLX_AGENT);
        for (int i = gw * 64 + lane; i < 96 * 1024 / 8; i += NGW * 64) *(u32x4*)((bf16*)(ws + W_ING) + (size_t)2720 * 1024 + (size_t)i * 8) = (u32x4){0u, 0u, 0u, 0u};
        for (int m = gw; m < MROWS + NMEM; m += NGW) {
            if (m < SEQ) rms_row_1024(INP(0) + (size_t)m * DM, INP(9), XN + (size_t)m * DM, lane);
            else if (m < MROWS) rms_row_1024(INP(1) + (size_t)(m - SEQ) * DM, INP(9), XN + (size_t)m * DM, lane);
            else rms_row_1024(INP(8) + (size_t)(m - MROWS) * DM, INP(21), MRGB + (size_t)(m - MROWS) * DM, lane);
        }
        for (int i = gw; i < NSB * PAST; i += NGW) {
            const int b = i >> 12, s = i & 4095;
            const f32x4 v = *((const f32x4*)(INP(2) + (size_t)i * 256) + lane);
            u32x2 w; w.x = pk2(v.x, v.y); w.y = pk2(v.z, v.w);
            *((u32x2*)(LAT + (size_t)(SEQ + b * SKEYS + s) * 256) + lane) = w;
        }
        for (int i = gw; i < NSB * PAST / 8; i += NGW) {
            const int rowi = i * 8 + (lane >> 3); const int b = rowi >> 12, s = rowi & 4095;
            const f32x4 v = *((const f32x4*)(INP(3) + (size_t)rowi * 32) + (lane & 7));
            u32x2 w; w.x = pk2(v.x, v.y); w.y = pk2(v.z, v.w);
            *((u32x2*)(KR + (size_t)(SEQ + b * SKEYS + s) * 32) + (lane & 7)) = w;
        }
        for (int i = gw * 64 + lane; i < NSB * NMEM * 512 / 4; i += NGW * 64) {
            const f32x4 a = *((const f32x4*)INP(6) + i), b = *((const f32x4*)INP(7) + i);
            u32x2 w; w.x = pk2(a.x, a.y); w.y = pk2(a.z, a.w); *((u32x2*)(MKB + (size_t)NMEM * 512) + i) = w;
            w.x = pk2(b.x, b.y); w.y = pk2(b.z, b.w); *((u32x2*)(MVB + (size_t)NMEM * 512) + i) = w;
        }
        for (int i = gw * 64 + lane; i < SEQ * 16; i += NGW * 64) {
            const int pos = i >> 4, f = i & 15;
            const float inv = powf(10000.0f, -(float)f * (2.0f / 32.0f)); const float ang = (float)pos * inv;
            TABM[(size_t)pos * 32 + f] = cosf(ang); TABM[(size_t)pos * 32 + 16 + f] = sinf(ang);
        }
        for (int i = gw * 64 + lane; i < SEQ * 4; i += NGW * 64) {
            const int pos = i >> 2, f = i & 3;
            const float inv = powf(500000.0f, -(float)f * (2.0f / 8.0f)); const float ang = (float)pos * inv;
            TABD[(size_t)pos * 8 + f] = cosf(ang); TABD[(size_t)pos * 8 + 4 + f] = sinf(ang);
        }
        asm volatile("s_waitcnt vmcnt(0) lgkmcnt(0)" ::: "memory");
        __syncthreads();
    }
    SEAM(0);

    if (IN(1)) REPS(1) {
        {
            pg8::Gemm g{MRGB, (const bf16*)(ws + W_MEM), NMEM, 1024, 1024}; pg8::StaticOrder S; S.init(NMEM, 1024, G, (bid + 4) % G);
            EpiMemKV E{out, MKB, MVB};
            pg8::gemm_phase<EpiMemKV, pg8::StaticOrder, true, true>(lds, g, S, E);
        }
        {
            pg8::Gemm g{XN, (const bf16*)(ws + W_ING), MROWS, NING, 1024}; pg8::StaticOrder S; S.init(MROWS, NING, G, bid);
            EpiP1 E{CQ, KR, DQ, DKP, DVP, MQ, GB, out, INP(28), TABM, TABD};
            pg8::gemm_phase<EpiP1, pg8::StaticOrder, true, true>(lds, g, S, E);
        }
    }
    SEAM(1);

    if (IN(2)) {
        PHASE_IDS
        for (int row = gw; row < MROWS; row += NGW) {
            {
                u32x4 raw = (u32x4){0u, 0u, 0u, 0u};
                if (lane < 48) raw = *((const u32x4*)(CQ + (size_t)row * 384) + lane);
                float v[8] = {bf_lo(raw.x), bf_hi(raw.x), bf_lo(raw.y), bf_hi(raw.y), bf_lo(raw.z), bf_hi(raw.z), bf_lo(raw.w), bf_hi(raw.w)};
                float s = 0.f;
#pragma unroll
                for (int e = 0; e < 8; ++e) s += v[e] * v[e];
                const float rstd = rsqrtf(wave_sum(s) * (1.f / 384.f) + EPSN);
                if (lane < 48) {
                    const f32x4 g0 = *((const f32x4*)INP(11) + 2 * lane), g1 = *((const f32x4*)INP(11) + 2 * lane + 1);
                    u32x4 w; w.x = pk2(v[0] * rstd * g0.x, v[1] * rstd * g0.y); w.y = pk2(v[2] * rstd * g0.z, v[3] * rstd * g0.w);
                    w.z = pk2(v[4] * rstd * g1.x, v[5] * rstd * g1.y); w.w = pk2(v[6] * rstd * g1.z, v[7] * rstd * g1.w);
                    *((u32x4*)(CQN + (size_t)row * 384) + lane) = w;
                }
            }
            {
                float* p = out_row(out, row, O_PCKV, O_SCKV, 256);
                f32x4 v = *((const f32x4*)p + lane);
                const float s = (v.x * v.x + v.y * v.y) + (v.z * v.z + v.w * v.w);
                const float rstd = rsqrtf(wave_sum(s) * (1.f / 256.f) + EPSN);
                const f32x4 gg = *((const f32x4*)INP(13) + lane);
                v.x *= rstd * gg.x; v.y *= rstd * gg.y; v.z *= rstd * gg.z; v.w *= rstd * gg.w;
                *((f32x4*)p + lane) = v;
                u32x2 w; w.x = pk2(v.x, v.y); w.y = pk2(v.z, v.w);
                *((u32x2*)(LAT + (size_t)row_krow(row) * 256) + lane) = w;
            }
        }
    }
    SEAM(2);

    if (IN(3)) REPS(3) {
#ifndef NO_P3A
        {
            pg8::Gemm g{CQN, (const bf16*)(ws + W_UQ), MROWS, 768, 384}; pg8::StaticOrder S; S.init(MROWS, 768, G, bid);
            EpiUQ E{QM, TABM};
            pg8::gemm_phase<EpiUQ, pg8::StaticOrder, true, true>(lds, g, S, E);
        }
#endif
#ifndef NO_P3B
        {
            pg8::Gemm g{LAT, (const bf16*)(ws + W_UKV), MKROWS, 1024, 256}; pg8::StaticOrder S; S.init(MKROWS, 1024, G, bid);
            EpiBf16Split E{KN, VM};
            pg8::gemm_phase<EpiBf16Split, pg8::StaticOrder, true, true>(lds, g, S, E);
        }
#endif
    }
    SEAM(3);

#ifndef REP_P4
#define REP_P4 1
#endif
    if (IN(4)) for (int rep_ = 0; rep_ < REP_P4; ++rep_) {
        PHASE_IDS
        float lam;
        {
            float sa = 0.f, sb = 0.f;
            if (lane < 32) { sa = INP(16)[lane] * INP(17)[lane]; sb = INP(18)[lane] * INP(19)[lane]; }
            sa = wave_sum(sa); sb = wave_sum(sb);
            lam = expf(sa) - expf(sb) + LAM_INIT;
        }
        constexpr int BIG = 1 << 30;
#define O_MLA OA
#define O_DIFF (OA + (size_t)MROWS * 512)
#define O_MEM (OA + (size_t)2 * MROWS * 512)
#ifndef KMASK
#define KMASK 15
#endif
#define AU_INIT(a) AU a; a.lam = lam; a.subg = INP(20); a.ldo = 512; a.Kb = nullptr; a.Vb = nullptr; a.Kr = KR; a.ldkr = 32; a.nsplit = BIG; a.ldk = 512; a.ldv = 512; a.limbase = BIG / 2;
#ifndef REP_MLA
#define REP_MLA 1
#endif
        if (KMASK & 1) for (int rp_ = 0; rp_ < REP_MLA; ++rp_) for (int it = bid; it < (rp_ == 0 ? 384 : 256); it += G) {
            const int ne = it < 256 ? 2 : 1;
#pragma unroll 1
            for (int e = 0; e < ne; ++e) {
                AU_INIT(a)
                if (it < 256) { const int head = it & 7, pair = it >> 3, qb = e == 0 ? 63 - pair : pair;
                    a.qrow0 = qb * 256; a.nq = 256; a.nkeys = (qb + 1) * 256; a.limbase = 4 * qb;
                    a.Q = QM + head * 96; a.ldq = 768; a.Ka = KN + head * 64; a.Va = VM + head * 64; a.O = O_MLA + head * 64;
                } else { const int jj = it - 256, b = jj >> 3, head = jj & 7; const size_t k0 = (size_t)SEQ + (size_t)b * SKEYS;
                    a.qrow0 = SEQ + b * 32; a.nq = 32; a.nkeys = SKEYS;
                    a.Q = QM + head * 96; a.ldq = 768; a.Ka = KN + k0 * 512 + head * 64; a.Kr = KR + k0 * 32; a.Va = VM + k0 * 512 + head * 64; a.O = O_MLA + head * 64; }
                attn_unit<0, false>(lds, a, tid);
            }
        }
#ifndef REP_DIFF
#define REP_DIFF 1
#endif
        if (KMASK & 2) for (int rp_ = 0; rp_ < REP_DIFF; ++rp_) for (int it = bid; it < 256; it += G) {
#pragma unroll 1
            for (int e = 0; e < 2; ++e) {
                AU_INIT(a)
                const int head = it & 7, pair = it >> 3, qb = e == 0 ? 63 - pair : pair;
                a.qrow0 = qb * 256; a.nq = 256; a.nkeys = (qb + 1) * 256; a.limbase = 4 * qb;
                a.Q = DQ + head * 64; a.ldq = 512; a.Ka = DKP + head * 64; a.Va = DVP + head * 64; a.O = O_DIFF + head * 64;
                attn_unit<1, false>(lds, a, tid);
            }
        }
        if (KMASK & 4) for (int it = (bid + G / 2) % G; it < 128; it += G) {
            AU_INIT(a)
            const int b = it >> 3, head = it & 7;
            a.qrow0 = SEQ + b * 32; a.nq = 32; a.nkeys = SKEYS; a.Q = DQ + head * 64; a.ldq = 512; a.nsplit = PAST;
            a.Ka = INP(4) + (size_t)b * PAST * 512 + head * 64; a.Kb = out + O_SDK + (size_t)b * 32 * 512 + head * 64;
            a.Va = INP(5) + (size_t)b * PAST * 512 + head * 64; a.Vb = out + O_SDV + (size_t)b * 32 * 512 + head * 64;
            a.O = O_DIFF + head * 64;
            attn_unit<1, true>(lds, a, tid);
        }
        if (KMASK & 8) for (int it = bid; it < 320; it += G) {
            AU_INIT(a)
            a.nkeys = NMEM; a.ldq = 512;
            if (it < 256) { const int qb = it >> 2, hm = it & 3; a.qrow0 = qb * 256; a.nq = 256; a.Q = MQ + hm * 128; a.Ka = MKB + hm * 128; a.Va = MVB + hm * 128; a.O = O_MEM + hm * 128; }
            else { const int jj = it - 256, b = jj >> 2, hm = jj & 3; a.qrow0 = SEQ + b * 32; a.nq = 32; a.Q = MQ + hm * 128;
                a.Ka = MKB + (size_t)(1 + b) * NMEM * 512 + hm * 128; a.Va = MVB + (size_t)(1 + b) * NMEM * 512 + hm * 128; a.O = O_MEM + hm * 128; }
            attn_unit<2, false>(lds, a, tid);
        }
#undef AU_INIT
    }
    SEAM(4);

    if (IN(5)) REPS(5) {
        const bf16* WOM = (const bf16*)(ws + W_OM);
        { pg8::Gemm g{OA, WOM, MROWS, 1024, 512}; pg8::StaticOrder S; S.init(MROWS, 1024, G, bid); EpiMerge<0> E{GB, MRG, MRGB};
          pg8::gemm_phase<EpiMerge<0>, pg8::StaticOrder, true, true>(lds, g, S, E); }
        { pg8::Gemm g{OA + (size_t)MROWS * 512, WOM + (size_t)1024 * 512, MROWS, 1024, 512}; pg8::StaticOrder S; S.init(MROWS, 1024, G, bid); EpiMerge<1> E{GB, MRG, MRGB};
          pg8::gemm_phase<EpiMerge<1>, pg8::StaticOrder, true, true>(lds, g, S, E); }
        { pg8::Gemm g{OA + (size_t)2 * MROWS * 512, WOM + (size_t)2048 * 512, MROWS, 1024, 512}; pg8::StaticOrder S; S.init(MROWS, 1024, G, bid); EpiMerge<2> E{GB, MRG, MRGB};
          pg8::gemm_phase<EpiMerge<2>, pg8::StaticOrder, true, true>(lds, g, S, E); }
    }
    SEAM(5);

    if (IN(6)) REPS(6) {
        pg8::Gemm g{MRGB, (const bf16*)(ws + W_OUT), MROWS, 1024, 1024}; pg8::StaticOrder S; S.init(MROWS, 1024, G, bid); EpiF32 E{MIX, 1024};
        pg8::gemm_phase<EpiF32, pg8::StaticOrder, true, true>(lds, g, S, E);
    }
    SEAM(6);

    if (IN(7)) REPS(7) {
        PHASE_IDS
        for (int row = gw; row < MROWS; row += NGW) {
            const float* xr = row < SEQ ? INP(0) + (size_t)row * DM : INP(1) + (size_t)(row - SEQ) * DM;
            const f32x4* mr = (const f32x4*)(MIX + (size_t)row * DM) + lane;
            f32x4 v[4]; float s = 0.f;
#pragma unroll
            for (int j = 0; j < 4; ++j) { v[j] = mr[64 * j]; s += (v[j].x * v[j].x + v[j].y * v[j].y) + (v[j].z * v[j].z + v[j].w * v[j].w); }
            const float rstd = rsqrtf(wave_sum(s) * (1.f / 1024.f) + EPSN);
            float s2 = 0.f;
#pragma unroll
            for (int j = 0; j < 4; ++j) { const f32x4 gg = *((const f32x4*)INP(30) + lane + 64 * j); const f32x4 xx = *((const f32x4*)xr + lane + 64 * j);
                v[j].x = xx.x + v[j].x * rstd * gg.x; v[j].y = xx.y + v[j].y * rstd * gg.y; v[j].z = xx.z + v[j].z * rstd * gg.z; v[j].w = xx.w + v[j].w * rstd * gg.w;
                s2 += (v[j].x * v[j].x + v[j].y * v[j].y) + (v[j].z * v[j].z + v[j].w * v[j].w);
                *((f32x4*)(out + O_Y + (size_t)row * DM) + lane + 64 * j) = v[j]; }
            const float rstd2 = rsqrtf(wave_sum(s2) * (1.f / 1024.f) + EPSN);
#pragma unroll
            for (int j = 0; j < 4; ++j) { const f32x4 gg = *((const f32x4*)INP(31) + lane + 64 * j);
                u32x2 w; w.x = pk2(v[j].x * rstd2 * gg.x, v[j].y * rstd2 * gg.y); w.y = pk2(v[j].z * rstd2 * gg.z, v[j].w * rstd2 * gg.w);
                *((u32x2*)(XN + (size_t)row * DM) + lane + 64 * j) = w; }
        }
    }
    SEAM(7);

    if (IN(8)) REPS(8) {
        pg8::Gemm g{XN, (const bf16*)(ws + W_UP), MROWS, DFF, 1024}; pg8::StaticOrder S; S.init(MROWS, DFF, G, bid); EpiUp E{UB};
        pg8::gemm_phase<EpiUp, pg8::StaticOrder, true, true>(lds, g, S, E);
    }
    SEAM(8);

    if (IN(9)) REPS(9) {
        pg8::Gemm g{UB, (const bf16*)(ws + W_DN), MROWS, 1024, DFF}; pg8::StaticOrder S; S.init(MROWS, 1024, G, bid); EpiF32 E{MIX, 1024};
        pg8::gemm_phase<EpiF32, pg8::StaticOrder, true, true>(lds, g, S, E);
    }
    SEAM(9);

    if (IN(10)) {
        PHASE_IDS
        for (int row = gw; row < MROWS; row += NGW) {
            const f32x4* fr_ = (const f32x4*)(MIX + (size_t)row * DM) + lane;
            f32x4 v[4]; float s = 0.f;
#pragma unroll
            for (int j = 0; j < 4; ++j) { v[j] = fr_[64 * j]; s += (v[j].x * v[j].x + v[j].y * v[j].y) + (v[j].z * v[j].z + v[j].w * v[j].w); }
            const float rstd = rsqrtf(wave_sum(s) * (1.f / 1024.f) + EPSN);
#pragma unroll
            for (int j = 0; j < 4; ++j) { const f32x4 gg = *((const f32x4*)INP(34) + lane + 64 * j); f32x4* yp = (f32x4*)(out + O_Y + (size_t)row * DM) + lane + 64 * j; const f32x4 xx = *yp;
                f32x4 y; y.x = xx.x + v[j].x * rstd * gg.x; y.y = xx.y + v[j].y * rstd * gg.y; y.z = xx.z + v[j].z * rstd * gg.z; y.w = xx.w + v[j].w * rstd * gg.w; *yp = y; }
        }
    }
#undef IN
#undef SEAM
}

#ifndef MK_N_LAUNCHES
#define MK_N_LAUNCHES 1
#endif

extern "C" void kernel_launch(void* const* d_in, const int* in_sizes, int n_in, void* d_out, int out_size, void* d_ws, size_t ws_size, hipStream_t stream) {
    static int grid = 0;
    if (grid == 0) {
        if (n_in != 35 || out_size != (int)O_END || ws_size < WS_END) { fprintf(stderr, "kernel_launch: unexpected shapes: n_in %d out %d ws %zu\n", n_in, out_size, ws_size); grid = -1; return; }
        int dev = 0, cus = 0, per_cu = 0;
        hipGetDevice(&dev); hipDeviceGetAttribute(&cus, hipDeviceAttributeMultiprocessorCount, dev);
        if (hipFuncSetAttribute((const void*)fwd_kernel, hipFuncAttributeMaxDynamicSharedMemorySize, LDS_BYTES) != hipSuccess) { fprintf(stderr, "kernel_launch: hipFuncSetAttribute failed\n"); grid = -1; return; }
        hipOccupancyMaxActiveBlocksPerMultiprocessor(&per_cu, (const void*)fwd_kernel, 512, LDS_BYTES);
        (void)hipGetLastError();
        if (per_cu < 1) per_cu = 1;
        grid = cus;
    }
    if (grid < 0) return;
    Args a{};
    for (int i = 0; i < 35; ++i) a.in[i] = (const float*)d_in[i];
    a.out = (float*)d_out; a.ws = (unsigned char*)d_ws;
#if MK_N_LAUNCHES == 1
    a.ph_lo = 0; a.ph_hi = NPHASE;
    void* kargs[] = {&a};
    hipError_t e = hipLaunchCooperativeKernel((const void*)fwd_kernel, dim3(grid), dim3(512), kargs, LDS_BYTES, stream);
    if (e != hipSuccess) fprintf(stderr, "cooperative launch failed: %s (grid %d)\n", hipGetErrorString(e), grid);
#else
    for (int p = 0; p < NPHASE; ++p) { a.ph_lo = p; a.ph_hi = p + 1; hipLaunchKernelGGL(fwd_kernel, dim3(grid), dim3(512), LDS_BYTES, stream, a); }
#endif
}
```

```cpp
#include <hip/hip_runtime.h>
#include <hip/hip_cooperative_groups.h>
#include <cstdio>
#include <cstdint>
namespace cg = cooperative_groups;
namespace pg8 {
#define PG8_LAS __attribute__((address_space(3)))
typedef unsigned short bf16_t;
typedef short bf16x8 __attribute__((ext_vector_type(8)));
typedef float f32x4 __attribute__((ext_vector_type(4)));
typedef unsigned u32x4 __attribute__((ext_vector_type(4)));
constexpr int BM = 256, BK = 64, HALF = 128, HTB = HALF * BK * 2  , STAGE_BYTES = 8 * HTB, NXCD = 8, WGM = 8;

__host__ __device__ __forceinline__ int lds_byte(int r, int c) { const int st = (r >> 4) * 2 + (c >> 5), rr = r & 15, cc = c & 31, ob = rr * 64 + cc * 2; return st * 1024 + (ob ^ (((ob >> 9) & 1) << 5)); }
__host__ __device__ __forceinline__ void stage_rc(int b, int& R, int& C) { const int st = b / 1024, sb = b % 1024, swz = sb ^ (((sb >> 9) & 1) << 5); R = (st >> 1) * 16 + swz / 64; C = (st & 1) * 32 + (swz % 64) / 2; }
__host__ __device__ __forceinline__ int perm32(int rho) { const int n = rho >> 4, i = rho & 15; return 8 * (i >> 2) + 4 * n + (i & 3); }

struct Unit { int pm, pn, kofs; };
struct Gemm { const bf16_t* A; const bf16_t* Bt; int M, N, K, KL; };

struct StaticOrder {
    int nM, nN, nwg, G, c;
    __host__ __device__ void init(int M, int N, int G_, int c_) { nM = M / BM; nN = N / BM; nwg = nM * nN; G = G_; c = c_; }
    __host__ __device__ bool next(int i, Unit& u) const {
        const long L = (long)i * G + c; if (L >= nwg) return false;
        int wgid = (int)L; { const int q = nwg / NXCD, r = nwg % NXCD, xcd = wgid % NXCD, off = wgid / NXCD; wgid = (xcd < r ? xcd * (q + 1) : r * (q + 1) + (xcd - r) * q) + off; }
        const int nig = WGM * nN, gid = wgid / nig, fm = gid * WGM, gsz = (nM - fm) < WGM ? (nM - fm) : WGM;
        u.pm = fm + ((wgid % nig) % gsz); u.pn = (wgid % nig) / gsz; u.kofs = 0; return true;
    }
    __device__ __forceinline__ void a_ready(const Unit&) const {}
    __device__ __forceinline__ void done(const Unit&) const {}
};

__device__ __forceinline__ unsigned cvt_pk_bf16(float lo, float hi) { unsigned r; asm volatile("v_cvt_pk_bf16_f32 %0, %1, %2" : "=v"(r) : "v"(lo), "v"(hi)); return r; }
template <class Epi, class Sched, bool ALIGN_EPI = false, bool SP2 = false>
__device__ __forceinline__ void gemm_phase(PG8_LAS unsigned char* lds, const Gemm g, const Sched& S, const Epi& E) {
    int tid_l = threadIdx.x; asm volatile("" : "+v"(tid_l));
    const int tid = tid_l, wid = __builtin_amdgcn_readfirstlane(tid >> 6), lane = tid & 63, wr = wid >> 2, wc = wid & 3, fr = lane & 15, fq = lane >> 4;
    const int K = g.K, nt = (g.KL ? g.KL : K) / BK;
    unsigned voffA[2], voffB[2];
#pragma unroll
    for (int i = 0; i < 2; ++i) { int R, C; stage_rc(tid * 16 + i * 8192, R, C); const int Rb = Epi::PERM ? ((R & ~31) + perm32(R & 31)) : R;
        voffA[i] = (unsigned)(R * K + C) * 2u; voffB[i] = (unsigned)(Rb * K + C) * 2u; }
    const size_t kstep = (size_t)(BK * 2);
    const size_t hstep = (size_t)HALF * K * 2;
    const size_t tstep = 2 * hstep;
    const unsigned ldsw = (unsigned)wid * 1024u;
    const int aoff = lds_byte(wr * 64 + fr, fq * 8), boff = lds_byte(wc * 32 + fr, fq * 8);
#define PG8_SA(b, h) (((b) * 2 + (h)) * HTB)
#define PG8_SB(b, h) ((4 + (b) * 2 + (h)) * HTB)
#define PG8_STAGE(bufoff, gbase, voff) do { _Pragma("unroll") for (int _i = 0; _i < 2; ++_i) \
        __builtin_amdgcn_global_load_lds((const unsigned*)((const char*)(gbase) + (voff)[_i]), (PG8_LAS unsigned*)(lds + (bufoff) + ldsw + _i * 8192), 16, 0, 0); } while (0)
#define PG8_LDA(dst, b, h) do { _Pragma("unroll") for (int m = 0; m < 4; ++m) _Pragma("unroll") for (int k = 0; k < 2; ++k) dst[m][k] = *(const PG8_LAS bf16x8*)(lds + PG8_SA(b, h) + aoff + m * 2048 + k * 1024); } while (0)
#define PG8_LDB(dst, b, h) do { _Pragma("unroll") for (int n = 0; n < 2; ++n) _Pragma("unroll") for (int k = 0; k < 2; ++k) dst[n][k] = *(const PG8_LAS bf16x8*)(lds + PG8_SB(b, h) + boff + n * 2048 + k * 1024); } while (0)
#define PG8_MMA(ai, bj, At, Bt) do { __builtin_amdgcn_s_setprio(1); _Pragma("unroll") for (int m = 0; m < 4; ++m) _Pragma("unroll") for (int n = 0; n < 2; ++n) _Pragma("unroll") for (int k = 0; k < 2; ++k) \
        acc[ai][bj][m][n] = __builtin_amdgcn_mfma_f32_16x16x32_bf16(Bt[n][k], At[m][k], acc[ai][bj][m][n], 0, 0, 0); __builtin_amdgcn_s_setprio(0); } while (0)
#define PG8_WAIT_V(n) asm volatile("s_waitcnt vmcnt(" #n ")" ::: "memory")
#define PG8_WAIT_L(n) asm volatile("s_waitcnt lgkmcnt(" #n ")" ::: "memory")
#define PG8_BAR __builtin_amdgcn_s_barrier()
#define PG8_SCHED __builtin_amdgcn_sched_barrier(0)
    Unit cur, nxt; int ui = 0;
    if (!S.next(0, cur)) return;
    f32x4 acc[2][2][4][2];
#pragma unroll
    for (int a = 0; a < 2; ++a)
#pragma unroll
        for (int b = 0; b < 2; ++b)
#pragma unroll
            for (int m = 0; m < 4; ++m)
#pragma unroll
                for (int n = 0; n < 2; ++n) acc[a][b][m][n] = (f32x4){0.f, 0.f, 0.f, 0.f};
    bf16x8 At[4][2], B0[2][2], B1[2][2];
    const char* cA = (const char*)g.A + (size_t)cur.pm * tstep + (size_t)cur.kofs * 2; const char* cB = (const char*)g.Bt + (size_t)cur.pn * tstep + (size_t)cur.kofs * 2;
    S.a_ready(cur);
    if constexpr (SP2) {
        PG8_STAGE(PG8_SB(0, 0), cB, voffB); PG8_STAGE(PG8_SB(0, 1), cB + hstep, voffB); PG8_STAGE(PG8_SA(0, 0), cA, voffA); PG8_STAGE(PG8_SA(0, 1), cA + hstep, voffA);
        if (wr == 1) PG8_BAR;
        PG8_WAIT_V(2); PG8_BAR;
        PG8_STAGE(PG8_SB(1, 0), cB + kstep, voffB); PG8_STAGE(PG8_SA(1, 0), cA + kstep, voffA); PG8_STAGE(PG8_SB(1, 1), cB + hstep + kstep, voffB);
        PG8_WAIT_V(6); PG8_BAR;
    } else {
        PG8_STAGE(PG8_SB(0, 0), cB, voffB); PG8_STAGE(PG8_SA(0, 0), cA, voffA); PG8_STAGE(PG8_SB(0, 1), cB + hstep, voffB); PG8_STAGE(PG8_SA(0, 1), cA + hstep, voffA);
        if (wr == 1) PG8_BAR;
        PG8_WAIT_V(4); PG8_BAR;
        PG8_STAGE(PG8_SB(1, 0), cB + kstep, voffB); PG8_STAGE(PG8_SA(1, 0), cA + kstep, voffA); PG8_STAGE(PG8_SB(1, 1), cB + hstep + kstep, voffB);
        PG8_WAIT_V(6); PG8_BAR;
    }
    for (;;) {
        const bool has_next = S.next(ui + 1, nxt);
        const char* nA = has_next ? (const char*)g.A + (size_t)nxt.pm * tstep + (size_t)nxt.kofs * 2 : cA; const char* nB = has_next ? (const char*)g.Bt + (size_t)nxt.pn * tstep + (size_t)nxt.kofs * 2 : cB;
        _Pragma("unroll 1") for (int t = 0; t < nt; t += 2) {
            const bool last = (t == nt - 2);
            const char* a1 = cA + (size_t)(t + 1) * kstep;
            const char* a2 = last ? nA : cA + (size_t)(t + 2) * kstep; const char* b2 = last ? nB : cB + (size_t)(t + 2) * kstep;
            const char* a3 = a2 + kstep; const char* b3 = b2 + kstep;
            if (last && has_next) S.a_ready(nxt);
            if constexpr (SP2) {
            PG8_LDB(B0, 0, 0); PG8_LDB(B1, 0, 1); PG8_SCHED; PG8_LDA(At, 0, 0); PG8_STAGE(PG8_SA(1, 1), a1 + hstep, voffA);
            PG8_WAIT_V(8); PG8_WAIT_L(0); PG8_BAR; PG8_MMA(0, 0, At, B0); PG8_MMA(0, 1, At, B1); PG8_BAR; PG8_SCHED;
            PG8_LDA(At, 0, 1); PG8_STAGE(PG8_SB(0, 0), b2, voffB); PG8_STAGE(PG8_SB(0, 1), b2 + hstep, voffB); PG8_STAGE(PG8_SA(0, 0), a2, voffA);
            PG8_WAIT_V(8); PG8_WAIT_L(0); PG8_BAR; PG8_MMA(1, 0, At, B0); PG8_MMA(1, 1, At, B1); PG8_BAR; PG8_SCHED;
            PG8_LDB(B0, 1, 0); PG8_LDB(B1, 1, 1); PG8_SCHED; PG8_LDA(At, 1, 0); PG8_STAGE(PG8_SA(0, 1), a2 + hstep, voffA);
            PG8_WAIT_V(8); PG8_WAIT_L(0); PG8_BAR; PG8_MMA(0, 0, At, B0); PG8_MMA(0, 1, At, B1); PG8_BAR; PG8_SCHED;
            PG8_LDA(At, 1, 1); PG8_STAGE(PG8_SB(1, 0), b3, voffB); PG8_STAGE(PG8_SB(1, 1), b3 + hstep, voffB); PG8_STAGE(PG8_SA(1, 0), a3, voffA);
            PG8_WAIT_V(8); PG8_WAIT_L(0); PG8_BAR; PG8_MMA(1, 0, At, B0); PG8_MMA(1, 1, At, B1); PG8_BAR; PG8_SCHED;
            } else {
            PG8_LDB(B0, 0, 0); PG8_SCHED; PG8_LDA(At, 0, 0); PG8_STAGE(PG8_SA(1, 1), a1 + hstep, voffA);
            PG8_WAIT_L(8); PG8_BAR; PG8_WAIT_L(0); PG8_MMA(0, 0, At, B0); PG8_BAR; PG8_SCHED;
            PG8_LDB(B1, 0, 1); PG8_STAGE(PG8_SB(0, 0), b2, voffB);
            PG8_BAR; PG8_WAIT_L(0); PG8_MMA(0, 1, At, B1); PG8_BAR;
            PG8_LDA(At, 0, 1); PG8_STAGE(PG8_SA(0, 0), a2, voffA);
            PG8_BAR; PG8_WAIT_L(0); PG8_MMA(1, 0, At, B0); PG8_BAR; PG8_SCHED;
            PG8_STAGE(PG8_SB(0, 1), b2 + hstep, voffB);
            PG8_WAIT_V(6); PG8_BAR; PG8_MMA(1, 1, At, B1); PG8_BAR;
            PG8_LDB(B0, 1, 0); PG8_SCHED; PG8_LDA(At, 1, 0); PG8_STAGE(PG8_SA(0, 1), a2 + hstep, voffA);
            PG8_WAIT_L(8); PG8_BAR; PG8_WAIT_L(0); PG8_MMA(0, 0, At, B0); PG8_BAR; PG8_SCHED;
            PG8_LDB(B1, 1, 1); PG8_STAGE(PG8_SB(1, 0), b3, voffB);
            PG8_BAR; PG8_WAIT_L(0); PG8_MMA(0, 1, At, B1); PG8_BAR;
            PG8_LDA(At, 1, 1); PG8_STAGE(PG8_SA(1, 0), a3, voffA);
            PG8_BAR; PG8_WAIT_L(0); PG8_MMA(1, 0, At, B0); PG8_BAR; PG8_SCHED;
            PG8_STAGE(PG8_SB(1, 1), b3 + hstep, voffB);
            PG8_WAIT_V(6); PG8_BAR; PG8_MMA(1, 1, At, B1); PG8_BAR;
            }
        }
        if constexpr (ALIGN_EPI) { if (wr == 0) PG8_BAR; }
        if constexpr (!Epi::AFTER_DRAIN) { E(acc, cur, wr, wc, fr, fq); S.done(cur); }
        if (!has_next) break;
#pragma unroll
        for (int a = 0; a < 2; ++a)
#pragma unroll
            for (int b = 0; b < 2; ++b)
#pragma unroll
                for (int m = 0; m < 4; ++m)
#pragma unroll
                    for (int n = 0; n < 2; ++n) acc[a][b][m][n] = (f32x4){0.f, 0.f, 0.f, 0.f};
        cur = nxt; cA = nA; cB = nB; ++ui;
        if constexpr (ALIGN_EPI) { if (wr == 1) PG8_BAR; }
    }
    PG8_WAIT_V(0);
    if constexpr (!ALIGN_EPI) { if (wr == 0) PG8_BAR; }
    PG8_BAR;
    if constexpr (Epi::AFTER_DRAIN) { E.fused(acc, cur, wr, wc, fr, fq, lds, wid, lane); S.done(cur); }
#undef PG8_SA
#undef PG8_SB
#undef PG8_STAGE
#undef PG8_LDA
#undef PG8_LDB
#undef PG8_MMA
#undef PG8_WAIT_V
#undef PG8_WAIT_L
#undef PG8_BAR
#undef PG8_SCHED
}
}

#define LAS __attribute__((address_space(3)))
#define DI __device__ __forceinline__
typedef unsigned short bf16;
typedef unsigned u32x4 __attribute__((ext_vector_type(4)));
typedef unsigned u32x2 __attribute__((ext_vector_type(2)));
typedef float f32x4 __attribute__((ext_vector_type(4)));
typedef float f32x2 __attribute__((ext_vector_type(2)));
typedef float f32x16 __attribute__((ext_vector_type(16)));
typedef short bf16x8 __attribute__((ext_vector_type(8)));
typedef short s16x4 __attribute__((ext_vector_type(4)));
typedef __bf16 bf16x2_t __attribute__((ext_vector_type(2)));

constexpr int DM = 1024, SEQ = 16384, NSB = 16, NST = 32, PAST = 4096, NMEM = 256;
constexpr int MROWS = SEQ + NSB * NST;
constexpr int SKEYS = PAST + NST;
constexpr int MKROWS = SEQ + NSB * SKEYS;
constexpr int INWP = 2816, NING = INWP + 3072;
constexpr int DFF = 4096;
constexpr float EPSN = 1e-6f;
constexpr float LOG2E = 1.4426950408889634f;
constexpr float C_MLA = 0.10206207261596575f * LOG2E;
constexpr float C_DIFF = 0.17677669529663687f * LOG2E;
constexpr float C_MEM = 0.08838834764831845f * LOG2E;
constexpr float LAM_INIT = 0.2f;

constexpr size_t O_Y = 0;
constexpr size_t O_PCKV = (size_t)MROWS * DM;
constexpr size_t O_PKR = O_PCKV + (size_t)SEQ * 256;
constexpr size_t O_PDK = O_PKR + (size_t)SEQ * 32;
constexpr size_t O_PDV = O_PDK + (size_t)SEQ * 512;
constexpr size_t O_PMK = O_PDV + (size_t)SEQ * 512;
constexpr size_t O_PMV = O_PMK + (size_t)NMEM * 512;
constexpr size_t O_SCKV = O_PMV + (size_t)NMEM * 512;
constexpr size_t O_SKR = O_SCKV + (size_t)512 * 256;
constexpr size_t O_SDK = O_SKR + (size_t)512 * 32;
constexpr size_t O_SDV = O_SDK + (size_t)512 * 512;
constexpr size_t O_END = O_SDV + (size_t)512 * 512;

constexpr size_t MiB = 1u << 20;
constexpr size_t WS_TABM = 1 * MiB;
constexpr size_t WS_TABD = 3 * MiB;
constexpr size_t WS_W = 4 * MiB;
constexpr size_t W_ING = WS_W;
constexpr size_t W_UQ = W_ING + (size_t)NING * 1024 * 2;
constexpr size_t W_UKV = W_UQ + (size_t)768 * 384 * 2;
constexpr size_t W_MEM = W_UKV + (size_t)1024 * 256 * 2;
constexpr size_t W_OM = W_MEM + (size_t)1024 * 1024 * 2;
constexpr size_t W_OUT = W_OM + (size_t)3 * 1024 * 512 * 2;
constexpr size_t W_UP = W_OUT + (size_t)1024 * 1024 * 2;
constexpr size_t W_DN = W_UP + (size_t)4096 * 1024 * 2;
constexpr size_t W_END = W_DN + (size_t)1024 * 4096 * 2;
static_assert(W_END <= 44 * MiB, "weights");
constexpr size_t WS_G = 44 * MiB;
constexpr size_t WS_MIX = 44 * MiB;
constexpr size_t WS_DQ = 148 * MiB;
constexpr size_t WS_MQ = 165 * MiB;
constexpr size_t WS_QM = 182 * MiB;
constexpr size_t WS_DKP = 208 * MiB;
constexpr size_t WS_DVP = 225 * MiB;
constexpr size_t WS_KR = 242 * MiB;
constexpr size_t WS_MK = 248 * MiB;
constexpr size_t WS_MV = 253 * MiB;
constexpr size_t WS_LAT = 258 * MiB;
constexpr size_t WS_CQN = 299 * MiB;
constexpr size_t WS_OA = 258 * MiB;
constexpr size_t WS_XN = 312 * MiB;
constexpr size_t WS_CQ = 346 * MiB;
constexpr size_t WS_KN = 312 * MiB;
constexpr size_t WS_VM = 393 * MiB;
constexpr size_t WS_MRG = 348 * MiB;
constexpr size_t WS_MRGB = 416 * MiB;
constexpr size_t WS_U = 348 * MiB;
constexpr size_t WS_PART = 480 * MiB;
constexpr size_t WS_END = 512 * MiB;
static_assert(WS_KR + (size_t)MKROWS * 32 * 2 <= WS_MK && WS_LAT + (size_t)MKROWS * 256 * 2 <= WS_CQN && WS_CQN + (size_t)MROWS * 384 * 2 <= WS_XN, "ws map 1");
static_assert(WS_OA + (size_t)3 * MROWS * 512 * 2 <= WS_XN && WS_XN + (size_t)MROWS * 1024 * 2 <= WS_CQ && WS_KN + (size_t)MKROWS * 512 * 2 <= WS_VM, "ws map 2");
static_assert(WS_VM + (size_t)MKROWS * 512 * 2 <= WS_END && WS_MRG + (size_t)MROWS * 1024 * 4 <= WS_MRGB && WS_U + (size_t)MROWS * 4096 * 2 <= WS_END, "ws map 3");
static_assert(WS_G + (size_t)MROWS * 3072 * 2 <= WS_DQ && WS_QM + (size_t)MROWS * 768 * 2 <= WS_DKP && WS_MK + (size_t)17 * 256 * 512 * 2 <= WS_MV && WS_MV + (size_t)17 * 256 * 512 * 2 <= WS_LAT, "ws map 4");

DI unsigned pk2(float lo, float hi) { f32x2 v = {lo, hi}; bf16x2_t b = __builtin_convertvector(v, bf16x2_t); return __builtin_bit_cast(unsigned, b); }
DI u32x4 pk8(f32x4 a, f32x4 b) { u32x4 w; w.x = pk2(a[0], a[1]); w.y = pk2(a[2], a[3]); w.z = pk2(b[0], b[1]); w.w = pk2(b[2], b[3]); return w; }
DI float bf_lo(unsigned u) { return __uint_as_float(u << 16); }
DI float bf_hi(unsigned u) { return __uint_as_float(u & 0xffff0000u); }
DI float wave_sum(float v) {
#pragma unroll
    for (int o = 1; o < 64; o <<= 1) v += __shfl_xor(v, o);
    return v;
}
DI int row_pos(int row) { return row < SEQ ? row : PAST + ((row - SEQ) & 31); }
DI int row_krow(int row) { if (row < SEQ) return row; const int rs = row - SEQ; return SEQ + (rs >> 5) * SKEYS + PAST + (rs & 31); }
DI float* out_row(float* out, int row, size_t offP, size_t offS, int W) { return row < SEQ ? out + offP + (size_t)row * W : out + offS + (size_t)(row - SEQ) * W; }

#define EPI_ROWS_BEGIN _Pragma("unroll") for (int ai = 0; ai < 2; ++ai) _Pragma("unroll") for (int m = 0; m < 4; ++m) { int row = row0 + ai * 128 + m * 16; asm volatile("" : "+v"(row)); f32x4 v0 = acc[ai][bj][m][0], v1 = acc[ai][bj][m][1];
#define EPI_ROWS_END asm volatile("" ::: "memory"); }

#ifndef TST_GATE
#define TST_GATE 1
#endif
#ifndef TST_KR
#define TST_KR 1
#endif
#ifndef TST_DQ
#define TST_DQ 1
#endif
struct EpiP1 {
    static constexpr bool PERM = true, AFTER_DRAIN = false;
    bf16* CQ; bf16* KR; bf16* DQ; bf16* DKP; bf16* DVP; bf16* MQ; bf16* G; float* out; const float* bgate; const float* tabm; const float* tabd;
    DI void operator()(const f32x4 (&acc)[2][2][4][2], const pg8::Unit& u, int wr, int wc, int fr, int fq) const {
        const int row0 = u.pm * 256 + wr * 64 + fr;
#pragma unroll
        for (int bj = 0; bj < 2; ++bj) {
            const int cgp = u.pn * 256 + bj * 128 + wc * 32;
            const int c = cgp + 8 * fq;
            if (TST_GATE && cgp >= INWP) {
                const int gc = c - INWP;
                EPI_ROWS_BEGIN
                    v0 += *(const f32x4*)(bgate + gc); v1 += *(const f32x4*)(bgate + gc + 4);
#pragma unroll
                    for (int e = 0; e < 4; ++e) { v0[e] = 1.f / (1.f + __expf(-v0[e])); v1[e] = 1.f / (1.f + __expf(-v1[e])); }
                    *(u32x4*)(G + (size_t)row * 3072 + gc) = pk8(v0, v1);
                EPI_ROWS_END
            } else if (cgp < 384) {
                EPI_ROWS_BEGIN
                    *(u32x4*)(CQ + (size_t)row * 384 + c) = pk8(v0, v1);
                EPI_ROWS_END
            } else if (cgp < 640) {
                EPI_ROWS_BEGIN
                    float* p = out_row(out, row, O_PCKV, O_SCKV, 256) + (c - 384);
                    *(f32x4*)p = v0; *(f32x4*)(p + 4) = v1;
                EPI_ROWS_END
            } else if (TST_KR && cgp < 672) {
                EPI_ROWS_BEGIN
                    const float* tb = tabm + (size_t)row_pos(row) * 32 + 8 * (fq & 1);
                    float* p = out_row(out, row, O_PKR, O_SKR, 32) + (c - 640);
                    const float sg = fq < 2 ? -1.f : 1.f;
                    f32x4 pv;
#pragma unroll
                    for (int e = 0; e < 4; ++e) pv[e] = __shfl_xor(v0[e], 32);
                    const f32x4 o0 = v0 * *(const f32x4*)tb + pv * (*(const f32x4*)(tb + 16) * sg);
                    asm volatile("" ::: "memory");
#pragma unroll
                    for (int e = 0; e < 4; ++e) pv[e] = __shfl_xor(v1[e], 32);
                    const f32x4 o1 = v1 * *(const f32x4*)(tb + 4) + pv * (*(const f32x4*)(tb + 20) * sg);
                    *(f32x4*)p = o0; *(f32x4*)(p + 4) = o1;
                    *(u32x4*)(KR + (size_t)row_krow(row) * 32 + (c - 640)) = pk8(o0, o1);
                EPI_ROWS_END
            } else if (TST_DQ && cgp < 1696) {
                const bool isq = cgp < 1184;
                EPI_ROWS_BEGIN
                    if (fq == 0) {
                        const float* tb = tabd + (size_t)row_pos(row) * 8;
                        const f32x4 cc = *(const f32x4*)tb, ss = *(const f32x4*)(tb + 4);
                        const f32x4 n0 = v0 * cc - v1 * ss, n1 = v1 * cc + v0 * ss; v0 = n0; v1 = n1;
                    }
                    if (isq) { v0 *= C_DIFF; v1 *= C_DIFF; *(u32x4*)(DQ + (size_t)row * 512 + (c - 672)) = pk8(v0, v1); }
                    else {
                        float* p = out_row(out, row, O_PDK, O_SDK, 512) + (c - 1184);
                        *(f32x4*)p = v0; *(f32x4*)(p + 4) = v1;
                        if (row < SEQ) *(u32x4*)(DKP + (size_t)row * 512 + (c - 1184)) = pk8(v0, v1);
                    }
                EPI_ROWS_END
            } else if (cgp < 2208) {
                EPI_ROWS_BEGIN
                    float* p = out_row(out, row, O_PDV, O_SDV, 512) + (c - 1696);
                    *(f32x4*)p = v0; *(f32x4*)(p + 4) = v1;
                    if (row < SEQ) *(u32x4*)(DVP + (size_t)row * 512 + (c - 1696)) = pk8(v0, v1);
                EPI_ROWS_END
            } else if (cgp < 2720) {
                EPI_ROWS_BEGIN
                    v0 *= C_MEM; v1 *= C_MEM;
                    *(u32x4*)(MQ + (size_t)row * 512 + (c - 2208)) = pk8(v0, v1);
                EPI_ROWS_END
            }
        }
    }
};

struct EpiMemKV {
    static constexpr bool PERM = true, AFTER_DRAIN = false;
    float* out; bf16* MK; bf16* MV;
    DI void operator()(const f32x4 (&acc)[2][2][4][2], const pg8::Unit& u, int wr, int wc, int fr, int fq) const {
        const int row0 = u.pm * 256 + wr * 64 + fr;
#pragma unroll
        for (int bj = 0; bj < 2; ++bj) {
            const int c = u.pn * 256 + bj * 128 + wc * 32 + 8 * fq;
            const bool isk = c < 512; const int cc = isk ? c : c - 512;
            float* ob = out + (isk ? O_PMK : O_PMV); bf16* bb = isk ? MK : MV;
            EPI_ROWS_BEGIN
                float* p = ob + (size_t)row * 512 + cc; *(f32x4*)p = v0; *(f32x4*)(p + 4) = v1;
                *(u32x4*)(bb + (size_t)row * 512 + cc) = pk8(v0, v1);
            EPI_ROWS_END
        }
    }
};

struct EpiUQ {
    static constexpr bool PERM = true, AFTER_DRAIN = false;
    bf16* QM; const float* tabm;
    DI void operator()(const f32x4 (&acc)[2][2][4][2], const pg8::Unit& u, int wr, int wc, int fr, int fq) const {
        const int row0 = u.pm * 256 + wr * 64 + fr;
#pragma unroll
        for (int bj = 0; bj < 2; ++bj) {
            const int cgp = u.pn * 256 + bj * 128 + wc * 32; const int c = cgp + 8 * fq;
            const bool isrope = ((cgp >> 5) % 3) == 2;
            if (isrope) {
                EPI_ROWS_BEGIN
                    f32x4 p0, p1;
#pragma unroll
                    for (int e = 0; e < 4; ++e) { p0[e] = __shfl_xor(v0[e], 32); p1[e] = __shfl_xor(v1[e], 32); }
                    const float* tb = tabm + (size_t)row_pos(row) * 32 + 8 * (fq & 1);
                    const f32x4 c0 = *(const f32x4*)tb, c1 = *(const f32x4*)(tb + 4), s0 = *(const f32x4*)(tb + 16), s1 = *(const f32x4*)(tb + 20);
                    f32x4 o0, o1;
                    if (fq < 2) { o0 = v0 * c0 - p0 * s0; o1 = v1 * c1 - p1 * s1; } else { o0 = v0 * c0 + p0 * s0; o1 = v1 * c1 + p1 * s1; }
                    o0 *= C_MLA; o1 *= C_MLA;
                    *(u32x4*)(QM + (size_t)row * 768 + c) = pk8(o0, o1);
                    asm volatile("" ::: "memory");
                EPI_ROWS_END
            } else {
                EPI_ROWS_BEGIN
                    v0 *= C_MLA; v1 *= C_MLA;
                    *(u32x4*)(QM + (size_t)row * 768 + c) = pk8(v0, v1);
                EPI_ROWS_END
            }
        }
    }
};

struct EpiBf16Split {
    static constexpr bool PERM = true, AFTER_DRAIN = false;
    bf16* A; bf16* B;
    DI void operator()(const f32x4 (&acc)[2][2][4][2], const pg8::Unit& u, int wr, int wc, int fr, int fq) const {
        const int row0 = u.pm * 256 + wr * 64 + fr;
#pragma unroll
        for (int bj = 0; bj < 2; ++bj) {
            const int c = u.pn * 256 + bj * 128 + wc * 32 + 8 * fq;
            bf16* bb = c < 512 ? A + c : B + (c - 512);
            EPI_ROWS_BEGIN
                *(u32x4*)(bb + (size_t)row * 512) = pk8(v0, v1);
            EPI_ROWS_END
        }
    }
};

template <int BR> struct EpiMerge {
    static constexpr bool PERM = true, AFTER_DRAIN = false;
    const bf16* G; float* MRG; bf16* MRGB;
    DI void operator()(const f32x4 (&acc)[2][2][4][2], const pg8::Unit& u, int wr, int wc, int fr, int fq) const {
        const int row0 = u.pm * 256 + wr * 64 + fr;
#pragma unroll
        for (int bj = 0; bj < 2; ++bj) {
            const int c = u.pn * 256 + bj * 128 + wc * 32 + 8 * fq;
            EPI_ROWS_BEGIN
                const u32x4 g = *(const u32x4*)(G + (size_t)row * 3072 + BR * 1024 + c);
                const f32x4 g0 = {bf_lo(g.x), bf_hi(g.x), bf_lo(g.y), bf_hi(g.y)}, g1 = {bf_lo(g.z), bf_hi(g.z), bf_lo(g.w), bf_hi(g.w)};
                v0 *= g0; v1 *= g1;
                float* p = MRG + (size_t)row * 1024 + c;
                if (BR > 0) { v0 += *(const f32x4*)p; v1 += *(const f32x4*)(p + 4); }
                if (BR < 2) { *(f32x4*)p = v0; *(f32x4*)(p + 4) = v1; }
                else *(u32x4*)(MRGB + (size_t)row * 1024 + c) = pk8(v0, v1);
            EPI_ROWS_END
        }
    }
};

struct EpiF32 {
    static constexpr bool PERM = true, AFTER_DRAIN = false;
    float* O; int ldc;
    DI void operator()(const f32x4 (&acc)[2][2][4][2], const pg8::Unit& u, int wr, int wc, int fr, int fq) const {
        const int row0 = u.pm * 256 + wr * 64 + fr;
#pragma unroll
        for (int bj = 0; bj < 2; ++bj) {
            const int c = u.pn * 256 + bj * 128 + wc * 32 + 8 * fq;
            EPI_ROWS_BEGIN
                float* p = O + (size_t)row * ldc + c; *(f32x4*)p = v0; *(f32x4*)(p + 4) = v1;
            EPI_ROWS_END
        }
    }
};

struct EpiUp {
    static constexpr bool PERM = true, AFTER_DRAIN = false;
    bf16* U;
    DI void operator()(const f32x4 (&acc)[2][2][4][2], const pg8::Unit& u, int wr, int wc, int fr, int fq) const {
        const int row0 = u.pm * 256 + wr * 64 + fr;
#pragma unroll
        for (int bj = 0; bj < 2; ++bj) {
            const int c = u.pn * 256 + bj * 128 + wc * 32 + 8 * fq;
            EPI_ROWS_BEGIN
#pragma unroll
                for (int e = 0; e < 4; ++e) { const float a = fmaxf(v0[e], 0.f), b = fmaxf(v1[e], 0.f); v0[e] = a * a; v1[e] = b * b; }
                *(u32x4*)(U + (size_t)row * DFF + c) = pk8(v0, v1);
            EPI_ROWS_END
        }
    }
};

struct PieceOrder {
    int S, KL, G, c;
    DI bool next(int i, pg8::Unit& u) const { const int L = i * G + c; if (L >= 8 * S) return false; const int tile = L / S, sl = L % S; u.pm = 64 + (tile >> 2); u.pn = tile & 3; u.kofs = sl * KL; return true; }
    DI void a_ready(const pg8::Unit&) const {}
    DI void done(const pg8::Unit&) const {}
};
struct EpiPart {
    static constexpr bool PERM = true, AFTER_DRAIN = false;
    float* P; int KSH;
    DI void operator()(const f32x4 (&acc)[2][2][4][2], const pg8::Unit& u, int wr, int wc, int fr, int fq) const {
        const int row0 = (u.pm - 64) * 256 + wr * 64 + fr; float* base = P + (size_t)(u.kofs >> KSH) * (512 * 1024);
#pragma unroll
        for (int bj = 0; bj < 2; ++bj) {
            const int c = u.pn * 256 + bj * 128 + wc * 32 + 8 * fq;
            EPI_ROWS_BEGIN
                float* p = base + (size_t)row * 1024 + c; *(f32x4*)p = v0; *(f32x4*)(p + 4) = v1;
            EPI_ROWS_END
        }
    }
};

struct Chunk { u32x4 a, b; };
template <bool F32> DI void ld_chunk(Chunk& c, const void* base, size_t eoff, bool valid) {
    c.a = (u32x4){0u, 0u, 0u, 0u}; c.b = (u32x4){0u, 0u, 0u, 0u};
    if (valid) {
        if (F32) { const __attribute__((address_space(1))) float* p = (const __attribute__((address_space(1))) float*)base + eoff; c.a = *(const __attribute__((address_space(1))) u32x4*)p; c.b = *(const __attribute__((address_space(1))) u32x4*)(p + 4); }
        else { c.a = *(const __attribute__((address_space(1))) u32x4*)((const __attribute__((address_space(1))) bf16*)base + eoff); }
    }
}
#define GASP __attribute__((address_space(1)))
template <bool F32> DI void ld_chunk2(Chunk& c, const GASP unsigned char* p, bool valid) {
    c.a = (u32x4){0u, 0u, 0u, 0u}; c.b = (u32x4){0u, 0u, 0u, 0u};
    if (valid) { c.a = *(const GASP u32x4*)p; if (F32) c.b = *(const GASP u32x4*)(p + 16); }
}
template <bool F32> DI u32x4 cvt_chunk(const Chunk& c) {
    if (!F32) return c.a;
    u32x4 w;
    w.x = pk2(__uint_as_float(c.a.x), __uint_as_float(c.a.y)); w.y = pk2(__uint_as_float(c.a.z), __uint_as_float(c.a.w));
    w.z = pk2(__uint_as_float(c.b.x), __uint_as_float(c.b.y)); w.w = pk2(__uint_as_float(c.b.z), __uint_as_float(c.b.w));
    return w;
}
typedef short v4i16_t __attribute__((ext_vector_type(4)));
DI s16x4 vtr(const LAS unsigned char* p) { return __builtin_bit_cast(s16x4, __builtin_amdgcn_ds_read_tr16_b64_v4i16((LAS v4i16_t*)p)); }
DI bf16x8 pack8(const f32x16& s, int b) {
    u32x4 w; w.x = pk2(s[b], s[b + 1]); w.y = pk2(s[b + 2], s[b + 3]); w.z = pk2(s[b + 4], s[b + 5]); w.w = pk2(s[b + 6], s[b + 7]);
    return __builtin_bit_cast(bf16x8, w);
}

struct AU {
    const bf16* Q; int ldq; int qrow0; int nq;
    const void* Ka; const void* Kb; int ldk; int nsplit;
    const bf16* Kr; int ldkr;
    const void* Va; const void* Vb; int ldv;
    int nkeys; int limbase;
    bf16* O; int ldo;
    float lam; const float* subg;
};

template <int MODE, bool F32>
DI void attn_unit(LAS unsigned char* lds, const AU& a, const int tid_in) {
    int tid = tid_in; asm volatile("" : "+v"(tid));
    constexpr int NS = (MODE == 1) ? 2 : 1;
    constexpr int DQK = (MODE == 0) ? 96 : (MODE == 1 ? 64 : 128);
    constexpr int DV = (MODE == 2) ? 128 : 64;
    constexpr int NKS = DQK / 16, NDB = DV / 32;
    constexpr int KSTR = DQK * 2 + 16, VSTR = DV * 2 + 16, KBY = 64 * KSTR, VBY = 64 * VSTR;
    constexpr int KC = (MODE == 0) ? 64 : DQK, KCH = KC / 8, NKJ = KC / 64, VCH = DV / 8, NVJ = DV / 64;
    constexpr bool PREF = (MODE != 2);
    constexpr int NDH = 1;
    constexpr bool PVA = (MODE != 1);
    constexpr float THR = 8.f;
    const int lane = tid & 63, wave = __builtin_amdgcn_readfirstlane(tid >> 6), r = lane & 31, h = lane >> 5;
    const int NT = (a.nkeys + 63) >> 6;
    int lim = a.limbase + (wave >> 1); if (lim > NT - 1) lim = NT - 1;
    const bool active = wave * 32 < a.nq;
    const int ntw = active ? lim + 1 : 0;
    const bool late = wave >= 4;
    bf16x8 qf[NKS];
#pragma unroll
    for (int s = 0; s < NKS; ++s) {
        qf[s] = (bf16x8){0, 0, 0, 0, 0, 0, 0, 0};
        if (active) qf[s] = *(const bf16x8*)(a.Q + (size_t)(a.qrow0 + wave * 32 + r) * a.ldq + 16 * s + 8 * h);
    }
    float mrun[NS], lrun[NS]; f32x16 o[NS][NDB]; f32x16 sA, sB; f32x16 negm[NS]; bf16x8 pf[NS][2][2];
#pragma unroll
    for (int c = 0; c < NS; ++c) { mrun[c] = 0.f; lrun[c] = 0.f;
#pragma unroll
        for (int i = 0; i < 16; ++i) { sA[i] = 0.f; sB[i] = 0.f; negm[c][i] = 0.f; }
#pragma unroll
        for (int x = 0; x < 4; ++x) pf[c][x >> 1][x & 1] = (bf16x8){0, 0, 0, 0, 0, 0, 0, 0};
#pragma unroll
        for (int d = 0; d < NDB; ++d)
#pragma unroll
            for (int i = 0; i < 16; ++i) o[c][d][i] = 0.f; }
    Chunk ck[NKJ], cr, cv[NVJ];
    constexpr int ESZ = F32 ? 4 : 2;
    int koff_[NKJ], krw_[NKJ], voff_[NVJ], vrw_[NVJ];
#pragma unroll
    for (int j = 0; j < NKJ; ++j) { const int q_ = tid + 512 * j; krw_[j] = q_ / KCH; koff_[j] = (krw_[j] * 512 + (q_ % KCH) * 8) * ESZ; }
#pragma unroll
    for (int j = 0; j < NVJ; ++j) { const int q_ = tid + 512 * j; vrw_[j] = q_ / VCH; voff_[j] = (vrw_[j] * 512 + (q_ % VCH) * 8) * ESZ; }
    cr.a = (u32x4){0u, 0u, 0u, 0u}; cr.b = cr.a;
    const int qq = (lane & 15) >> 2, pp = lane & 3, blk = (lane >> 4) & 1;
    const int kroff = r * KSTR + h * 16, vroff = (4 * h + qq) * VSTR + (16 * blk + 4 * pp) * 2;
#define AT_LOAD(t) do { const int kv0_ = (t) * 64; const bool fs_ = kv0_ < a.nsplit; const size_t tb_ = (size_t)(fs_ ? kv0_ : kv0_ - a.nsplit) * 512; \
        const GASP unsigned char* kbs_ = (const GASP unsigned char*)(fs_ ? a.Ka : a.Kb) + tb_ * ESZ; const GASP unsigned char* vbs_ = (const GASP unsigned char*)(fs_ ? a.Va : a.Vb) + tb_ * ESZ; \
        _Pragma("unroll") for (int j = 0; j < NKJ; ++j) ld_chunk2<F32>(ck[j], kbs_ + koff_[j], kv0_ + krw_[j] < a.nkeys); \
        if (MODE == 0) { if (tid < 256) ld_chunk2<false>(cr, (const GASP unsigned char*)a.Kr + (size_t)kv0_ * 64 + (size_t)((tid >> 2) * 64 + (tid & 3) * 16), kv0_ + (tid >> 2) < a.nkeys); } \
        _Pragma("unroll") for (int j = 0; j < NVJ; ++j) ld_chunk2<F32>(cv[j], vbs_ + voff_[j], kv0_ + vrw_[j] < a.nkeys); } while (0)
#define AT_COMMIT(t) do { LAS unsigned char* kb_ = lds + ((t) % 3) * KBY; LAS unsigned char* vb_ = lds + 3 * KBY + ((t) & 3) * VBY; \
        _Pragma("unroll") for (int j = 0; j < NKJ; ++j) { const int q_ = tid + 512 * j, rw_ = q_ / KCH, ch_ = q_ % KCH; *(LAS u32x4*)(kb_ + rw_ * KSTR + ch_ * 16) = cvt_chunk<F32>(ck[j]); } \
        if (MODE == 0) { if (tid < 256) { const int rw_ = tid >> 2, ch_ = tid & 3; *(LAS u32x4*)(kb_ + rw_ * KSTR + 128 + ch_ * 16) = cr.a; } } \
        _Pragma("unroll") for (int j = 0; j < NVJ; ++j) { const int q_ = tid + 512 * j, rw_ = q_ / VCH, ch_ = q_ % VCH; *(LAS u32x4*)(vb_ + rw_ * VSTR + ch_ * 16) = cvt_chunk<F32>(cv[j]); } } while (0)
#define AT_QKC(tt, c) do { const LAS unsigned char* kp_ = lds + (((tt) % 3) * KBY + kroff); const bool halft_ = (a.nkeys - (tt) * 64) <= 32; \
        f32x16 s0_ = negm[c], s1_ = negm[c];     \
        constexpr int KSN_ = (MODE == 1) ? 2 : NKS; constexpr int KBT_ = (KSN_ > 4) ? ((KSN_ % 4 == 0) ? 4 : 3) : KSN_; \
        _Pragma("unroll") for (int kb0 = 0; kb0 < KSN_; kb0 += KBT_) { \
            bf16x8 kf_[2 * KBT_]; \
            _Pragma("unroll") for (int ks = 0; ks < KBT_; ++ks) { const int kk = ((MODE == 1) ? 2 * (c) : 0) + kb0 + ks; \
                kf_[2 * ks] = *(const LAS bf16x8*)(kp_ + kk * 32); kf_[2 * ks + 1] = *(const LAS bf16x8*)(kp_ + 32 * KSTR + kk * 32); } \
            __builtin_amdgcn_sched_barrier(0); \
            _Pragma("unroll") for (int ks = 0; ks < KBT_; ++ks) { const int kk = ((MODE == 1) ? 2 * (c) : 0) + kb0 + ks; \
                s0_ = __builtin_amdgcn_mfma_f32_32x32x16_bf16(kf_[2 * ks], qf[kk], s0_, 0, 0, 0); \
                s1_ = __builtin_amdgcn_mfma_f32_32x32x16_bf16(kf_[2 * ks + 1], qf[kk], s1_, 0, 0, 0); } \
            __builtin_amdgcn_sched_barrier(0); } \
        if (halft_) { _Pragma("unroll") for (int i = 0; i < 16; ++i) s1_[i] = -1e30f; } \
        sA = s0_; sB = s1_; } while (0)
#define AT_SM(tt, c) do { \
        float mx = fmaxf(sA[0], sB[0]); \
        _Pragma("unroll") for (int i = 1; i < 16; ++i) mx = fmaxf(fmaxf(sA[i], sB[i]), mx); \
        mx = fmaxf(mx, __shfl_xor(mx, 32)); \
        if ((tt) == 0) {     \
            mrun[c] = mx; \
            _Pragma("unroll") for (int i = 0; i < 16; ++i) { sA[i] -= mx; sB[i] -= mx; negm[c][i] = -mx; } \
        } else if (__any(mx > THR)) {     \
            const float dl = fmaxf(mx, 0.f); const float al = __builtin_amdgcn_exp2f(-dl); mrun[c] += dl; lrun[c] *= al; \
            _Pragma("unroll") for (int d = 0; d < NDB; ++d) _Pragma("unroll") for (int i = 0; i < 16; ++i) o[c][d][i] *= al; \
            const float nm = -mrun[c]; \
            _Pragma("unroll") for (int i = 0; i < 16; ++i) { sA[i] -= dl; sB[i] -= dl; negm[c][i] = nm; } } \
        float ps = 0.f; \
        _Pragma("unroll") for (int i = 0; i < 16; ++i) { sA[i] = __builtin_amdgcn_exp2f(sA[i]); sB[i] = __builtin_amdgcn_exp2f(sB[i]); ps += sA[i] + sB[i]; } \
        lrun[c] += ps; \
        pf[c][0][0] = pack8(sA, 0); pf[c][0][1] = pack8(sA, 8); pf[c][1][0] = pack8(sB, 0); pf[c][1][1] = pack8(sB, 8); } while (0)
#define AT_VRD(tt, d0) do { const LAS unsigned char* vp0_ = lds + (3 * KBY + ((tt) & 3) * VBY + vroff); \
        _Pragma("unroll") for (int dd = 0; dd < NDH; ++dd) _Pragma("unroll") for (int kb = 0; kb < 2; ++kb) _Pragma("unroll") for (int sp = 0; sp < 2; ++sp) { \
            const LAS unsigned char* vp = vp0_ + ((kb * 32 + sp * 16) * VSTR + ((d0) + dd) * 64); \
            vlo_[dd * 4 + kb * 2 + sp] = vtr(vp); vhi_[dd * 4 + kb * 2 + sp] = vtr(vp + 8 * VSTR); } } while (0)
#define AT_PVM(d0) do { _Pragma("unroll") for (int dd = 0; dd < NDH; ++dd) _Pragma("unroll") for (int kb = 0; kb < 2; ++kb) _Pragma("unroll") for (int sp = 0; sp < 2; ++sp) { \
            const s16x4 lo = vlo_[dd * 4 + kb * 2 + sp], hi = vhi_[dd * 4 + kb * 2 + sp]; \
            const bf16x8 vf = (bf16x8){lo[0], lo[1], lo[2], lo[3], hi[0], hi[1], hi[2], hi[3]}; \
            _Pragma("unroll") for (int c = 0; c < NS; ++c) o[c][(d0) + dd] = __builtin_amdgcn_mfma_f32_32x32x16_bf16(vf, pf[c][kb][sp], o[c][(d0) + dd], 0, 0, 0); } } while (0)
#define AT_PHA(tt) do { AT_QKC(tt, 0); if (MODE == 1) { AT_SM(tt, 0); } } while (0)
#define AT_PHB(tt) do { s16x4 vlo_[NDH * 4], vhi_[NDH * 4]; \
        AT_VRD(tt, 0); \
        __builtin_amdgcn_sched_barrier(0); \
        if (MODE == 1) { AT_QKC(tt, 1); AT_SM(tt, NS - 1); } else { AT_SM(tt, 0); } \
        __builtin_amdgcn_sched_barrier(0); \
        AT_PVM(0); \
        _Pragma("unroll") for (int d0 = NDH; d0 < NDB; d0 += NDH) { __builtin_amdgcn_sched_barrier(0); AT_VRD(tt, d0); __builtin_amdgcn_sched_barrier(0); AT_PVM(d0); } } while (0)
#define AT_BAR() asm volatile("s_waitcnt lgkmcnt(0)\n\ts_barrier" ::: "memory")
    AT_LOAD(0); AT_COMMIT(0);
    if (NT > 1) { AT_LOAD(1); AT_COMMIT(1); }
    AT_BAR();
    if (late) AT_BAR();
    for (int t = 0; t < NT; ++t) {
        if (PREF && t + 2 < NT) AT_LOAD(t + 2);
        if (PVA) {
            const bool pvok = t >= 1 && t - 1 < ntw;
            s16x4 vlo_[NDH * 4], vhi_[NDH * 4];
            if (pvok) AT_VRD(t - 1, 0);
            __builtin_amdgcn_sched_barrier(0);
            if (t < ntw) AT_QKC(t, 0);
            if (pvok) { AT_PVM(0);
#pragma unroll
                for (int d0 = NDH; d0 < NDB; d0 += NDH) { __builtin_amdgcn_sched_barrier(0); AT_VRD(t - 1, d0); __builtin_amdgcn_sched_barrier(0); AT_PVM(d0); } }
        } else { if (t < ntw) AT_PHA(t); }
        AT_BAR();
        if (t < ntw) { if (PVA) { AT_SM(t, 0); } else { AT_PHB(t); } }
        if (t + 2 < NT) { if (!PREF) AT_LOAD(t + 2); AT_COMMIT(t + 2); }
        AT_BAR();
    }
    if (PVA && ntw == NT && ntw > 0) {
        s16x4 vlo_[NDH * 4], vhi_[NDH * 4];
#pragma unroll
        for (int d0 = 0; d0 < NDB; d0 += NDH) { AT_VRD(NT - 1, d0); __builtin_amdgcn_sched_barrier(0); AT_PVM(d0); __builtin_amdgcn_sched_barrier(0); }
    }
    if (!late) AT_BAR();
    AT_BAR();
#undef AT_LOAD
#undef AT_COMMIT
#undef AT_QKC
#undef AT_SM
#undef AT_PHA
#undef AT_PHB
#undef AT_VRD
#undef AT_PVM
#undef AT_BAR
    if (active) {
        const int qi = wave * 32 + r;
        float inv[NS];
#pragma unroll
        for (int c = 0; c < NS; ++c) { const float lt = lrun[c] + __shfl_xor(lrun[c], 32); inv[c] = 1.f / lt; }
        float rs = 1.f;
        if (MODE == 1) {
            float ss = 0.f;
#pragma unroll
            for (int d = 0; d < NDB; ++d)
#pragma unroll
                for (int i = 0; i < 16; ++i) { const float v = o[0][d][i] * inv[0] - a.lam * (o[NS - 1][d][i] * inv[NS - 1]); o[0][d][i] = v; ss += v * v; }
            ss += __shfl_xor(ss, 32);
            rs = rsqrtf(ss * (1.f / 64.f) + EPSN) * (1.f - LAM_INIT);
        } else rs = inv[0];
        bf16* op = a.O + (size_t)(a.qrow0 + qi) * 512;
#pragma unroll
        for (int d = 0; d < NDB; ++d)
#pragma unroll
            for (int g4 = 0; g4 < 4; ++g4) {
                const int dc = d * 32 + 8 * g4 + 4 * h;
                float w0 = o[0][d][4 * g4] * rs, w1 = o[0][d][4 * g4 + 1] * rs, w2 = o[0][d][4 * g4 + 2] * rs, w3 = o[0][d][4 * g4 + 3] * rs;
                if (MODE == 1) { const f32x4 gg = *(const f32x4*)(a.subg + dc); w0 *= gg[0]; w1 *= gg[1]; w2 *= gg[2]; w3 *= gg[3]; }
                u32x2 w; w.x = pk2(w0, w1); w.y = pk2(w2, w3);
                if (qi < a.nq) *(u32x2*)(op + dc) = w;
            }
    }
}

DI void p0_transpose_item(const float* W, int K, int N, bf16* WT, int row_off, LAS float* scr, int item, int lane) {
    const int nblk = N / 32, kb = item / nblk, nb = item % nblk, k0 = 64 * kb, n0 = 32 * nb;
#pragma unroll 8
    for (int i = 0; i < 32; ++i) { const int kk = 2 * i + (lane >> 5); scr[kk * 33 + (lane & 31)] = W[(size_t)(k0 + kk) * N + n0 + (lane & 31)]; }
    asm volatile("s_waitcnt lgkmcnt(0)" ::: "memory");
    const int c = lane & 7;
#pragma unroll
    for (int j = 0; j < 4; ++j) { const int n = (lane >> 3) + 8 * j; const LAS float* s = scr + (8 * c) * 33 + n;
        u32x4 o; o.x = pk2(s[0 * 33], s[1 * 33]); o.y = pk2(s[2 * 33], s[3 * 33]); o.z = pk2(s[4 * 33], s[5 * 33]); o.w = pk2(s[6 * 33], s[7 * 33]);
        *(u32x4*)(WT + (size_t)(row_off + n0 + n) * K + k0 + 8 * c) = o; }
    asm volatile("s_waitcnt lgkmcnt(0)" ::: "memory");
}
DI void rms_row_1024(const float* xrow, const float* g, bf16* orow, int lane) {
    const f32x4* xr = (const f32x4*)xrow + lane; const f32x4* gr = (const f32x4*)g + lane;
    f32x4 v[4]; float s = 0.f;
#pragma unroll
    for (int j = 0; j < 4; ++j) { v[j] = xr[64 * j]; s += (v[j].x * v[j].x + v[j].y * v[j].y) + (v[j].z * v[j].z + v[j].w * v[j].w); }
    const float rstd = rsqrtf(wave_sum(s) * (1.f / 1024.f) + EPSN);
    u32x2* o8 = (u32x2*)orow + lane;
#pragma unroll
    for (int j = 0; j < 4; ++j) { const f32x4 gg = gr[64 * j]; u32x2 w; w.x = pk2(v[j].x * rstd * gg.x, v[j].y * rstd * gg.y); w.y = pk2(v[j].z * rstd * gg.z, v[j].w * rstd * gg.w); o8[64 * j] = w; }
}


template <int K> DI const float* inp_ld() {
    auto kp = __builtin_amdgcn_kernarg_segment_ptr();
    unsigned long long v;
    asm volatile("s_load_dwordx2 %0, %1, %2\n\ts_waitcnt lgkmcnt(0)" : "=s"(v) : "s"(kp), "n"(K * 8));
    return (const float*)(const __attribute__((address_space(1))) float*)v;
}
#define INP(k) inp_ld<k>()


#define RLX_AGENT __ATOMIC_RELAXED, __HIP_MEMORY_SCOPE_AGENT
#define XB_TMO      128
#define XB_XCNT(j)  (256  + 64 * (j))
#define XB_XSUB(j)  (1280 + 64 * (j))
#define XB_XGEN(j)  (2304 + 64 * (j))
#define XB_TOP      3328
#define XB_TOPGEN   3392
#define XCD_BAR_WORDS 3456
#define XB_SPIN_CAP (1u << 18)

__device__ __forceinline__ unsigned xb_ld(unsigned* p)              { return __hip_atomic_load(p, __ATOMIC_RELAXED, __HIP_MEMORY_SCOPE_AGENT); }
__device__ __forceinline__ unsigned xb_add(unsigned* p, unsigned v) { return __hip_atomic_fetch_add(p, v, __ATOMIC_RELAXED, __HIP_MEMORY_SCOPE_AGENT); }
__device__ __forceinline__ unsigned xb_xcc_id() { return (unsigned)__builtin_amdgcn_s_getreg((3 << 11) | 20) & 0xFu; }
#define XB_SPIN(cond, bar) do { unsigned _sp = 0; while (cond) { __builtin_amdgcn_s_sleep(1); \
    if ((++_sp & 255u) == 0u) { if (xb_ld(&(bar)[XB_TMO])) break; if (_sp > XB_SPIN_CAP) { atomicAdd(&(bar)[XB_TMO], 1u); break; } } } } while (0)

struct XcdBarrier {
    unsigned* bar; unsigned x;
    volatile LAS unsigned* st;
};

__device__ __forceinline__ XcdBarrier xcd_barrier_post(unsigned* bar, volatile LAS unsigned* st) {
    XcdBarrier b; b.bar = bar; b.x = xb_xcc_id(); b.st = st;
    if (threadIdx.x == 0) (void)xb_add(&bar[XB_XCNT(b.x)], 1u);
    return b;
}
__device__ __forceinline__ void xcd_barrier_complete(unsigned* bar, unsigned x, unsigned& nloc, unsigned& nx) {
    const unsigned G = gridDim.x * gridDim.y * gridDim.z;
    unsigned sum, cnt, mine, sp = 0u;
    for (;;) {
        sum = 0u; cnt = 0u; mine = 0u;
#pragma unroll
        for (unsigned j = 0; j < 16; ++j) { const unsigned c = xb_ld(&bar[XB_XCNT(j)]); sum += c; cnt += (c > 0u) ? 1u : 0u; mine = (j == x) ? c : mine; }
        if (sum == G) break;
        __builtin_amdgcn_s_sleep(1);
        if ((++sp & 255u) == 0u) { if (xb_ld(&bar[XB_TMO])) break; if (sp > XB_SPIN_CAP) { atomicAdd(&bar[XB_TMO], 1u); break; } }
    }
    nloc = mine > 0u ? mine : 1u; nx = cnt > 0u ? cnt : 1u;
}

__device__ __forceinline__ void xcd_barrier(const XcdBarrier& b) {
    asm volatile("s_waitcnt vmcnt(0)" ::: "memory");
    __syncthreads();
    if (threadIdx.x == 0) {
        unsigned* bar = b.bar;
        __builtin_amdgcn_s_waitcnt(0);
        unsigned nloc = b.st[0], nx = b.st[1];
        if (nloc == 0u) { xcd_barrier_complete(bar, b.x, nloc, nx); b.st[0] = nloc; b.st[1] = nx; }
        const unsigned old = xb_add(&bar[XB_XSUB(b.x)], 1u);
        const unsigned gen = old / nloc;
        if (old + 1u == (gen + 1u) * nloc) {
            __builtin_amdgcn_fence(__ATOMIC_RELEASE, "agent");
            asm volatile("s_waitcnt vmcnt(0)" ::: "memory");
            const unsigned og = xb_add(&bar[XB_TOP], 1u);
            const unsigned tg = og / nx;
            if (og + 1u == (tg + 1u) * nx) xb_add(&bar[XB_TOPGEN], 1u);
            else XB_SPIN(xb_ld(&bar[XB_TOPGEN]) == tg, bar);
            __builtin_amdgcn_fence(__ATOMIC_ACQUIRE, "agent");
            xb_add(&bar[XB_XGEN(b.x)], 1u);
            asm volatile("s_waitcnt vmcnt(0)" ::: "memory");
        } else {
            XB_SPIN(xb_ld(&bar[XB_XGEN(b.x)]) == gen, bar);
            __builtin_amdgcn_fence(__ATOMIC_ACQUIRE, "agent");
            asm volatile("s_waitcnt vmcnt(0)" ::: "memory");
        }
    }
    __syncthreads();
}

struct Args { const float* in[35]; float* out; unsigned char* ws; int ph_lo, ph_hi; };

constexpr int NPHASE = 11;
constexpr int LDS_BYTES = 147456;

__global__ void __launch_bounds__(512, 2) fwd_kernel(Args args) {
    extern __shared__ __attribute__((aligned(16))) unsigned char lds_raw[];
    LAS unsigned char* lds = (LAS unsigned char*)lds_raw;
    cg::grid_group grid = cg::this_grid();
    volatile LAS unsigned* MISC = (volatile LAS unsigned*)(lds + 131072 + 320);
    if (threadIdx.x < 64) MISC[threadIdx.x] = 0u;
    __syncthreads();
    XcdBarrier xbar; xbar.bar = (unsigned*)args.ws; xbar.x = 0; xbar.st = MISC + 8;
    const int G = gridDim.x, bid = blockIdx.x;
    const int NGW = G * 8;
#define PHASE_IDS int tid = threadIdx.x; asm volatile("" : "+v"(tid)); const int lane = tid & 63, wave = __builtin_amdgcn_readfirstlane(tid >> 6); const int gw = bid * 8 + wave; (void)lane; (void)gw;
    unsigned char* ws = args.ws; float* out = args.out;
    const int lo = args.ph_lo, hi = args.ph_hi;
#ifndef PHM
#define PHM 0x7ff
#endif
#define IN(k) (((PHM >> (k)) & 1) && lo <= (k) && (k) < hi)
#ifndef REPM
#define REPM 0
#endif
#define REPS(k) for (int rq_ = 0; rq_ < (((REPM >> (k)) & 1) ? 2 : 1); ++rq_)
#define SEAM(k) do { if (IN(k) && IN((k) + 1)) { if ((k) == 0) { grid.sync(); xbar = xcd_barrier_post((unsigned*)args.ws, MISC + 8); } else xcd_barrier(xbar); } } while (0)
#define XN ((bf16*)(ws + WS_XN))
#define GB ((bf16*)(ws + WS_G))
#define CQ ((bf16*)(ws + WS_CQ))
#define CQN ((bf16*)(ws + WS_CQN))
#define QM ((bf16*)(ws + WS_QM))
#define DQ ((bf16*)(ws + WS_DQ))
#define MQ ((bf16*)(ws + WS_MQ))
#define DKP ((bf16*)(ws + WS_DKP))
#define DVP ((bf16*)(ws + WS_DVP))
#define KR ((bf16*)(ws + WS_KR))
#define MKB ((bf16*)(ws + WS_MK))
#define MVB ((bf16*)(ws + WS_MV))
#define LAT ((bf16*)(ws + WS_LAT))
#define KN ((bf16*)(ws + WS_KN))
#define VM ((bf16*)(ws + WS_VM))
#define OA ((bf16*)(ws + WS_OA))
#define MRG ((float*)(ws + WS_MRG))
#define MRGB ((bf16*)(ws + WS_MRGB))
#define MIX ((float*)(ws + WS_MIX))
#define UB ((bf16*)(ws + WS_U))
#define TABM ((float*)(ws + WS_TABM))
#define TABD ((float*)(ws + WS_TABD))

    if (IN(0)) REPS(0) {
        PHASE_IDS
        LAS float* scr = (LAS float*)(lds + wave * 16384);
        {
            constexpr int I_IN = 16 * 85, I_G = 16 * 96, I_UQ = 6 * 24, I_UK = 4 * 16, I_MK = 16 * 16, I_O = 8 * 32, I_OUT = 16 * 32, I_UP = 16 * 128, I_DN = 64 * 32;
            constexpr int NITEMS = I_IN + I_G + I_UQ + 2 * I_UK + 2 * I_MK + 3 * I_O + I_OUT + I_UP + I_DN;
            for (int it = gw; it < NITEMS; it += NGW) {
                int r = it;
                if (r < I_IN) { p0_transpose_item(INP(10), 1024, 2720, (bf16*)(ws + W_ING), 0, scr, r, lane); continue; } r -= I_IN;
                if (r < I_G) { p0_transpose_item(INP(27), 1024, 3072, (bf16*)(ws + W_ING), INWP, scr, r, lane); continue; } r -= I_G;
                if (r < I_UQ) { p0_transpose_item(INP(12), 384, 768, (bf16*)(ws + W_UQ), 0, scr, r, lane); continue; } r -= I_UQ;
                if (r < I_UK) { p0_transpose_item(INP(14), 256, 512, (bf16*)(ws + W_UKV), 0, scr, r, lane); continue; } r -= I_UK;
                if (r < I_UK) { p0_transpose_item(INP(15), 256, 512, (bf16*)(ws + W_UKV), 512, scr, r, lane); continue; } r -= I_UK;
                if (r < I_MK) { p0_transpose_item(INP(22), 1024, 512, (bf16*)(ws + W_MEM), 0, scr, r, lane); continue; } r -= I_MK;
                if (r < I_MK) { p0_transpose_item(INP(23), 1024, 512, (bf16*)(ws + W_MEM), 512, scr, r, lane); continue; } r -= I_MK;
                if (r < I_O) { p0_transpose_item(INP(24), 512, 1024, (bf16*)(ws + W_OM), 0, scr, r, lane); continue; } r -= I_O;
                if (r < I_O) { p0_transpose_item(INP(25), 512, 1024, (bf16*)(ws + W_OM), 1024, scr, r, lane); continue; } r -= I_O;
                if (r < I_O) { p0_transpose_item(INP(26), 512, 1024, (bf16*)(ws + W_OM), 2048, scr, r, lane); continue; } r -= I_O;
                if (r < I_OUT) { p0_transpose_item(INP(29), 1024, 1024, (bf16*)(ws + W_OUT), 0, scr, r, lane); continue; } r -= I_OUT;
                if (r < I_UP) { p0_transpose_item(INP(32), 1024, 4096, (bf16*)(ws + W_UP), 0, scr, r, lane); continue; } r -= I_UP;
                p0_transpose_item(INP(33), 4096, 1024, (bf16*)(ws + W_DN), 0, scr, r, lane);
            }
        }
        if (bid == 0) for (int i = tid; i < XCD_BAR_WORDS; i += 512) __hip_atomic_store((unsigned*)ws + i, 0u, RLX_AGENT);
        for (int i = gw * 64 + lane; i < 96 * 1024 / 8; i += NGW * 64) *(u32x4*)((bf16*)(ws + W_ING) + (size_t)2720 * 1024 + (size_t)i * 8) = (u32x4){0u, 0u, 0u, 0u};
        for (int m = gw; m < MROWS + NMEM; m += NGW) {
            if (m < SEQ) rms_row_1024(INP(0) + (size_t)m * DM, INP(9), XN + (size_t)m * DM, lane);
            else if (m < MROWS) rms_row_1024(INP(1) + (size_t)(m - SEQ) * DM, INP(9), XN + (size_t)m * DM, lane);
            else rms_row_1024(INP(8) + (size_t)(m - MROWS) * DM, INP(21), MRGB + (size_t)(m - MROWS) * DM, lane);
        }
        for (int i = gw; i < NSB * PAST; i += NGW) {
            const int b = i >> 12, s = i & 4095;
            const f32x4 v = *((const f32x4*)(INP(2) + (size_t)i * 256) + lane);
            u32x2 w; w.x = pk2(v.x, v.y); w.y = pk2(v.z, v.w);
            *((u32x2*)(LAT + (size_t)(SEQ + b * SKEYS + s) * 256) + lane) = w;
        }
        for (int i = gw; i < NSB * PAST / 8; i += NGW) {
            const int rowi = i * 8 + (lane >> 3); const int b = rowi >> 12, s = rowi & 4095;
            const f32x4 v = *((const f32x4*)(INP(3) + (size_t)rowi * 32) + (lane & 7));
            u32x2 w; w.x = pk2(v.x, v.y); w.y = pk2(v.z, v.w);
            *((u32x2*)(KR + (size_t)(SEQ + b * SKEYS + s) * 32) + (lane & 7)) = w;
        }
        for (int i = gw * 64 + lane; i < NSB * NMEM * 512 / 4; i += NGW * 64) {
            const f32x4 a = *((const f32x4*)INP(6) + i), b = *((const f32x4*)INP(7) + i);
            u32x2 w; w.x = pk2(a.x, a.y); w.y = pk2(a.z, a.w); *((u32x2*)(MKB + (size_t)NMEM * 512) + i) = w;
            w.x = pk2(b.x, b.y); w.y = pk2(b.z, b.w); *((u32x2*)(MVB + (size_t)NMEM * 512) + i) = w;
        }
        for (int i = gw * 64 + lane; i < SEQ * 16; i += NGW * 64) {
            const int pos = i >> 4, f = i & 15;
            const float inv = powf(10000.0f, -(float)f * (2.0f / 32.0f)); const float ang = (float)pos * inv;
            TABM[(size_t)pos * 32 + f] = cosf(ang); TABM[(size_t)pos * 32 + 16 + f] = sinf(ang);
        }
        for (int i = gw * 64 + lane; i < SEQ * 4; i += NGW * 64) {
            const int pos = i >> 2, f = i & 3;
            const float inv = powf(500000.0f, -(float)f * (2.0f / 8.0f)); const float ang = (float)pos * inv;
            TABD[(size_t)pos * 8 + f] = cosf(ang); TABD[(size_t)pos * 8 + 4 + f] = sinf(ang);
        }
        asm volatile("s_waitcnt vmcnt(0) lgkmcnt(0)" ::: "memory");
        __syncthreads();
    }
    SEAM(0);

    if (IN(1)) REPS(1) {
        {
            pg8::Gemm g{MRGB, (const bf16*)(ws + W_MEM), NMEM, 1024, 1024}; pg8::StaticOrder S; S.init(NMEM, 1024, G, (bid + 4) % G);
            EpiMemKV E{out, MKB, MVB};
            pg8::gemm_phase<EpiMemKV, pg8::StaticOrder, true, true>(lds, g, S, E);
        }
        {
            pg8::Gemm g{XN, (const bf16*)(ws + W_ING), MROWS, NING, 1024}; pg8::StaticOrder S; S.init(MROWS, NING, G, bid);
            EpiP1 E{CQ, KR, DQ, DKP, DVP, MQ, GB, out, INP(28), TABM, TABD};
            pg8::gemm_phase<EpiP1, pg8::StaticOrder, true, true>(lds, g, S, E);
        }
    }
    SEAM(1);

    if (IN(2)) {
        PHASE_IDS
        for (int row = gw; row < MROWS; row += NGW) {
            {
                u32x4 raw = (u32x4){0u, 0u, 0u, 0u};
                if (lane < 48) raw = *((const u32x4*)(CQ + (size_t)row * 384) + lane);
                float v[8] = {bf_lo(raw.x), bf_hi(raw.x), bf_lo(raw.y), bf_hi(raw.y), bf_lo(raw.z), bf_hi(raw.z), bf_lo(raw.w), bf_hi(raw.w)};
                float s = 0.f;
#pragma unroll
                for (int e = 0; e < 8; ++e) s += v[e] * v[e];
                const float rstd = rsqrtf(wave_sum(s) * (1.f / 384.f) + EPSN);
                if (lane < 48) {
                    const f32x4 g0 = *((const f32x4*)INP(11) + 2 * lane), g1 = *((const f32x4*)INP(11) + 2 * lane + 1);
                    u32x4 w; w.x = pk2(v[0] * rstd * g0.x, v[1] * rstd * g0.y); w.y = pk2(v[2] * rstd * g0.z, v[3] * rstd * g0.w);
                    w.z = pk2(v[4] * rstd * g1.x, v[5] * rstd * g1.y); w.w = pk2(v[6] * rstd * g1.z, v[7] * rstd * g1.w);
                    *((u32x4*)(CQN + (size_t)row * 384) + lane) = w;
                }
            }
            {
                float* p = out_row(out, row, O_PCKV, O_SCKV, 256);
                f32x4 v = *((const f32x4*)p + lane);
                const float s = (v.x * v.x + v.y * v.y) + (v.z * v.z + v.w * v.w);
                const float rstd = rsqrtf(wave_sum(s) * (1.f / 256.f) + EPSN);
                const f32x4 gg = *((const f32x4*)INP(13) + lane);
                v.x *= rstd * gg.x; v.y *= rstd * gg.y; v.z *= rstd * gg.z; v.w *= rstd * gg.w;
                *((f32x4*)p + lane) = v;
                u32x2 w; w.x = pk2(v.x, v.y); w.y = pk2(v.z, v.w);
                *((u32x2*)(LAT + (size_t)row_krow(row) * 256) + lane) = w;
            }
        }
    }
    SEAM(2);

    if (IN(3)) REPS(3) {
#ifndef NO_P3A
        {
            pg8::Gemm g{CQN, (const bf16*)(ws + W_UQ), MROWS, 768, 384}; pg8::StaticOrder S; S.init(MROWS, 768, G, bid);
            EpiUQ E{QM, TABM};
            pg8::gemm_phase<EpiUQ, pg8::StaticOrder, true, true>(lds, g, S, E);
        }
#endif
#ifndef NO_P3B
        {
            pg8::Gemm g{LAT, (const bf16*)(ws + W_UKV), MKROWS, 1024, 256}; pg8::StaticOrder S; S.init(MKROWS, 1024, G, bid);
            EpiBf16Split E{KN, VM};
            pg8::gemm_phase<EpiBf16Split, pg8::StaticOrder, true, true>(lds, g, S, E);
        }
#endif
    }
    SEAM(3);

#ifndef REP_P4
#define REP_P4 1
#endif
    if (IN(4)) for (int rep_ = 0; rep_ < REP_P4; ++rep_) {
        PHASE_IDS
        float lam;
        {
            float sa = 0.f, sb = 0.f;
            if (lane < 32) { sa = INP(16)[lane] * INP(17)[lane]; sb = INP(18)[lane] * INP(19)[lane]; }
            sa = wave_sum(sa); sb = wave_sum(sb);
            lam = expf(sa) - expf(sb) + LAM_INIT;
        }
        constexpr int BIG = 1 << 30;
#define O_MLA OA
#define O_DIFF (OA + (size_t)MROWS * 512)
#define O_MEM (OA + (size_t)2 * MROWS * 512)
#ifndef KMASK
#define KMASK 15
#endif
#define AU_INIT(a) AU a; a.lam = lam; a.subg = INP(20); a.ldo = 512; a.Kb = nullptr; a.Vb = nullptr; a.Kr = KR; a.ldkr = 32; a.nsplit = BIG; a.ldk = 512; a.ldv = 512; a.limbase = BIG / 2;
#ifndef REP_MLA
#define REP_MLA 1
#endif
        if (KMASK & 1) for (int rp_ = 0; rp_ < REP_MLA; ++rp_) for (int it = bid; it < (rp_ == 0 ? 384 : 256); it += G) {
            const int ne = it < 256 ? 2 : 1;
#pragma unroll 1
            for (int e = 0; e < ne; ++e) {
                AU_INIT(a)
                if (it < 256) { const int head = it & 7, pair = it >> 3, qb = e == 0 ? 63 - pair : pair;
                    a.qrow0 = qb * 256; a.nq = 256; a.nkeys = (qb + 1) * 256; a.limbase = 4 * qb;
                    a.Q = QM + head * 96; a.ldq = 768; a.Ka = KN + head * 64; a.Va = VM + head * 64; a.O = O_MLA + head * 64;
                } else { const int jj = it - 256, b = jj >> 3, head = jj & 7; const size_t k0 = (size_t)SEQ + (size_t)b * SKEYS;
                    a.qrow0 = SEQ + b * 32; a.nq = 32; a.nkeys = SKEYS;
                    a.Q = QM + head * 96; a.ldq = 768; a.Ka = KN + k0 * 512 + head * 64; a.Kr = KR + k0 * 32; a.Va = VM + k0 * 512 + head * 64; a.O = O_MLA + head * 64; }
                attn_unit<0, false>(lds, a, tid);
            }
        }
#ifndef REP_DIFF
#define REP_DIFF 1
#endif
        if (KMASK & 2) for (int rp_ = 0; rp_ < REP_DIFF; ++rp_) for (int it = bid; it < 256; it += G) {
#pragma unroll 1
            for (int e = 0; e < 2; ++e) {
                AU_INIT(a)
                const int head = it & 7, pair = it >> 3, qb = e == 0 ? 63 - pair : pair;
                a.qrow0 = qb * 256; a.nq = 256; a.nkeys = (qb + 1) * 256; a.limbase = 4 * qb;
                a.Q = DQ + head * 64; a.ldq = 512; a.Ka = DKP + head * 64; a.Va = DVP + head * 64; a.O = O_DIFF + head * 64;
                attn_unit<1, false>(lds, a, tid);
            }
        }
        if (KMASK & 4) for (int it = (bid + G / 2) % G; it < 128; it += G) {
            AU_INIT(a)
            const int b = it >> 3, head = it & 7;
            a.qrow0 = SEQ + b * 32; a.nq = 32; a.nkeys = SKEYS; a.Q = DQ + head * 64; a.ldq = 512; a.nsplit = PAST;
            a.Ka = INP(4) + (size_t)b * PAST * 512 + head * 64; a.Kb = out + O_SDK + (size_t)b * 32 * 512 + head * 64;
            a.Va = INP(5) + (size_t)b * PAST * 512 + head * 64; a.Vb = out + O_SDV + (size_t)b * 32 * 512 + head * 64;
            a.O = O_DIFF + head * 64;
            attn_unit<1, true>(lds, a, tid);
        }
        if (KMASK & 8) for (int it = bid; it < 320; it += G) {
            AU_INIT(a)
            a.nkeys = NMEM; a.ldq = 512;
            if (it < 256) { const int qb = it >> 2, hm = it & 3; a.qrow0 = qb * 256; a.nq = 256; a.Q = MQ + hm * 128; a.Ka = MKB + hm * 128; a.Va = MVB + hm * 128; a.O = O_MEM + hm * 128; }
            else { const int jj = it - 256, b = jj >> 2, hm = jj & 3; a.qrow0 = SEQ + b * 32; a.nq = 32; a.Q = MQ + hm * 128;
                a.Ka = MKB + (size_t)(1 + b) * NMEM * 512 + hm * 128; a.Va = MVB + (size_t)(1 + b) * NMEM * 512 + hm * 128; a.O = O_MEM + hm * 128; }
            attn_unit<2, false>(lds, a, tid);
        }
#undef AU_INIT
    }
    SEAM(4);

    if (IN(5)) REPS(5) {
        const bf16* WOM = (const bf16*)(ws + W_OM);
        { pg8::Gemm g{OA, WOM, MROWS, 1024, 512}; pg8::StaticOrder S; S.init(MROWS, 1024, G, bid); EpiMerge<0> E{GB, MRG, MRGB};
          pg8::gemm_phase<EpiMerge<0>, pg8::StaticOrder, true, true>(lds, g, S, E); }
        { pg8::Gemm g{OA + (size_t)MROWS * 512, WOM + (size_t)1024 * 512, MROWS, 1024, 512}; pg8::StaticOrder S; S.init(MROWS, 1024, G, bid); EpiMerge<1> E{GB, MRG, MRGB};
          pg8::gemm_phase<EpiMerge<1>, pg8::StaticOrder, true, true>(lds, g, S, E); }
        { pg8::Gemm g{OA + (size_t)2 * MROWS * 512, WOM + (size_t)2048 * 512, MROWS, 1024, 512}; pg8::StaticOrder S; S.init(MROWS, 1024, G, bid); EpiMerge<2> E{GB, MRG, MRGB};
          pg8::gemm_phase<EpiMerge<2>, pg8::StaticOrder, true, true>(lds, g, S, E); }
    }
    SEAM(5);

    if (IN(6)) REPS(6) {
        { pg8::Gemm g{MRGB, (const bf16*)(ws + W_OUT), SEQ, 1024, 1024, 0}; pg8::StaticOrder S; S.init(SEQ, 1024, G, bid); EpiF32 E{MIX, 1024};
          pg8::gemm_phase<EpiF32, pg8::StaticOrder, true, true>(lds, g, S, E); }
        { int kl = 128; asm volatile("" : "+s"(kl));
          pg8::Gemm g{MRGB, (const bf16*)(ws + W_OUT), MROWS, 1024, 1024, kl}; PieceOrder S{8, kl, G, (bid + 96) % G}; EpiPart E{(float*)(ws + WS_PART), 7};
          pg8::gemm_phase<EpiPart, PieceOrder, true, true>(lds, g, S, E); }
    }
    SEAM(6);

    if (IN(7)) REPS(7) {
        PHASE_IDS
        for (int row = gw; row < MROWS; row += NGW) {
            const float* xr = row < SEQ ? INP(0) + (size_t)row * DM : INP(1) + (size_t)(row - SEQ) * DM;
            const f32x4* mr = (const f32x4*)(MIX + (size_t)row * DM) + lane;
            f32x4 v[4]; float s = 0.f;
#pragma unroll
            for (int j = 0; j < 4; ++j) {
                if (row < SEQ) v[j] = mr[64 * j];
                else { const f32x4* pr = (const f32x4*)((const float*)(ws + WS_PART) + (size_t)(row - SEQ) * DM) + lane + 64 * j; v[j] = pr[0];
#pragma unroll
                    for (int sl = 1; sl < 8; ++sl) v[j] += pr[(size_t)sl * (512 * 1024 / 4)]; }
                s += (v[j].x * v[j].x + v[j].y * v[j].y) + (v[j].z * v[j].z + v[j].w * v[j].w); }
            const float rstd = rsqrtf(wave_sum(s) * (1.f / 1024.f) + EPSN);
            float s2 = 0.f;
#pragma unroll
            for (int j = 0; j < 4; ++j) { const f32x4 gg = *((const f32x4*)INP(30) + lane + 64 * j); const f32x4 xx = *((const f32x4*)xr + lane + 64 * j);
                v[j].x = xx.x + v[j].x * rstd * gg.x; v[j].y = xx.y + v[j].y * rstd * gg.y; v[j].z = xx.z + v[j].z * rstd * gg.z; v[j].w = xx.w + v[j].w * rstd * gg.w;
                s2 += (v[j].x * v[j].x + v[j].y * v[j].y) + (v[j].z * v[j].z + v[j].w * v[j].w);
                *((f32x4*)(out + O_Y + (size_t)row * DM) + lane + 64 * j) = v[j]; }
            const float rstd2 = rsqrtf(wave_sum(s2) * (1.f / 1024.f) + EPSN);
#pragma unroll
            for (int j = 0; j < 4; ++j) { const f32x4 gg = *((const f32x4*)INP(31) + lane + 64 * j);
                u32x2 w; w.x = pk2(v[j].x * rstd2 * gg.x, v[j].y * rstd2 * gg.y); w.y = pk2(v[j].z * rstd2 * gg.z, v[j].w * rstd2 * gg.w);
                *((u32x2*)(XN + (size_t)row * DM) + lane + 64 * j) = w; }
        }
    }
    SEAM(7);

    if (IN(8)) REPS(8) {
        pg8::Gemm g{XN, (const bf16*)(ws + W_UP), MROWS, DFF, 1024}; pg8::StaticOrder S; S.init(MROWS, DFF, G, bid); EpiUp E{UB};
        pg8::gemm_phase<EpiUp, pg8::StaticOrder, true, true>(lds, g, S, E);
    }
    SEAM(8);

    if (IN(9)) REPS(9) {
        { pg8::Gemm g{UB, (const bf16*)(ws + W_DN), SEQ, 1024, DFF, 0}; pg8::StaticOrder S; S.init(SEQ, 1024, G, bid); EpiF32 E{MIX, 1024};
          pg8::gemm_phase<EpiF32, pg8::StaticOrder, true, true>(lds, g, S, E); }
        { pg8::Gemm g{UB, (const bf16*)(ws + W_DN), MROWS, 1024, DFF, 256}; PieceOrder S{16, 256, G, bid}; EpiPart E{(float*)(ws + WS_PART), 8};
          pg8::gemm_phase<EpiPart, PieceOrder, true, true>(lds, g, S, E); }
    }
    SEAM(9);

    if (IN(10)) {
        PHASE_IDS
        for (int row = gw; row < MROWS; row += NGW) {
            const f32x4* fr_ = (const f32x4*)(MIX + (size_t)row * DM) + lane;
            f32x4 v[4]; float s = 0.f;
#pragma unroll
            for (int j = 0; j < 4; ++j) {
                if (row < SEQ) v[j] = fr_[64 * j];
                else { const f32x4* pr = (const f32x4*)((const float*)(ws + WS_PART) + (size_t)(row - SEQ) * DM) + lane + 64 * j; v[j] = pr[0];
#pragma unroll
                    for (int sl = 1; sl < 16; ++sl) v[j] += pr[(size_t)sl * (512 * 1024 / 4)]; }
                s += (v[j].x * v[j].x + v[j].y * v[j].y) + (v[j].z * v[j].z + v[j].w * v[j].w); }
            const float rstd = rsqrtf(wave_sum(s) * (1.f / 1024.f) + EPSN);
#pragma unroll
            for (int j = 0; j < 4; ++j) { const f32x4 gg = *((const f32x4*)INP(34) + lane + 64 * j); f32x4* yp = (f32x4*)(out + O_Y + (size_t)row * DM) + lane + 64 * j; const f32x4 xx = *yp;
                f32x4 y; y.x = xx.x + v[j].x * rstd * gg.x; y.y = xx.y + v[j].y * rstd * gg.y; y.z = xx.z + v[j].z * rstd * gg.z; y.w = xx.w + v[j].w * rstd * gg.w; *yp = y; }
        }
    }
#undef IN
#undef SEAM
}

#ifndef MK_N_LAUNCHES
#define MK_N_LAUNCHES 1
#endif

extern "C" void kernel_launch(void* const* d_in, const int* in_sizes, int n_in, void* d_out, int out_size, void* d_ws, size_t ws_size, hipStream_t stream) {
    static int grid = 0;
    if (grid == 0) {
        if (n_in != 35 || out_size != (int)O_END || ws_size < WS_END) { fprintf(stderr, "kernel_launch: unexpected shapes: n_in %d out %d ws %zu\n", n_in, out_size, ws_size); grid = -1; return; }
        int dev = 0, cus = 0, per_cu = 0;
        hipGetDevice(&dev); hipDeviceGetAttribute(&cus, hipDeviceAttributeMultiprocessorCount, dev);
        if (hipFuncSetAttribute((const void*)fwd_kernel, hipFuncAttributeMaxDynamicSharedMemorySize, LDS_BYTES) != hipSuccess) { fprintf(stderr, "kernel_launch: hipFuncSetAttribute failed\n"); grid = -1; return; }
        hipOccupancyMaxActiveBlocksPerMultiprocessor(&per_cu, (const void*)fwd_kernel, 512, LDS_BYTES);
        (void)hipGetLastError();
        if (per_cu < 1) per_cu = 1;
        grid = cus;
    }
    if (grid < 0) return;
    Args a{};
    for (int i = 0; i < 35; ++i) a.in[i] = (const float*)d_in[i];
    a.out = (float*)d_out; a.ws = (unsigned char*)d_ws;
#if MK_N_LAUNCHES == 1
    a.ph_lo = 0; a.ph_hi = NPHASE;
    void* kargs[] = {&a};
    hipError_t e = hipLaunchCooperativeKernel((const void*)fwd_kernel, dim3(grid), dim3(512), kargs, LDS_BYTES, stream);
    if (e != hipSuccess) fprintf(stderr, "cooperative launch failed: %s (grid %d)\n", hipGetErrorString(e), grid);
#else
    for (int p = 0; p < NPHASE; ++p) { a.ph_lo = p; a.ph_hi = p + 1; hipLaunchKernelGGL(fwd_kernel, dim3(grid), dim3(512), LDS_BYTES, stream, a); }
#endif
}
```

```cpp
#include <hip/hip_runtime.h>
#include <hip/hip_cooperative_groups.h>
#include <cstdio>
#include <cstdint>
namespace cg = cooperative_groups;
namespace pg8 {
#define PG8_LAS __attribute__((address_space(3)))
typedef unsigned short bf16_t;
typedef short bf16x8 __attribute__((ext_vector_type(8)));
typedef float f32x4 __attribute__((ext_vector_type(4)));
typedef unsigned u32x4 __attribute__((ext_vector_type(4)));
constexpr int BM = 256, BK = 64, HALF = 128, HTB = HALF * BK * 2  , STAGE_BYTES = 8 * HTB, NXCD = 8, WGM = 8;

__host__ __device__ __forceinline__ int lds_byte(int r, int c) { const int st = (r >> 4) * 2 + (c >> 5), rr = r & 15, cc = c & 31, ob = rr * 64 + cc * 2; return st * 1024 + (ob ^ (((ob >> 9) & 1) << 5)); }
__host__ __device__ __forceinline__ void stage_rc(int b, int& R, int& C) { const int st = b / 1024, sb = b % 1024, swz = sb ^ (((sb >> 9) & 1) << 5); R = (st >> 1) * 16 + swz / 64; C = (st & 1) * 32 + (swz % 64) / 2; }
__host__ __device__ __forceinline__ int perm32(int rho) { const int n = rho >> 4, i = rho & 15; return 8 * (i >> 2) + 4 * n + (i & 3); }

struct Unit { int pm, pn, kofs; };
struct Gemm { const bf16_t* A; const bf16_t* Bt; int M, N, K, KL; };

struct StaticOrder {
    int nM, nN, nwg, G, c;
    __host__ __device__ void init(int M, int N, int G_, int c_) { nM = M / BM; nN = N / BM; nwg = nM * nN; G = G_; c = c_; }
    __host__ __device__ bool next(int i, Unit& u) const {
        const long L = (long)i * G + c; if (L >= nwg) return false;
        int wgid = (int)L; { const int q = nwg / NXCD, r = nwg % NXCD, xcd = wgid % NXCD, off = wgid / NXCD; wgid = (xcd < r ? xcd * (q + 1) : r * (q + 1) + (xcd - r) * q) + off; }
        const int nig = WGM * nN, gid = wgid / nig, fm = gid * WGM, gsz = (nM - fm) < WGM ? (nM - fm) : WGM;
        u.pm = fm + ((wgid % nig) % gsz); u.pn = (wgid % nig) / gsz; u.kofs = 0; return true;
    }
    __device__ __forceinline__ void a_ready(const Unit&) const {}
    __device__ __forceinline__ void done(const Unit&) const {}
};

__device__ __forceinline__ unsigned cvt_pk_bf16(float lo, float hi) { unsigned r; asm volatile("v_cvt_pk_bf16_f32 %0, %1, %2" : "=v"(r) : "v"(lo), "v"(hi)); return r; }
template <class Epi, class Sched, bool ALIGN_EPI = false, bool SP2 = false>
__device__ __forceinline__ void gemm_phase(PG8_LAS unsigned char* lds, const Gemm g, const Sched& S, const Epi& E) {
    int tid_l = threadIdx.x; asm volatile("" : "+v"(tid_l));
    const int tid = tid_l, wid = __builtin_amdgcn_readfirstlane(tid >> 6), lane = tid & 63, wr = wid >> 2, wc = wid & 3, fr = lane & 15, fq = lane >> 4;
    const int K = g.K, nt = (g.KL ? g.KL : K) / BK;
    unsigned voffA[2], voffB[2];
#pragma unroll
    for (int i = 0; i < 2; ++i) { int R, C; stage_rc(tid * 16 + i * 8192, R, C); const int Rb = Epi::PERM ? ((R & ~31) + perm32(R & 31)) : R;
        voffA[i] = (unsigned)(R * K + C) * 2u; voffB[i] = (unsigned)(Rb * K + C) * 2u; }
    const size_t kstep = (size_t)(BK * 2);
    const size_t hstep = (size_t)HALF * K * 2;
    const size_t tstep = 2 * hstep;
    const unsigned ldsw = (unsigned)wid * 1024u;
    const int aoff = lds_byte(wr * 64 + fr, fq * 8), boff = lds_byte(wc * 32 + fr, fq * 8);
#define PG8_SA(b, h) (((b) * 2 + (h)) * HTB)
#define PG8_SB(b, h) ((4 + (b) * 2 + (h)) * HTB)
#define PG8_STAGE(bufoff, gbase, voff) do { _Pragma("unroll") for (int _i = 0; _i < 2; ++_i) \
        __builtin_amdgcn_global_load_lds((const unsigned*)((const char*)(gbase) + (voff)[_i]), (PG8_LAS unsigned*)(lds + (bufoff) + ldsw + _i * 8192), 16, 0, 0); } while (0)
#define PG8_LDA(dst, b, h) do { _Pragma("unroll") for (int m = 0; m < 4; ++m) _Pragma("unroll") for (int k = 0; k < 2; ++k) dst[m][k] = *(const PG8_LAS bf16x8*)(lds + PG8_SA(b, h) + aoff + m * 2048 + k * 1024); } while (0)
#define PG8_LDB(dst, b, h) do { _Pragma("unroll") for (int n = 0; n < 2; ++n) _Pragma("unroll") for (int k = 0; k < 2; ++k) dst[n][k] = *(const PG8_LAS bf16x8*)(lds + PG8_SB(b, h) + boff + n * 2048 + k * 1024); } while (0)
#define PG8_MMA(ai, bj, At, Bt) do { __builtin_amdgcn_s_setprio(1); _Pragma("unroll") for (int m = 0; m < 4; ++m) _Pragma("unroll") for (int n = 0; n < 2; ++n) _Pragma("unroll") for (int k = 0; k < 2; ++k) \
        acc[ai][bj][m][n] = __builtin_amdgcn_mfma_f32_16x16x32_bf16(Bt[n][k], At[m][k], acc[ai][bj][m][n], 0, 0, 0); __builtin_amdgcn_s_setprio(0); } while (0)
#define PG8_WAIT_V(n) asm volatile("s_waitcnt vmcnt(" #n ")" ::: "memory")
#define PG8_WAIT_L(n) asm volatile("s_waitcnt lgkmcnt(" #n ")" ::: "memory")
#define PG8_BAR __builtin_amdgcn_s_barrier()
#define PG8_SCHED __builtin_amdgcn_sched_barrier(0)
    Unit cur, nxt; int ui = 0;
    if (!S.next(0, cur)) return;
    f32x4 acc[2][2][4][2];
#pragma unroll
    for (int a = 0; a < 2; ++a)
#pragma unroll
        for (int b = 0; b < 2; ++b)
#pragma unroll
            for (int m = 0; m < 4; ++m)
#pragma unroll
                for (int n = 0; n < 2; ++n) acc[a][b][m][n] = (f32x4){0.f, 0.f, 0.f, 0.f};
    bf16x8 At[4][2], B0[2][2], B1[2][2];
    const char* cA = (const char*)g.A + (size_t)cur.pm * tstep + (size_t)cur.kofs * 2; const char* cB = (const char*)g.Bt + (size_t)cur.pn * tstep + (size_t)cur.kofs * 2;
    S.a_ready(cur);
    if constexpr (SP2) {
        PG8_STAGE(PG8_SB(0, 0), cB, voffB); PG8_STAGE(PG8_SB(0, 1), cB + hstep, voffB); PG8_STAGE(PG8_SA(0, 0), cA, voffA); PG8_STAGE(PG8_SA(0, 1), cA + hstep, voffA);
        if (wr == 1) PG8_BAR;
        PG8_WAIT_V(2); PG8_BAR;
        PG8_STAGE(PG8_SB(1, 0), cB + kstep, voffB); PG8_STAGE(PG8_SA(1, 0), cA + kstep, voffA); PG8_STAGE(PG8_SB(1, 1), cB + hstep + kstep, voffB);
        PG8_WAIT_V(6); PG8_BAR;
    } else {
        PG8_STAGE(PG8_SB(0, 0), cB, voffB); PG8_STAGE(PG8_SA(0, 0), cA, voffA); PG8_STAGE(PG8_SB(0, 1), cB + hstep, voffB); PG8_STAGE(PG8_SA(0, 1), cA + hstep, voffA);
        if (wr == 1) PG8_BAR;
        PG8_WAIT_V(4); PG8_BAR;
        PG8_STAGE(PG8_SB(1, 0), cB + kstep, voffB); PG8_STAGE(PG8_SA(1, 0), cA + kstep, voffA); PG8_STAGE(PG8_SB(1, 1), cB + hstep + kstep, voffB);
        PG8_WAIT_V(6); PG8_BAR;
    }
    for (;;) {
        const bool has_next = S.next(ui + 1, nxt);
        const char* nA = has_next ? (const char*)g.A + (size_t)nxt.pm * tstep + (size_t)nxt.kofs * 2 : cA; const char* nB = has_next ? (const char*)g.Bt + (size_t)nxt.pn * tstep + (size_t)nxt.kofs * 2 : cB;
        _Pragma("unroll 1") for (int t = 0; t < nt; t += 2) {
            const bool last = (t == nt - 2);
            const char* a1 = cA + (size_t)(t + 1) * kstep;
            const char* a2 = last ? nA : cA + (size_t)(t + 2) * kstep; const char* b2 = last ? nB : cB + (size_t)(t + 2) * kstep;
            const char* a3 = a2 + kstep; const char* b3 = b2 + kstep;
            if (last && has_next) S.a_ready(nxt);
            if constexpr (SP2) {
            PG8_LDB(B0, 0, 0); PG8_LDB(B1, 0, 1); PG8_SCHED; PG8_LDA(At, 0, 0); PG8_STAGE(PG8_SA(1, 1), a1 + hstep, voffA);
            PG8_WAIT_V(8); PG8_WAIT_L(0); PG8_BAR; PG8_MMA(0, 0, At, B0); PG8_MMA(0, 1, At, B1); PG8_BAR; PG8_SCHED;
            PG8_LDA(At, 0, 1); PG8_STAGE(PG8_SB(0, 0), b2, voffB); PG8_STAGE(PG8_SB(0, 1), b2 + hstep, voffB); PG8_STAGE(PG8_SA(0, 0), a2, voffA);
            PG8_WAIT_V(8); PG8_WAIT_L(0); PG8_BAR; PG8_MMA(1, 0, At, B0); PG8_MMA(1, 1, At, B1); PG8_BAR; PG8_SCHED;
            PG8_LDB(B0, 1, 0); PG8_LDB(B1, 1, 1); PG8_SCHED; PG8_LDA(At, 1, 0); PG8_STAGE(PG8_SA(0, 1), a2 + hstep, voffA);
            PG8_WAIT_V(8); PG8_WAIT_L(0); PG8_BAR; PG8_MMA(0, 0, At, B0); PG8_MMA(0, 1, At, B1); PG8_BAR; PG8_SCHED;
            PG8_LDA(At, 1, 1); PG8_STAGE(PG8_SB(1, 0), b3, voffB); PG8_STAGE(PG8_SB(1, 1), b3 + hstep, voffB); PG8_STAGE(PG8_SA(1, 0), a3, voffA);
            PG8_WAIT_V(8); PG8_WAIT_L(0); PG8_BAR; PG8_MMA(1, 0, At, B0); PG8_MMA(1, 1, At, B1); PG8_BAR; PG8_SCHED;
            } else {
            PG8_LDB(B0, 0, 0); PG8_SCHED; PG8_LDA(At, 0, 0); PG8_STAGE(PG8_SA(1, 1), a1 + hstep, voffA);
            PG8_WAIT_L(8); PG8_BAR; PG8_WAIT_L(0); PG8_MMA(0, 0, At, B0); PG8_BAR; PG8_SCHED;
            PG8_LDB(B1, 0, 1); PG8_STAGE(PG8_SB(0, 0), b2, voffB);
            PG8_BAR; PG8_WAIT_L(0); PG8_MMA(0, 1, At, B1); PG8_BAR;
            PG8_LDA(At, 0, 1); PG8_STAGE(PG8_SA(0, 0), a2, voffA);
            PG8_BAR; PG8_WAIT_L(0); PG8_MMA(1, 0, At, B0); PG8_BAR; PG8_SCHED;
            PG8_STAGE(PG8_SB(0, 1), b2 + hstep, voffB);
            PG8_WAIT_V(6); PG8_BAR; PG8_MMA(1, 1, At, B1); PG8_BAR;
            PG8_LDB(B0, 1, 0); PG8_SCHED; PG8_LDA(At, 1, 0); PG8_STAGE(PG8_SA(0, 1), a2 + hstep, voffA);
            PG8_WAIT_L(8); PG8_BAR; PG8_WAIT_L(0); PG8_MMA(0, 0, At, B0); PG8_BAR; PG8_SCHED;
            PG8_LDB(B1, 1, 1); PG8_STAGE(PG8_SB(1, 0), b3, voffB);
            PG8_BAR; PG8_WAIT_L(0); PG8_MMA(0, 1, At, B1); PG8_BAR;
            PG8_LDA(At, 1, 1); PG8_STAGE(PG8_SA(1, 0), a3, voffA);
            PG8_BAR; PG8_WAIT_L(0); PG8_MMA(1, 0, At, B0); PG8_BAR; PG8_SCHED;
            PG8_STAGE(PG8_SB(1, 1), b3 + hstep, voffB);
            PG8_WAIT_V(6); PG8_BAR; PG8_MMA(1, 1, At, B1); PG8_BAR;
            }
        }
        if constexpr (ALIGN_EPI) { if (wr == 0) PG8_BAR; }
        if constexpr (!Epi::AFTER_DRAIN) { E(acc, cur, wr, wc, fr, fq); S.done(cur); }
        if (!has_next) break;
#pragma unroll
        for (int a = 0; a < 2; ++a)
#pragma unroll
            for (int b = 0; b < 2; ++b)
#pragma unroll
                for (int m = 0; m < 4; ++m)
#pragma unroll
                    for (int n = 0; n < 2; ++n) acc[a][b][m][n] = (f32x4){0.f, 0.f, 0.f, 0.f};
        cur = nxt; cA = nA; cB = nB; ++ui;
        if constexpr (ALIGN_EPI) { if (wr == 1) PG8_BAR; }
    }
    PG8_WAIT_V(0);
    if constexpr (!ALIGN_EPI) { if (wr == 0) PG8_BAR; }
    PG8_BAR;
    if constexpr (Epi::AFTER_DRAIN) { E.fused(acc, cur, wr, wc, fr, fq, lds, wid, lane); S.done(cur); }
#undef PG8_SA
#undef PG8_SB
#undef PG8_STAGE
#undef PG8_LDA
#undef PG8_LDB
#undef PG8_MMA
#undef PG8_WAIT_V
#undef PG8_WAIT_L
#undef PG8_BAR
#undef PG8_SCHED
}
}

#define LAS __attribute__((address_space(3)))
#define DI __device__ __forceinline__
typedef unsigned short bf16;
typedef unsigned u32x4 __attribute__((ext_vector_type(4)));
typedef unsigned u32x2 __attribute__((ext_vector_type(2)));
typedef float f32x4 __attribute__((ext_vector_type(4)));
typedef float f32x2 __attribute__((ext_vector_type(2)));
typedef float f32x16 __attribute__((ext_vector_type(16)));
typedef short bf16x8 __attribute__((ext_vector_type(8)));
typedef short s16x4 __attribute__((ext_vector_type(4)));
typedef __bf16 bf16x2_t __attribute__((ext_vector_type(2)));

constexpr int DM = 1024, SEQ = 16384, NSB = 16, NST = 32, PAST = 4096, NMEM = 256;
constexpr int MROWS = SEQ + NSB * NST;
constexpr int SKEYS = PAST + NST;
constexpr int MKROWS = SEQ + NSB * SKEYS;
constexpr int INWP = 2816, NING = INWP + 3072;
constexpr int DFF = 4096;
constexpr float EPSN = 1e-6f;
constexpr float LOG2E = 1.4426950408889634f;
constexpr float C_MLA = 0.10206207261596575f * LOG2E;
constexpr float C_DIFF = 0.17677669529663687f * LOG2E;
constexpr float C_MEM = 0.08838834764831845f * LOG2E;
constexpr float LAM_INIT = 0.2f;

constexpr size_t O_Y = 0;
constexpr size_t O_PCKV = (size_t)MROWS * DM;
constexpr size_t O_PKR = O_PCKV + (size_t)SEQ * 256;
constexpr size_t O_PDK = O_PKR + (size_t)SEQ * 32;
constexpr size_t O_PDV = O_PDK + (size_t)SEQ * 512;
constexpr size_t O_PMK = O_PDV + (size_t)SEQ * 512;
constexpr size_t O_PMV = O_PMK + (size_t)NMEM * 512;
constexpr size_t O_SCKV = O_PMV + (size_t)NMEM * 512;
constexpr size_t O_SKR = O_SCKV + (size_t)512 * 256;
constexpr size_t O_SDK = O_SKR + (size_t)512 * 32;
constexpr size_t O_SDV = O_SDK + (size_t)512 * 512;
constexpr size_t O_END = O_SDV + (size_t)512 * 512;

constexpr size_t MiB = 1u << 20;
constexpr size_t WS_TABM = 1 * MiB;
constexpr size_t WS_TABD = 3 * MiB;
constexpr size_t WS_W = 4 * MiB;
constexpr size_t W_ING = WS_W;
constexpr size_t W_UQ = W_ING + (size_t)NING * 1024 * 2;
constexpr size_t W_UKV = W_UQ + (size_t)768 * 384 * 2;
constexpr size_t W_MEM = W_UKV + (size_t)1024 * 256 * 2;
constexpr size_t W_OM = W_MEM + (size_t)1024 * 1024 * 2;
constexpr size_t W_OUT = W_OM + (size_t)3 * 1024 * 512 * 2;
constexpr size_t W_UP = W_OUT + (size_t)1024 * 1024 * 2;
constexpr size_t W_DN = W_UP + (size_t)4096 * 1024 * 2;
constexpr size_t W_END = W_DN + (size_t)1024 * 4096 * 2;
static_assert(W_END <= 44 * MiB, "weights");
constexpr size_t WS_G = 44 * MiB;
constexpr size_t WS_MIX = 44 * MiB;
constexpr size_t WS_DQ = 148 * MiB;
constexpr size_t WS_MQ = 165 * MiB;
constexpr size_t WS_QM = 182 * MiB;
constexpr size_t WS_DKP = 208 * MiB;
constexpr size_t WS_DVP = 225 * MiB;
constexpr size_t WS_KR = 242 * MiB;
constexpr size_t WS_MK = 248 * MiB;
constexpr size_t WS_MV = 253 * MiB;
constexpr size_t WS_LAT = 258 * MiB;
constexpr size_t WS_CQN = 299 * MiB;
constexpr size_t WS_OA = 258 * MiB;
constexpr size_t WS_XN = 312 * MiB;
constexpr size_t WS_CQ = 346 * MiB;
constexpr size_t WS_KN = 312 * MiB;
constexpr size_t WS_VM = 393 * MiB;
constexpr size_t WS_MRG = 348 * MiB;
constexpr size_t WS_MRGB = 416 * MiB;
constexpr size_t WS_U = 348 * MiB;
constexpr size_t WS_PART = 480 * MiB;
constexpr size_t WS_END = 512 * MiB;
static_assert(WS_KR + (size_t)MKROWS * 32 * 2 <= WS_MK && WS_LAT + (size_t)MKROWS * 256 * 2 <= WS_CQN && WS_CQN + (size_t)MROWS * 384 * 2 <= WS_XN, "ws map 1");
static_assert(WS_OA + (size_t)3 * MROWS * 512 * 2 <= WS_XN && WS_XN + (size_t)MROWS * 1024 * 2 <= WS_CQ && WS_KN + (size_t)MKROWS * 512 * 2 <= WS_VM, "ws map 2");
static_assert(WS_VM + (size_t)MKROWS * 512 * 2 <= WS_END && WS_MRG + (size_t)MROWS * 1024 * 4 <= WS_MRGB && WS_U + (size_t)MROWS * 4096 * 2 <= WS_END, "ws map 3");
static_assert(WS_G + (size_t)MROWS * 3072 * 2 <= WS_DQ && WS_QM + (size_t)MROWS * 768 * 2 <= WS_DKP && WS_MK + (size_t)17 * 256 * 512 * 2 <= WS_MV && WS_MV + (size_t)17 * 256 * 512 * 2 <= WS_LAT, "ws map 4");

DI unsigned pk2(float lo, float hi) { f32x2 v = {lo, hi}; bf16x2_t b = __builtin_convertvector(v, bf16x2_t); return __builtin_bit_cast(unsigned, b); }
DI u32x4 pk8(f32x4 a, f32x4 b) { u32x4 w; w.x = pk2(a[0], a[1]); w.y = pk2(a[2], a[3]); w.z = pk2(b[0], b[1]); w.w = pk2(b[2], b[3]); return w; }
DI float bf_lo(unsigned u) { return __uint_as_float(u << 16); }
DI float bf_hi(unsigned u) { return __uint_as_float(u & 0xffff0000u); }
DI float wave_sum(float v) {
#pragma unroll
    for (int o = 1; o < 64; o <<= 1) v += __shfl_xor(v, o);
    return v;
}
DI int row_pos(int row) { return row < SEQ ? row : PAST + ((row - SEQ) & 31); }
DI int row_krow(int row) { if (row < SEQ) return row; const int rs = row - SEQ; return SEQ + (rs >> 5) * SKEYS + PAST + (rs & 31); }
DI float* out_row(float* out, int row, size_t offP, size_t offS, int W) { return row < SEQ ? out + offP + (size_t)row * W : out + offS + (size_t)(row - SEQ) * W; }

#define EPI_ROWS_BEGIN _Pragma("unroll") for (int ai = 0; ai < 2; ++ai) _Pragma("unroll") for (int m = 0; m < 4; ++m) { int row = row0 + ai * 128 + m * 16; asm volatile("" : "+v"(row)); f32x4 v0 = acc[ai][bj][m][0], v1 = acc[ai][bj][m][1];
#define EPI_ROWS_END asm volatile("" ::: "memory"); }

#ifndef TST_GATE
#define TST_GATE 1
#endif
#ifndef TST_KR
#define TST_KR 1
#endif
#ifndef TST_DQ
#define TST_DQ 1
#endif
struct EpiP1 {
    static constexpr bool PERM = true, AFTER_DRAIN = false;
    bf16* CQ; bf16* KR; bf16* DQ; bf16* DKP; bf16* DVP; bf16* MQ; bf16* G; float* out; const float* bgate; const float* tabm; const float* tabd;
    DI void operator()(const f32x4 (&acc)[2][2][4][2], const pg8::Unit& u, int wr, int wc, int fr, int fq) const {
        const int row0 = u.pm * 256 + wr * 64 + fr;
#pragma unroll
        for (int bj = 0; bj < 2; ++bj) {
            const int cgp = u.pn * 256 + bj * 128 + wc * 32;
            const int c = cgp + 8 * fq;
            if (TST_GATE && cgp >= INWP) {
                const int gc = c - INWP;
                EPI_ROWS_BEGIN
                    v0 += *(const f32x4*)(bgate + gc); v1 += *(const f32x4*)(bgate + gc + 4);
#pragma unroll
                    for (int e = 0; e < 4; ++e) { v0[e] = 1.f / (1.f + __expf(-v0[e])); v1[e] = 1.f / (1.f + __expf(-v1[e])); }
                    *(u32x4*)(G + (size_t)row * 3072 + gc) = pk8(v0, v1);
                EPI_ROWS_END
            } else if (cgp < 384) {
                EPI_ROWS_BEGIN
                    *(u32x4*)(CQ + (size_t)row * 384 + c) = pk8(v0, v1);
                EPI_ROWS_END
            } else if (cgp < 640) {
                EPI_ROWS_BEGIN
                    float* p = out_row(out, row, O_PCKV, O_SCKV, 256) + (c - 384);
                    *(f32x4*)p = v0; *(f32x4*)(p + 4) = v1;
                EPI_ROWS_END
            } else if (TST_KR && cgp < 672) {
                EPI_ROWS_BEGIN
                    const float* tb = tabm + (size_t)row_pos(row) * 32 + 8 * (fq & 1);
                    float* p = out_row(out, row, O_PKR, O_SKR, 32) + (c - 640);
                    const float sg = fq < 2 ? -1.f : 1.f;
                    f32x4 pv;
#pragma unroll
                    for (int e = 0; e < 4; ++e) pv[e] = __shfl_xor(v0[e], 32);
                    const f32x4 o0 = v0 * *(const f32x4*)tb + pv * (*(const f32x4*)(tb + 16) * sg);
                    asm volatile("" ::: "memory");
#pragma unroll
                    for (int e = 0; e < 4; ++e) pv[e] = __shfl_xor(v1[e], 32);
                    const f32x4 o1 = v1 * *(const f32x4*)(tb + 4) + pv * (*(const f32x4*)(tb + 20) * sg);
                    *(f32x4*)p = o0; *(f32x4*)(p + 4) = o1;
                    *(u32x4*)(KR + (size_t)row_krow(row) * 32 + (c - 640)) = pk8(o0, o1);
                EPI_ROWS_END
            } else if (TST_DQ && cgp < 1696) {
                const bool isq = cgp < 1184;
                EPI_ROWS_BEGIN
                    if (fq == 0) {
                        const float* tb = tabd + (size_t)row_pos(row) * 8;
                        const f32x4 cc = *(const f32x4*)tb, ss = *(const f32x4*)(tb + 4);
                        const f32x4 n0 = v0 * cc - v1 * ss, n1 = v1 * cc + v0 * ss; v0 = n0; v1 = n1;
                    }
                    if (isq) { v0 *= C_DIFF; v1 *= C_DIFF; *(u32x4*)(DQ + (size_t)row * 512 + (c - 672)) = pk8(v0, v1); }
                    else {
                        float* p = out_row(out, row, O_PDK, O_SDK, 512) + (c - 1184);
                        *(f32x4*)p = v0; *(f32x4*)(p + 4) = v1;
                        if (row < SEQ) *(u32x4*)(DKP + (size_t)row * 512 + (c - 1184)) = pk8(v0, v1);
                    }
                EPI_ROWS_END
            } else if (cgp < 2208) {
                EPI_ROWS_BEGIN
                    float* p = out_row(out, row, O_PDV, O_SDV, 512) + (c - 1696);
                    *(f32x4*)p = v0; *(f32x4*)(p + 4) = v1;
                    if (row < SEQ) *(u32x4*)(DVP + (size_t)row * 512 + (c - 1696)) = pk8(v0, v1);
                EPI_ROWS_END
            } else if (cgp < 2720) {
                EPI_ROWS_BEGIN
                    v0 *= C_MEM; v1 *= C_MEM;
                    *(u32x4*)(MQ + (size_t)row * 512 + (c - 2208)) = pk8(v0, v1);
                EPI_ROWS_END
            }
        }
    }
};

struct EpiMemKV {
    static constexpr bool PERM = true, AFTER_DRAIN = false;
    float* out; bf16* MK; bf16* MV;
    DI void operator()(const f32x4 (&acc)[2][2][4][2], const pg8::Unit& u, int wr, int wc, int fr, int fq) const {
        const int row0 = u.pm * 256 + wr * 64 + fr;
#pragma unroll
        for (int bj = 0; bj < 2; ++bj) {
            const int c = u.pn * 256 + bj * 128 + wc * 32 + 8 * fq;
            const bool isk = c < 512; const int cc = isk ? c : c - 512;
            float* ob = out + (isk ? O_PMK : O_PMV); bf16* bb = isk ? MK : MV;
            EPI_ROWS_BEGIN
                float* p = ob + (size_t)row * 512 + cc; *(f32x4*)p = v0; *(f32x4*)(p + 4) = v1;
                *(u32x4*)(bb + (size_t)row * 512 + cc) = pk8(v0, v1);
            EPI_ROWS_END
        }
    }
};

struct EpiUQ {
    static constexpr bool PERM = true, AFTER_DRAIN = false;
    bf16* QM; const float* tabm;
    DI void operator()(const f32x4 (&acc)[2][2][4][2], const pg8::Unit& u, int wr, int wc, int fr, int fq) const {
        const int row0 = u.pm * 256 + wr * 64 + fr;
#pragma unroll
        for (int bj = 0; bj < 2; ++bj) {
            const int cgp = u.pn * 256 + bj * 128 + wc * 32; const int c = cgp + 8 * fq;
            const bool isrope = ((cgp >> 5) % 3) == 2;
            if (isrope) {
                EPI_ROWS_BEGIN
                    f32x4 p0, p1;
#pragma unroll
                    for (int e = 0; e < 4; ++e) { p0[e] = __shfl_xor(v0[e], 32); p1[e] = __shfl_xor(v1[e], 32); }
                    const float* tb = tabm + (size_t)row_pos(row) * 32 + 8 * (fq & 1);
                    const f32x4 c0 = *(const f32x4*)tb, c1 = *(const f32x4*)(tb + 4), s0 = *(const f32x4*)(tb + 16), s1 = *(const f32x4*)(tb + 20);
                    f32x4 o0, o1;
                    if (fq < 2) { o0 = v0 * c0 - p0 * s0; o1 = v1 * c1 - p1 * s1; } else { o0 = v0 * c0 + p0 * s0; o1 = v1 * c1 + p1 * s1; }
                    o0 *= C_MLA; o1 *= C_MLA;
                    *(u32x4*)(QM + (size_t)row * 768 + c) = pk8(o0, o1);
                    asm volatile("" ::: "memory");
                EPI_ROWS_END
            } else {
                EPI_ROWS_BEGIN
                    v0 *= C_MLA; v1 *= C_MLA;
                    *(u32x4*)(QM + (size_t)row * 768 + c) = pk8(v0, v1);
                EPI_ROWS_END
            }
        }
    }
};

struct EpiBf16Split {
    static constexpr bool PERM = true, AFTER_DRAIN = false;
    bf16* A; bf16* B;
    DI void operator()(const f32x4 (&acc)[2][2][4][2], const pg8::Unit& u, int wr, int wc, int fr, int fq) const {
        const int row0 = u.pm * 256 + wr * 64 + fr;
#pragma unroll
        for (int bj = 0; bj < 2; ++bj) {
            const int c = u.pn * 256 + bj * 128 + wc * 32 + 8 * fq;
            bf16* bb = c < 512 ? A + c : B + (c - 512);
            EPI_ROWS_BEGIN
                *(u32x4*)(bb + (size_t)row * 512) = pk8(v0, v1);
            EPI_ROWS_END
        }
    }
};

template <int BR> struct EpiMerge {
    static constexpr bool PERM = true, AFTER_DRAIN = false;
    const bf16* G; float* MRG; bf16* MRGB;
    DI void operator()(const f32x4 (&acc)[2][2][4][2], const pg8::Unit& u, int wr, int wc, int fr, int fq) const {
        const int row0 = u.pm * 256 + wr * 64 + fr;
#pragma unroll
        for (int bj = 0; bj < 2; ++bj) {
            const int c = u.pn * 256 + bj * 128 + wc * 32 + 8 * fq;
            EPI_ROWS_BEGIN
                const u32x4 g = *(const u32x4*)(G + (size_t)row * 3072 + BR * 1024 + c);
                const f32x4 g0 = {bf_lo(g.x), bf_hi(g.x), bf_lo(g.y), bf_hi(g.y)}, g1 = {bf_lo(g.z), bf_hi(g.z), bf_lo(g.w), bf_hi(g.w)};
                v0 *= g0; v1 *= g1;
                float* p = MRG + (size_t)row * 1024 + c;
                if (BR > 0) { v0 += *(const f32x4*)p; v1 += *(const f32x4*)(p + 4); }
                if (BR < 2) { *(f32x4*)p = v0; *(f32x4*)(p + 4) = v1; }
                else *(u32x4*)(MRGB + (size_t)row * 1024 + c) = pk8(v0, v1);
            EPI_ROWS_END
        }
    }
};

struct EpiF32 {
    static constexpr bool PERM = true, AFTER_DRAIN = false;
    float* O; int ldc;
    DI void operator()(const f32x4 (&acc)[2][2][4][2], const pg8::Unit& u, int wr, int wc, int fr, int fq) const {
        const int row0 = u.pm * 256 + wr * 64 + fr;
#pragma unroll
        for (int bj = 0; bj < 2; ++bj) {
            const int c = u.pn * 256 + bj * 128 + wc * 32 + 8 * fq;
            EPI_ROWS_BEGIN
                float* p = O + (size_t)row * ldc + c; *(f32x4*)p = v0; *(f32x4*)(p + 4) = v1;
            EPI_ROWS_END
        }
    }
};

struct EpiUp {
    static constexpr bool PERM = true, AFTER_DRAIN = false;
    bf16* U;
    DI void operator()(const f32x4 (&acc)[2][2][4][2], const pg8::Unit& u, int wr, int wc, int fr, int fq) const {
        const int row0 = u.pm * 256 + wr * 64 + fr;
#pragma unroll
        for (int bj = 0; bj < 2; ++bj) {
            const int c = u.pn * 256 + bj * 128 + wc * 32 + 8 * fq;
            EPI_ROWS_BEGIN
#pragma unroll
                for (int e = 0; e < 4; ++e) { const float a = fmaxf(v0[e], 0.f), b = fmaxf(v1[e], 0.f); v0[e] = a * a; v1[e] = b * b; }
                *(u32x4*)(U + (size_t)row * DFF + c) = pk8(v0, v1);
            EPI_ROWS_END
        }
    }
};

struct PieceOrder {
    int S, KL, G, c;
    DI bool next(int i, pg8::Unit& u) const { const int L = i * G + c; if (L >= 8 * S) return false; const int tile = L / S, sl = L % S; u.pm = 64 + (tile >> 2); u.pn = tile & 3; u.kofs = sl * KL; return true; }
    DI void a_ready(const pg8::Unit&) const {}
    DI void done(const pg8::Unit&) const {}
};
struct EpiPart {
    static constexpr bool PERM = true, AFTER_DRAIN = false;
    float* P; int KSH;
    DI void operator()(const f32x4 (&acc)[2][2][4][2], const pg8::Unit& u, int wr, int wc, int fr, int fq) const {
        const int row0 = (u.pm - 64) * 256 + wr * 64 + fr; float* base = P + (size_t)(u.kofs >> KSH) * (512 * 1024);
#pragma unroll
        for (int bj = 0; bj < 2; ++bj) {
            const int c = u.pn * 256 + bj * 128 + wc * 32 + 8 * fq;
            EPI_ROWS_BEGIN
                float* p = base + (size_t)row * 1024 + c; *(f32x4*)p = v0; *(f32x4*)(p + 4) = v1;
            EPI_ROWS_END
        }
    }
};

struct Chunk { u32x4 a, b; };
template <bool F32> DI void ld_chunk(Chunk& c, const void* base, size_t eoff, bool valid) {
    c.a = (u32x4){0u, 0u, 0u, 0u}; c.b = (u32x4){0u, 0u, 0u, 0u};
    if (valid) {
        if (F32) { const __attribute__((address_space(1))) float* p = (const __attribute__((address_space(1))) float*)base + eoff; c.a = *(const __attribute__((address_space(1))) u32x4*)p; c.b = *(const __attribute__((address_space(1))) u32x4*)(p + 4); }
        else { c.a = *(const __attribute__((address_space(1))) u32x4*)((const __attribute__((address_space(1))) bf16*)base + eoff); }
    }
}
#define GASP __attribute__((address_space(1)))
template <bool F32> DI void ld_chunk2(Chunk& c, const GASP unsigned char* p, bool valid) {
    c.a = (u32x4){0u, 0u, 0u, 0u}; c.b = (u32x4){0u, 0u, 0u, 0u};
    if (valid) { c.a = *(const GASP u32x4*)p; if (F32) c.b = *(const GASP u32x4*)(p + 16); }
}
template <bool F32> DI u32x4 cvt_chunk(const Chunk& c) {
    if (!F32) return c.a;
    u32x4 w;
    w.x = pk2(__uint_as_float(c.a.x), __uint_as_float(c.a.y)); w.y = pk2(__uint_as_float(c.a.z), __uint_as_float(c.a.w));
    w.z = pk2(__uint_as_float(c.b.x), __uint_as_float(c.b.y)); w.w = pk2(__uint_as_float(c.b.z), __uint_as_float(c.b.w));
    return w;
}
typedef short v4i16_t __attribute__((ext_vector_type(4)));
DI s16x4 vtr(const LAS unsigned char* p) { return __builtin_bit_cast(s16x4, __builtin_amdgcn_ds_read_tr16_b64_v4i16((LAS v4i16_t*)p)); }
DI bf16x8 pack8(const f32x16& s, int b) {
    u32x4 w; w.x = pk2(s[b], s[b + 1]); w.y = pk2(s[b + 2], s[b + 3]); w.z = pk2(s[b + 4], s[b + 5]); w.w = pk2(s[b + 6], s[b + 7]);
    return __builtin_bit_cast(bf16x8, w);
}

struct AU {
    const bf16* Q; int ldq; int qrow0; int nq;
    const void* Ka; const void* Kb; int ldk; int nsplit;
    const bf16* Kr; int ldkr;
    const void* Va; const void* Vb; int ldv;
    int nkeys; int limbase;
    bf16* O; int ldo;
    float lam; const float* subg;
};

template <int MODE, bool F32>
DI void attn_unit(LAS unsigned char* lds, const AU& a, const int tid_in) {
    int tid = tid_in; asm volatile("" : "+v"(tid));
    constexpr int NS = (MODE == 1) ? 2 : 1;
    constexpr int DQK = (MODE == 0) ? 96 : (MODE == 1 ? 64 : 128);
    constexpr int DV = (MODE == 2) ? 128 : 64;
    constexpr int NKS = DQK / 16, NDB = DV / 32;
    constexpr int KSTR = DQK * 2 + 16, VSTR = DV * 2 + 16, KBY = 64 * KSTR, VBY = 64 * VSTR;
    constexpr int KC = (MODE == 0) ? 64 : DQK, KCH = KC / 8, NKJ = KC / 64, VCH = DV / 8, NVJ = DV / 64;
    constexpr bool PREF = (MODE != 2);
    constexpr int NDH = 1;
    constexpr bool PVA = (MODE != 1);
    constexpr float THR = 8.f;
    const int lane = tid & 63, wave = __builtin_amdgcn_readfirstlane(tid >> 6), r = lane & 31, h = lane >> 5;
    const int NT = (a.nkeys + 63) >> 6;
    int lim = a.limbase + (wave >> 1); if (lim > NT - 1) lim = NT - 1;
    const bool active = wave * 32 < a.nq;
    const int ntw = active ? lim + 1 : 0;
#ifndef AT_STAGGER
#define AT_STAGGER 0
#endif
    const bool late = AT_STAGGER && wave >= 4;
    bf16x8 qf[NKS];
#pragma unroll
    for (int s = 0; s < NKS; ++s) {
        qf[s] = (bf16x8){0, 0, 0, 0, 0, 0, 0, 0};
        if (active) qf[s] = *(const bf16x8*)(a.Q + (size_t)(a.qrow0 + wave * 32 + r) * a.ldq + 16 * s + 8 * h);
    }
    float mrun[NS], lrun[NS]; f32x16 o[NS][NDB]; f32x16 sA, sB; f32x16 negm[NS]; bf16x8 pf[NS][2][2];
#pragma unroll
    for (int c = 0; c < NS; ++c) { mrun[c] = 0.f; lrun[c] = 0.f;
#pragma unroll
        for (int i = 0; i < 16; ++i) { sA[i] = 0.f; sB[i] = 0.f; negm[c][i] = 0.f; }
#pragma unroll
        for (int x = 0; x < 4; ++x) pf[c][x >> 1][x & 1] = (bf16x8){0, 0, 0, 0, 0, 0, 0, 0};
#pragma unroll
        for (int d = 0; d < NDB; ++d)
#pragma unroll
            for (int i = 0; i < 16; ++i) o[c][d][i] = 0.f; }
    Chunk ck[NKJ], cr, cv[NVJ];
    constexpr int ESZ = F32 ? 4 : 2;
    int koff_[NKJ], krw_[NKJ], voff_[NVJ], vrw_[NVJ];
#pragma unroll
    for (int j = 0; j < NKJ; ++j) { const int q_ = tid + 512 * j; krw_[j] = q_ / KCH; koff_[j] = (krw_[j] * 512 + (q_ % KCH) * 8) * ESZ; }
#pragma unroll
    for (int j = 0; j < NVJ; ++j) { const int q_ = tid + 512 * j; vrw_[j] = q_ / VCH; voff_[j] = (vrw_[j] * 512 + (q_ % VCH) * 8) * ESZ; }
    cr.a = (u32x4){0u, 0u, 0u, 0u}; cr.b = cr.a;
    const int qq = (lane & 15) >> 2, pp = lane & 3, blk = (lane >> 4) & 1;
    const int kroff = r * KSTR + h * 16, vroff = (4 * h + qq) * VSTR + (16 * blk + 4 * pp) * 2;
#define AT_LOAD(t) do { const int kv0_ = (t) * 64; const bool fs_ = kv0_ < a.nsplit; const size_t tb_ = (size_t)(fs_ ? kv0_ : kv0_ - a.nsplit) * 512; \
        const GASP unsigned char* kbs_ = (const GASP unsigned char*)(fs_ ? a.Ka : a.Kb) + tb_ * ESZ; const GASP unsigned char* vbs_ = (const GASP unsigned char*)(fs_ ? a.Va : a.Vb) + tb_ * ESZ; \
        _Pragma("unroll") for (int j = 0; j < NKJ; ++j) ld_chunk2<F32>(ck[j], kbs_ + koff_[j], kv0_ + krw_[j] < a.nkeys); \
        if (MODE == 0) { if (tid < 256) ld_chunk2<false>(cr, (const GASP unsigned char*)a.Kr + (size_t)kv0_ * 64 + (size_t)((tid >> 2) * 64 + (tid & 3) * 16), kv0_ + (tid >> 2) < a.nkeys); } \
        _Pragma("unroll") for (int j = 0; j < NVJ; ++j) ld_chunk2<F32>(cv[j], vbs_ + voff_[j], kv0_ + vrw_[j] < a.nkeys); } while (0)
#define AT_COMMIT(t) do { LAS unsigned char* kb_ = lds + ((t) % 3) * KBY; LAS unsigned char* vb_ = lds + 3 * KBY + ((t) & 3) * VBY; \
        _Pragma("unroll") for (int j = 0; j < NKJ; ++j) { const int q_ = tid + 512 * j, rw_ = q_ / KCH, ch_ = q_ % KCH; *(LAS u32x4*)(kb_ + rw_ * KSTR + ch_ * 16) = cvt_chunk<F32>(ck[j]); } \
        if (MODE == 0) { if (tid < 256) { const int rw_ = tid >> 2, ch_ = tid & 3; *(LAS u32x4*)(kb_ + rw_ * KSTR + 128 + ch_ * 16) = cr.a; } } \
        _Pragma("unroll") for (int j = 0; j < NVJ; ++j) { const int q_ = tid + 512 * j, rw_ = q_ / VCH, ch_ = q_ % VCH; *(LAS u32x4*)(vb_ + rw_ * VSTR + ch_ * 16) = cvt_chunk<F32>(cv[j]); } } while (0)
#define AT_QKC(tt, c) do { const LAS unsigned char* kp_ = lds + (((tt) % 3) * KBY + kroff); const bool halft_ = (a.nkeys - (tt) * 64) <= 32; \
        f32x16 s0_ = negm[c], s1_ = negm[c];     \
        constexpr int KSN_ = (MODE == 1) ? 2 : NKS; constexpr int KBT_ = (KSN_ > 4) ? ((KSN_ % 4 == 0) ? 4 : 3) : KSN_; \
        _Pragma("unroll") for (int kb0 = 0; kb0 < KSN_; kb0 += KBT_) { \
            bf16x8 kf_[2 * KBT_]; \
            _Pragma("unroll") for (int ks = 0; ks < KBT_; ++ks) { const int kk = ((MODE == 1) ? 2 * (c) : 0) + kb0 + ks; \
                kf_[2 * ks] = *(const LAS bf16x8*)(kp_ + kk * 32); kf_[2 * ks + 1] = *(const LAS bf16x8*)(kp_ + 32 * KSTR + kk * 32); } \
            __builtin_amdgcn_sched_barrier(0); \
            _Pragma("unroll") for (int ks = 0; ks < KBT_; ++ks) { const int kk = ((MODE == 1) ? 2 * (c) : 0) + kb0 + ks; \
                s0_ = __builtin_amdgcn_mfma_f32_32x32x16_bf16(kf_[2 * ks], qf[kk], s0_, 0, 0, 0); \
                s1_ = __builtin_amdgcn_mfma_f32_32x32x16_bf16(kf_[2 * ks + 1], qf[kk], s1_, 0, 0, 0); } \
            __builtin_amdgcn_sched_barrier(0); } \
        if (halft_) { _Pragma("unroll") for (int i = 0; i < 16; ++i) s1_[i] = -1e30f; } \
        sA = s0_; sB = s1_; } while (0)
#define AT_SM(tt, c) do { \
        float mx = fmaxf(sA[0], sB[0]); \
        _Pragma("unroll") for (int i = 1; i < 16; ++i) mx = fmaxf(fmaxf(sA[i], sB[i]), mx); \
        mx = fmaxf(mx, __shfl_xor(mx, 32)); \
        if ((tt) == 0) {     \
            mrun[c] = mx; \
            _Pragma("unroll") for (int i = 0; i < 16; ++i) { sA[i] -= mx; sB[i] -= mx; negm[c][i] = -mx; } \
        } else if (__any(mx > THR)) {     \
            const float dl = fmaxf(mx, 0.f); const float al = __builtin_amdgcn_exp2f(-dl); mrun[c] += dl; lrun[c] *= al; \
            _Pragma("unroll") for (int d = 0; d < NDB; ++d) _Pragma("unroll") for (int i = 0; i < 16; ++i) o[c][d][i] *= al; \
            const float nm = -mrun[c]; \
            _Pragma("unroll") for (int i = 0; i < 16; ++i) { sA[i] -= dl; sB[i] -= dl; negm[c][i] = nm; } } \
        float ps = 0.f; \
        _Pragma("unroll") for (int i = 0; i < 16; ++i) { sA[i] = __builtin_amdgcn_exp2f(sA[i]); sB[i] = __builtin_amdgcn_exp2f(sB[i]); ps += sA[i] + sB[i]; } \
        lrun[c] += ps; \
        pf[c][0][0] = pack8(sA, 0); pf[c][0][1] = pack8(sA, 8); pf[c][1][0] = pack8(sB, 0); pf[c][1][1] = pack8(sB, 8); } while (0)
#define AT_VRD(tt, d0) do { const LAS unsigned char* vp0_ = lds + (3 * KBY + ((tt) & 3) * VBY + vroff); \
        _Pragma("unroll") for (int dd = 0; dd < NDH; ++dd) _Pragma("unroll") for (int kb = 0; kb < 2; ++kb) _Pragma("unroll") for (int sp = 0; sp < 2; ++sp) { \
            const LAS unsigned char* vp = vp0_ + ((kb * 32 + sp * 16) * VSTR + ((d0) + dd) * 64); \
            vlo_[dd * 4 + kb * 2 + sp] = vtr(vp); vhi_[dd * 4 + kb * 2 + sp] = vtr(vp + 8 * VSTR); } } while (0)
#define AT_PVM(d0) do { _Pragma("unroll") for (int dd = 0; dd < NDH; ++dd) _Pragma("unroll") for (int kb = 0; kb < 2; ++kb) _Pragma("unroll") for (int sp = 0; sp < 2; ++sp) { \
            const s16x4 lo = vlo_[dd * 4 + kb * 2 + sp], hi = vhi_[dd * 4 + kb * 2 + sp]; \
            const bf16x8 vf = (bf16x8){lo[0], lo[1], lo[2], lo[3], hi[0], hi[1], hi[2], hi[3]}; \
            _Pragma("unroll") for (int c = 0; c < NS; ++c) o[c][(d0) + dd] = __builtin_amdgcn_mfma_f32_32x32x16_bf16(vf, pf[c][kb][sp], o[c][(d0) + dd], 0, 0, 0); } } while (0)
#define AT_PHA(tt) do { AT_QKC(tt, 0); if (MODE == 1) { AT_SM(tt, 0); } } while (0)
#define AT_PHB(tt) do { s16x4 vlo_[NDH * 4], vhi_[NDH * 4]; \
        AT_VRD(tt, 0); \
        __builtin_amdgcn_sched_barrier(0); \
        if (MODE == 1) { AT_QKC(tt, 1); AT_SM(tt, NS - 1); } else { AT_SM(tt, 0); } \
        __builtin_amdgcn_sched_barrier(0); \
        AT_PVM(0); \
        _Pragma("unroll") for (int d0 = NDH; d0 < NDB; d0 += NDH) { __builtin_amdgcn_sched_barrier(0); AT_VRD(tt, d0); __builtin_amdgcn_sched_barrier(0); AT_PVM(d0); } } while (0)
#define AT_BAR() asm volatile("s_waitcnt lgkmcnt(0)\n\ts_barrier" ::: "memory")
    AT_LOAD(0); AT_COMMIT(0);
    if (NT > 1) { AT_LOAD(1); AT_COMMIT(1); }
    AT_BAR();
    if (late) AT_BAR();
    for (int t = 0; t < NT; ++t) {
        if (PREF && t + 2 < NT) AT_LOAD(t + 2);
        if (PVA) {
            const bool pvok = t >= 1 && t - 1 < ntw;
            s16x4 vlo_[NDH * 4], vhi_[NDH * 4];
            if (pvok) AT_VRD(t - 1, 0);
            __builtin_amdgcn_sched_barrier(0);
            if (t < ntw) AT_QKC(t, 0);
            if (pvok) { AT_PVM(0);
#pragma unroll
                for (int d0 = NDH; d0 < NDB; d0 += NDH) { __builtin_amdgcn_sched_barrier(0); AT_VRD(t - 1, d0); __builtin_amdgcn_sched_barrier(0); AT_PVM(d0); } }
        } else { if (t < ntw) AT_PHA(t); }
        if (AT_STAGGER) AT_BAR();
        if (t < ntw) { if (PVA) { AT_SM(t, 0); } else { AT_PHB(t); } }
        if (t + 2 < NT) { if (!PREF) AT_LOAD(t + 2); AT_COMMIT(t + 2); }
        AT_BAR();
    }
    if (PVA && ntw == NT && ntw > 0) {
        s16x4 vlo_[NDH * 4], vhi_[NDH * 4];
#pragma unroll
        for (int d0 = 0; d0 < NDB; d0 += NDH) { AT_VRD(NT - 1, d0); __builtin_amdgcn_sched_barrier(0); AT_PVM(d0); __builtin_amdgcn_sched_barrier(0); }
    }
    if (AT_STAGGER && !late) AT_BAR();
    AT_BAR();
#undef AT_LOAD
#undef AT_COMMIT
#undef AT_QKC
#undef AT_SM
#undef AT_PHA
#undef AT_PHB
#undef AT_VRD
#undef AT_PVM
#undef AT_BAR
    if (active) {
        const int qi = wave * 32 + r;
        float inv[NS];
#pragma unroll
        for (int c = 0; c < NS; ++c) { const float lt = lrun[c] + __shfl_xor(lrun[c], 32); inv[c] = 1.f / lt; }
        float rs = 1.f;
        if (MODE == 1) {
            float ss = 0.f;
#pragma unroll
            for (int d = 0; d < NDB; ++d)
#pragma unroll
                for (int i = 0; i < 16; ++i) { const float v = o[0][d][i] * inv[0] - a.lam * (o[NS - 1][d][i] * inv[NS - 1]); o[0][d][i] = v; ss += v * v; }
            ss += __shfl_xor(ss, 32);
            rs = rsqrtf(ss * (1.f / 64.f) + EPSN) * (1.f - LAM_INIT);
        } else rs = inv[0];
        bf16* op = a.O + (size_t)(a.qrow0 + qi) * 512;
#pragma unroll
        for (int d = 0; d < NDB; ++d)
#pragma unroll
            for (int g4 = 0; g4 < 4; ++g4) {
                const int dc = d * 32 + 8 * g4 + 4 * h;
                float w0 = o[0][d][4 * g4] * rs, w1 = o[0][d][4 * g4 + 1] * rs, w2 = o[0][d][4 * g4 + 2] * rs, w3 = o[0][d][4 * g4 + 3] * rs;
                if (MODE == 1) { const f32x4 gg = *(const f32x4*)(a.subg + dc); w0 *= gg[0]; w1 *= gg[1]; w2 *= gg[2]; w3 *= gg[3]; }
                u32x2 w; w.x = pk2(w0, w1); w.y = pk2(w2, w3);
                if (qi < a.nq) *(u32x2*)(op + dc) = w;
            }
    }
}

DI void p0_transpose_item(const float* W, int K, int N, bf16* WT, int row_off, LAS float* scr, int item, int lane) {
    const int nblk = N / 32, kb = item / nblk, nb = item % nblk, k0 = 64 * kb, n0 = 32 * nb;
#pragma unroll 8
    for (int i = 0; i < 32; ++i) { const int kk = 2 * i + (lane >> 5); scr[kk * 33 + (lane & 31)] = W[(size_t)(k0 + kk) * N + n0 + (lane & 31)]; }
    asm volatile("s_waitcnt lgkmcnt(0)" ::: "memory");
    const int c = lane & 7;
#pragma unroll
    for (int j = 0; j < 4; ++j) { const int n = (lane >> 3) + 8 * j; const LAS float* s = scr + (8 * c) * 33 + n;
        u32x4 o; o.x = pk2(s[0 * 33], s[1 * 33]); o.y = pk2(s[2 * 33], s[3 * 33]); o.z = pk2(s[4 * 33], s[5 * 33]); o.w = pk2(s[6 * 33], s[7 * 33]);
        *(u32x4*)(WT + (size_t)(row_off + n0 + n) * K + k0 + 8 * c) = o; }
    asm volatile("s_waitcnt lgkmcnt(0)" ::: "memory");
}
DI void rms_row_1024(const float* xrow, const float* g, bf16* orow, int lane) {
    const f32x4* xr = (const f32x4*)xrow + lane; const f32x4* gr = (const f32x4*)g + lane;
    f32x4 v[4]; float s = 0.f;
#pragma unroll
    for (int j = 0; j < 4; ++j) { v[j] = xr[64 * j]; s += (v[j].x * v[j].x + v[j].y * v[j].y) + (v[j].z * v[j].z + v[j].w * v[j].w); }
    const float rstd = rsqrtf(wave_sum(s) * (1.f / 1024.f) + EPSN);
    u32x2* o8 = (u32x2*)orow + lane;
#pragma unroll
    for (int j = 0; j < 4; ++j) { const f32x4 gg = gr[64 * j]; u32x2 w; w.x = pk2(v[j].x * rstd * gg.x, v[j].y * rstd * gg.y); w.y = pk2(v[j].z * rstd * gg.z, v[j].w * rstd * gg.w); o8[64 * j] = w; }
}


template <int K> DI const float* inp_ld() {
    auto kp = __builtin_amdgcn_kernarg_segment_ptr();
    unsigned long long v;
    asm volatile("s_load_dwordx2 %0, %1, %2\n\ts_waitcnt lgkmcnt(0)" : "=s"(v) : "s"(kp), "n"(K * 8));
    return (const float*)(const __attribute__((address_space(1))) float*)v;
}
#define INP(k) inp_ld<k>()


#define RLX_AGENT __ATOMIC_RELAXED, __HIP_MEMORY_SCOPE_AGENT
#define XB_TMO      128
#define XB_XCNT(j)  (256  + 64 * (j))
#define XB_XSUB(j)  (1280 + 64 * (j))
#define XB_XGEN(j)  (2304 + 64 * (j))
#define XB_TOP      3328
#define XB_TOPGEN   3392
#define XCD_BAR_WORDS 3456
#define XB_SPIN_CAP (1u << 18)

__device__ __forceinline__ unsigned xb_ld(unsigned* p)              { return __hip_atomic_load(p, __ATOMIC_RELAXED, __HIP_MEMORY_SCOPE_AGENT); }
__device__ __forceinline__ unsigned xb_add(unsigned* p, unsigned v) { return __hip_atomic_fetch_add(p, v, __ATOMIC_RELAXED, __HIP_MEMORY_SCOPE_AGENT); }
__device__ __forceinline__ unsigned xb_xcc_id() { return (unsigned)__builtin_amdgcn_s_getreg((3 << 11) | 20) & 0xFu; }
#define XB_SPIN(cond, bar) do { unsigned _sp = 0; while (cond) { __builtin_amdgcn_s_sleep(1); \
    if ((++_sp & 255u) == 0u) { if (xb_ld(&(bar)[XB_TMO])) break; if (_sp > XB_SPIN_CAP) { atomicAdd(&(bar)[XB_TMO], 1u); break; } } } } while (0)

struct XcdBarrier {
    unsigned* bar; unsigned x;
    volatile LAS unsigned* st;
};

__device__ __forceinline__ XcdBarrier xcd_barrier_post(unsigned* bar, volatile LAS unsigned* st) {
    XcdBarrier b; b.bar = bar; b.x = xb_xcc_id(); b.st = st;
    if (threadIdx.x == 0) (void)xb_add(&bar[XB_XCNT(b.x)], 1u);
    return b;
}
__device__ __forceinline__ void xcd_barrier_complete(unsigned* bar, unsigned x, unsigned& nloc, unsigned& nx) {
    const unsigned G = gridDim.x * gridDim.y * gridDim.z;
    unsigned sum, cnt, mine, sp = 0u;
    for (;;) {
        sum = 0u; cnt = 0u; mine = 0u;
#pragma unroll
        for (unsigned j = 0; j < 16; ++j) { const unsigned c = xb_ld(&bar[XB_XCNT(j)]); sum += c; cnt += (c > 0u) ? 1u : 0u; mine = (j == x) ? c : mine; }
        if (sum == G) break;
        __builtin_amdgcn_s_sleep(1);
        if ((++sp & 255u) == 0u) { if (xb_ld(&bar[XB_TMO])) break; if (sp > XB_SPIN_CAP) { atomicAdd(&bar[XB_TMO], 1u); break; } }
    }
    nloc = mine > 0u ? mine : 1u; nx = cnt > 0u ? cnt : 1u;
}

__device__ __forceinline__ void xcd_barrier(const XcdBarrier& b) {
    asm volatile("s_waitcnt vmcnt(0)" ::: "memory");
    __syncthreads();
    if (threadIdx.x == 0) {
        unsigned* bar = b.bar;
        __builtin_amdgcn_s_waitcnt(0);
        unsigned nloc = b.st[0], nx = b.st[1];
        if (nloc == 0u) { xcd_barrier_complete(bar, b.x, nloc, nx); b.st[0] = nloc; b.st[1] = nx; }
        const unsigned old = xb_add(&bar[XB_XSUB(b.x)], 1u);
        const unsigned gen = old / nloc;
        if (old + 1u == (gen + 1u) * nloc) {
            __builtin_amdgcn_fence(__ATOMIC_RELEASE, "agent");
            asm volatile("s_waitcnt vmcnt(0)" ::: "memory");
            const unsigned og = xb_add(&bar[XB_TOP], 1u);
            const unsigned tg = og / nx;
            if (og + 1u == (tg + 1u) * nx) xb_add(&bar[XB_TOPGEN], 1u);
            else XB_SPIN(xb_ld(&bar[XB_TOPGEN]) == tg, bar);
            __builtin_amdgcn_fence(__ATOMIC_ACQUIRE, "agent");
            xb_add(&bar[XB_XGEN(b.x)], 1u);
            asm volatile("s_waitcnt vmcnt(0)" ::: "memory");
        } else {
            XB_SPIN(xb_ld(&bar[XB_XGEN(b.x)]) == gen, bar);
            __builtin_amdgcn_fence(__ATOMIC_ACQUIRE, "agent");
            asm volatile("s_waitcnt vmcnt(0)" ::: "memory");
        }
    }
    __syncthreads();
}

struct Args { const float* in[35]; float* out; unsigned char* ws; int ph_lo, ph_hi; };

constexpr int NPHASE = 11;
constexpr int LDS_BYTES = 147456;

__global__ void __launch_bounds__(512, 2) fwd_kernel(Args args) {
    extern __shared__ __attribute__((aligned(16))) unsigned char lds_raw[];
    LAS unsigned char* lds = (LAS unsigned char*)lds_raw;
    cg::grid_group grid = cg::this_grid();
    volatile LAS unsigned* MISC = (volatile LAS unsigned*)(lds + 131072 + 320);
    if (threadIdx.x < 64) MISC[threadIdx.x] = 0u;
    __syncthreads();
    XcdBarrier xbar; xbar.bar = (unsigned*)args.ws; xbar.x = 0; xbar.st = MISC + 8;
    const int G = gridDim.x, bid = blockIdx.x;
    const int NGW = G * 8;
#define PHASE_IDS int tid = threadIdx.x; asm volatile("" : "+v"(tid)); const int lane = tid & 63, wave = __builtin_amdgcn_readfirstlane(tid >> 6); const int gw = bid * 8 + wave; (void)lane; (void)gw;
    unsigned char* ws = args.ws; float* out = args.out;
    const int lo = args.ph_lo, hi = args.ph_hi;
#ifndef PHM
#define PHM 0x7ff
#endif
#define IN(k) (((PHM >> (k)) & 1) && lo <= (k) && (k) < hi)
#ifndef REPM
#define REPM 0
#endif
#define REPS(k) for (int rq_ = 0; rq_ < (((REPM >> (k)) & 1) ? 2 : 1); ++rq_)
#define SEAM(k) do { if (IN(k) && IN((k) + 1)) { if ((k) == 0) { grid.sync(); xbar = xcd_barrier_post((unsigned*)args.ws, MISC + 8); } else xcd_barrier(xbar); } } while (0)
#define XN ((bf16*)(ws + WS_XN))
#define GB ((bf16*)(ws + WS_G))
#define CQ ((bf16*)(ws + WS_CQ))
#define CQN ((bf16*)(ws + WS_CQN))
#define QM ((bf16*)(ws + WS_QM))
#define DQ ((bf16*)(ws + WS_DQ))
#define MQ ((bf16*)(ws + WS_MQ))
#define DKP ((bf16*)(ws + WS_DKP))
#define DVP ((bf16*)(ws + WS_DVP))
#define KR ((bf16*)(ws + WS_KR))
#define MKB ((bf16*)(ws + WS_MK))
#define MVB ((bf16*)(ws + WS_MV))
#define LAT ((bf16*)(ws + WS_LAT))
#define KN ((bf16*)(ws + WS_KN))
#define VM ((bf16*)(ws + WS_VM))
#define OA ((bf16*)(ws + WS_OA))
#define MRG ((float*)(ws + WS_MRG))
#define MRGB ((bf16*)(ws + WS_MRGB))
#define MIX ((float*)(ws + WS_MIX))
#define UB ((bf16*)(ws + WS_U))
#define TABM ((float*)(ws + WS_TABM))
#define TABD ((float*)(ws + WS_TABD))

    if (IN(0)) REPS(0) {
        PHASE_IDS
        LAS float* scr = (LAS float*)(lds + wave * 16384);
        {
            constexpr int I_IN = 16 * 85, I_G = 16 * 96, I_UQ = 6 * 24, I_UK = 4 * 16, I_MK = 16 * 16, I_O = 8 * 32, I_OUT = 16 * 32, I_UP = 16 * 128, I_DN = 64 * 32;
            constexpr int NITEMS = I_IN + I_G + I_UQ + 2 * I_UK + 2 * I_MK + 3 * I_O + I_OUT + I_UP + I_DN;
            for (int it = gw; it < NITEMS; it += NGW) {
                int r = it;
                if (r < I_IN) { p0_transpose_item(INP(10), 1024, 2720, (bf16*)(ws + W_ING), 0, scr, r, lane); continue; } r -= I_IN;
                if (r < I_G) { p0_transpose_item(INP(27), 1024, 3072, (bf16*)(ws + W_ING), INWP, scr, r, lane); continue; } r -= I_G;
                if (r < I_UQ) { p0_transpose_item(INP(12), 384, 768, (bf16*)(ws + W_UQ), 0, scr, r, lane); continue; } r -= I_UQ;
                if (r < I_UK) { p0_transpose_item(INP(14), 256, 512, (bf16*)(ws + W_UKV), 0, scr, r, lane); continue; } r -= I_UK;
                if (r < I_UK) { p0_transpose_item(INP(15), 256, 512, (bf16*)(ws + W_UKV), 512, scr, r, lane); continue; } r -= I_UK;
                if (r < I_MK) { p0_transpose_item(INP(22), 1024, 512, (bf16*)(ws + W_MEM), 0, scr, r, lane); continue; } r -= I_MK;
                if (r < I_MK) { p0_transpose_item(INP(23), 1024, 512, (bf16*)(ws + W_MEM), 512, scr, r, lane); continue; } r -= I_MK;
                if (r < I_O) { p0_transpose_item(INP(24), 512, 1024, (bf16*)(ws + W_OM), 0, scr, r, lane); continue; } r -= I_O;
                if (r < I_O) { p0_transpose_item(INP(25), 512, 1024, (bf16*)(ws + W_OM), 1024, scr, r, lane); continue; } r -= I_O;
                if (r < I_O) { p0_transpose_item(INP(26), 512, 1024, (bf16*)(ws + W_OM), 2048, scr, r, lane); continue; } r -= I_O;
                if (r < I_OUT) { p0_transpose_item(INP(29), 1024, 1024, (bf16*)(ws + W_OUT), 0, scr, r, lane); continue; } r -= I_OUT;
                if (r < I_UP) { p0_transpose_item(INP(32), 1024, 4096, (bf16*)(ws + W_UP), 0, scr, r, lane); continue; } r -= I_UP;
                p0_transpose_item(INP(33), 4096, 1024, (bf16*)(ws + W_DN), 0, scr, r, lane);
            }
        }
        if (bid == 0) for (int i = tid; i < XCD_BAR_WORDS; i += 512) __hip_atomic_store((unsigned*)ws + i, 0u, RLX_AGENT);
        for (int i = gw * 64 + lane; i < 96 * 1024 / 8; i += NGW * 64) *(u32x4*)((bf16*)(ws + W_ING) + (size_t)2720 * 1024 + (size_t)i * 8) = (u32x4){0u, 0u, 0u, 0u};
        for (int m = gw; m < MROWS + NMEM; m += NGW) {
            if (m < SEQ) rms_row_1024(INP(0) + (size_t)m * DM, INP(9), XN + (size_t)m * DM, lane);
            else if (m < MROWS) rms_row_1024(INP(1) + (size_t)(m - SEQ) * DM, INP(9), XN + (size_t)m * DM, lane);
            else rms_row_1024(INP(8) + (size_t)(m - MROWS) * DM, INP(21), MRGB + (size_t)(m - MROWS) * DM, lane);
        }
        for (int i = gw; i < NSB * PAST; i += NGW) {
            const int b = i >> 12, s = i & 4095;
            const f32x4 v = *((const f32x4*)(INP(2) + (size_t)i * 256) + lane);
            u32x2 w; w.x = pk2(v.x, v.y); w.y = pk2(v.z, v.w);
            *((u32x2*)(LAT + (size_t)(SEQ + b * SKEYS + s) * 256) + lane) = w;
        }
        for (int i = gw; i < NSB * PAST / 8; i += NGW) {
            const int rowi = i * 8 + (lane >> 3); const int b = rowi >> 12, s = rowi & 4095;
            const f32x4 v = *((const f32x4*)(INP(3) + (size_t)rowi * 32) + (lane & 7));
            u32x2 w; w.x = pk2(v.x, v.y); w.y = pk2(v.z, v.w);
            *((u32x2*)(KR + (size_t)(SEQ + b * SKEYS + s) * 32) + (lane & 7)) = w;
        }
        for (int i = gw * 64 + lane; i < NSB * NMEM * 512 / 4; i += NGW * 64) {
            const f32x4 a = *((const f32x4*)INP(6) + i), b = *((const f32x4*)INP(7) + i);
            u32x2 w; w.x = pk2(a.x, a.y); w.y = pk2(a.z, a.w); *((u32x2*)(MKB + (size_t)NMEM * 512) + i) = w;
            w.x = pk2(b.x, b.y); w.y = pk2(b.z, b.w); *((u32x2*)(MVB + (size_t)NMEM * 512) + i) = w;
        }
        for (int i = gw * 64 + lane; i < SEQ * 16; i += NGW * 64) {
            const int pos = i >> 4, f = i & 15;
            const float inv = powf(10000.0f, -(float)f * (2.0f / 32.0f)); const float ang = (float)pos * inv;
            TABM[(size_t)pos * 32 + f] = cosf(ang); TABM[(size_t)pos * 32 + 16 + f] = sinf(ang);
        }
        for (int i = gw * 64 + lane; i < SEQ * 4; i += NGW * 64) {
            const int pos = i >> 2, f = i & 3;
            const float inv = powf(500000.0f, -(float)f * (2.0f / 8.0f)); const float ang = (float)pos * inv;
            TABD[(size_t)pos * 8 + f] = cosf(ang); TABD[(size_t)pos * 8 + 4 + f] = sinf(ang);
        }
        asm volatile("s_waitcnt vmcnt(0) lgkmcnt(0)" ::: "memory");
        __syncthreads();
    }
    SEAM(0);

    if (IN(1)) REPS(1) {
        {
            pg8::Gemm g{MRGB, (const bf16*)(ws + W_MEM), NMEM, 1024, 1024}; pg8::StaticOrder S; S.init(NMEM, 1024, G, (bid + 4) % G);
            EpiMemKV E{out, MKB, MVB};
            pg8::gemm_phase<EpiMemKV, pg8::StaticOrder, true, true>(lds, g, S, E);
        }
        {
            pg8::Gemm g{XN, (const bf16*)(ws + W_ING), MROWS, NING, 1024}; pg8::StaticOrder S; S.init(MROWS, NING, G, bid);
            EpiP1 E{CQ, KR, DQ, DKP, DVP, MQ, GB, out, INP(28), TABM, TABD};
            pg8::gemm_phase<EpiP1, pg8::StaticOrder, true, true>(lds, g, S, E);
        }
    }
    SEAM(1);

    if (IN(2)) {
        PHASE_IDS
        for (int row = gw; row < MROWS; row += NGW) {
            {
                u32x4 raw = (u32x4){0u, 0u, 0u, 0u};
                if (lane < 48) raw = *((const u32x4*)(CQ + (size_t)row * 384) + lane);
                float v[8] = {bf_lo(raw.x), bf_hi(raw.x), bf_lo(raw.y), bf_hi(raw.y), bf_lo(raw.z), bf_hi(raw.z), bf_lo(raw.w), bf_hi(raw.w)};
                float s = 0.f;
#pragma unroll
                for (int e = 0; e < 8; ++e) s += v[e] * v[e];
                const float rstd = rsqrtf(wave_sum(s) * (1.f / 384.f) + EPSN);
                if (lane < 48) {
                    const f32x4 g0 = *((const f32x4*)INP(11) + 2 * lane), g1 = *((const f32x4*)INP(11) + 2 * lane + 1);
                    u32x4 w; w.x = pk2(v[0] * rstd * g0.x, v[1] * rstd * g0.y); w.y = pk2(v[2] * rstd * g0.z, v[3] * rstd * g0.w);
                    w.z = pk2(v[4] * rstd * g1.x, v[5] * rstd * g1.y); w.w = pk2(v[6] * rstd * g1.z, v[7] * rstd * g1.w);
                    *((u32x4*)(CQN + (size_t)row * 384) + lane) = w;
                }
            }
            {
                float* p = out_row(out, row, O_PCKV, O_SCKV, 256);
                f32x4 v = *((const f32x4*)p + lane);
                const float s = (v.x * v.x + v.y * v.y) + (v.z * v.z + v.w * v.w);
                const float rstd = rsqrtf(wave_sum(s) * (1.f / 256.f) + EPSN);
                const f32x4 gg = *((const f32x4*)INP(13) + lane);
                v.x *= rstd * gg.x; v.y *= rstd * gg.y; v.z *= rstd * gg.z; v.w *= rstd * gg.w;
                *((f32x4*)p + lane) = v;
                u32x2 w; w.x = pk2(v.x, v.y); w.y = pk2(v.z, v.w);
                *((u32x2*)(LAT + (size_t)row_krow(row) * 256) + lane) = w;
            }
        }
    }
    SEAM(2);

    if (IN(3)) REPS(3) {
#ifndef NO_P3A
        {
            pg8::Gemm g{CQN, (const bf16*)(ws + W_UQ), MROWS, 768, 384}; pg8::StaticOrder S; S.init(MROWS, 768, G, bid);
            EpiUQ E{QM, TABM};
            pg8::gemm_phase<EpiUQ, pg8::StaticOrder, true, true>(lds, g, S, E);
        }
#endif
#ifndef NO_P3B
        {
            pg8::Gemm g{LAT, (const bf16*)(ws + W_UKV), MKROWS, 1024, 256}; pg8::StaticOrder S; S.init(MKROWS, 1024, G, bid);
            EpiBf16Split E{KN, VM};
            pg8::gemm_phase<EpiBf16Split, pg8::StaticOrder, true, true>(lds, g, S, E);
        }
#endif
    }
    SEAM(3);

#ifndef REP_P4
#define REP_P4 1
#endif
    if (IN(4)) for (int rep_ = 0; rep_ < REP_P4; ++rep_) {
        PHASE_IDS
        float lam;
        {
            float sa = 0.f, sb = 0.f;
            if (lane < 32) { sa = INP(16)[lane] * INP(17)[lane]; sb = INP(18)[lane] * INP(19)[lane]; }
            sa = wave_sum(sa); sb = wave_sum(sb);
            lam = expf(sa) - expf(sb) + LAM_INIT;
        }
        constexpr int BIG = 1 << 30;
#define O_MLA OA
#define O_DIFF (OA + (size_t)MROWS * 512)
#define O_MEM (OA + (size_t)2 * MROWS * 512)
#ifndef KMASK
#define KMASK 15
#endif
#define AU_INIT(a) AU a; a.lam = lam; a.subg = INP(20); a.ldo = 512; a.Kb = nullptr; a.Vb = nullptr; a.Kr = KR; a.ldkr = 32; a.nsplit = BIG; a.ldk = 512; a.ldv = 512; a.limbase = BIG / 2;
#ifndef REP_MLA
#define REP_MLA 1
#endif
        if (KMASK & 1) for (int rp_ = 0; rp_ < REP_MLA; ++rp_) for (int it = bid; it < (rp_ == 0 ? 384 : 256); it += G) {
            const int ne = it < 256 ? 2 : 1;
#pragma unroll 1
            for (int e = 0; e < ne; ++e) {
                AU_INIT(a)
                if (it < 256) { const int head = it & 7, pair = it >> 3, qb = e == 0 ? 63 - pair : pair;
                    a.qrow0 = qb * 256; a.nq = 256; a.nkeys = (qb + 1) * 256; a.limbase = 4 * qb;
                    a.Q = QM + head * 96; a.ldq = 768; a.Ka = KN + head * 64; a.Va = VM + head * 64; a.O = O_MLA + head * 64;
                } else { const int jj = it - 256, b = jj >> 3, head = jj & 7; const size_t k0 = (size_t)SEQ + (size_t)b * SKEYS;
                    a.qrow0 = SEQ + b * 32; a.nq = 32; a.nkeys = SKEYS;
                    a.Q = QM + head * 96; a.ldq = 768; a.Ka = KN + k0 * 512 + head * 64; a.Kr = KR + k0 * 32; a.Va = VM + k0 * 512 + head * 64; a.O = O_MLA + head * 64; }
                attn_unit<0, false>(lds, a, tid);
            }
        }
#ifndef REP_DIFF
#define REP_DIFF 1
#endif
        if (KMASK & 2) for (int rp_ = 0; rp_ < REP_DIFF; ++rp_) for (int it = bid; it < 256; it += G) {
#pragma unroll 1
            for (int e = 0; e < 2; ++e) {
                AU_INIT(a)
                const int head = it & 7, pair = it >> 3, qb = e == 0 ? 63 - pair : pair;
                a.qrow0 = qb * 256; a.nq = 256; a.nkeys = (qb + 1) * 256; a.limbase = 4 * qb;
                a.Q = DQ + head * 64; a.ldq = 512; a.Ka = DKP + head * 64; a.Va = DVP + head * 64; a.O = O_DIFF + head * 64;
                attn_unit<1, false>(lds, a, tid);
            }
        }
        if (KMASK & 4) for (int it = (bid + G / 2) % G; it < 128; it += G) {
            AU_INIT(a)
            const int b = it >> 3, head = it & 7;
            a.qrow0 = SEQ + b * 32; a.nq = 32; a.nkeys = SKEYS; a.Q = DQ + head * 64; a.ldq = 512; a.nsplit = PAST;
            a.Ka = INP(4) + (size_t)b * PAST * 512 + head * 64; a.Kb = out + O_SDK + (size_t)b * 32 * 512 + head * 64;
            a.Va = INP(5) + (size_t)b * PAST * 512 + head * 64; a.Vb = out + O_SDV + (size_t)b * 32 * 512 + head * 64;
            a.O = O_DIFF + head * 64;
            attn_unit<1, true>(lds, a, tid);
        }
        if (KMASK & 8) for (int it = bid; it < 320; it += G) {
            AU_INIT(a)
            a.nkeys = NMEM; a.ldq = 512;
            if (it < 256) { const int qb = it >> 2, hm = it & 3; a.qrow0 = qb * 256; a.nq = 256; a.Q = MQ + hm * 128; a.Ka = MKB + hm * 128; a.Va = MVB + hm * 128; a.O = O_MEM + hm * 128; }
            else { const int jj = it - 256, b = jj >> 2, hm = jj & 3; a.qrow0 = SEQ + b * 32; a.nq = 32; a.Q = MQ + hm * 128;
                a.Ka = MKB + (size_t)(1 + b) * NMEM * 512 + hm * 128; a.Va = MVB + (size_t)(1 + b) * NMEM * 512 + hm * 128; a.O = O_MEM + hm * 128; }
            attn_unit<2, false>(lds, a, tid);
        }
#undef AU_INIT
    }
    SEAM(4);

    if (IN(5)) REPS(5) {
        const bf16* WOM = (const bf16*)(ws + W_OM);
        { pg8::Gemm g{OA, WOM, MROWS, 1024, 512}; pg8::StaticOrder S; S.init(MROWS, 1024, G, bid); EpiMerge<0> E{GB, MRG, MRGB};
          pg8::gemm_phase<EpiMerge<0>, pg8::StaticOrder, true, true>(lds, g, S, E); }
        { pg8::Gemm g{OA + (size_t)MROWS * 512, WOM + (size_t)1024 * 512, MROWS, 1024, 512}; pg8::StaticOrder S; S.init(MROWS, 1024, G, bid); EpiMerge<1> E{GB, MRG, MRGB};
          pg8::gemm_phase<EpiMerge<1>, pg8::StaticOrder, true, true>(lds, g, S, E); }
        { pg8::Gemm g{OA + (size_t)2 * MROWS * 512, WOM + (size_t)2048 * 512, MROWS, 1024, 512}; pg8::StaticOrder S; S.init(MROWS, 1024, G, bid); EpiMerge<2> E{GB, MRG, MRGB};
          pg8::gemm_phase<EpiMerge<2>, pg8::StaticOrder, true, true>(lds, g, S, E); }
    }
    SEAM(5);

    if (IN(6)) REPS(6) {
        { pg8::Gemm g{MRGB, (const bf16*)(ws + W_OUT), SEQ, 1024, 1024, 0}; pg8::StaticOrder S; S.init(SEQ, 1024, G, bid); EpiF32 E{MIX, 1024};
          pg8::gemm_phase<EpiF32, pg8::StaticOrder, true, true>(lds, g, S, E); }
        { int kl = 128; asm volatile("" : "+s"(kl));
          pg8::Gemm g{MRGB, (const bf16*)(ws + W_OUT), MROWS, 1024, 1024, kl}; PieceOrder S{8, kl, G, (bid + 96) % G}; EpiPart E{(float*)(ws + WS_PART), 7};
          pg8::gemm_phase<EpiPart, PieceOrder, true, true>(lds, g, S, E); }
    }
    SEAM(6);

    if (IN(7)) REPS(7) {
        PHASE_IDS
        for (int row = gw; row < MROWS; row += NGW) {
            const float* xr = row < SEQ ? INP(0) + (size_t)row * DM : INP(1) + (size_t)(row - SEQ) * DM;
            const f32x4* mr = (const f32x4*)(MIX + (size_t)row * DM) + lane;
            f32x4 v[4]; float s = 0.f;
#pragma unroll
            for (int j = 0; j < 4; ++j) {
                if (row < SEQ) v[j] = mr[64 * j];
                else { const f32x4* pr = (const f32x4*)((const float*)(ws + WS_PART) + (size_t)(row - SEQ) * DM) + lane + 64 * j; v[j] = pr[0];
#pragma unroll
                    for (int sl = 1; sl < 8; ++sl) v[j] += pr[(size_t)sl * (512 * 1024 / 4)]; }
                s += (v[j].x * v[j].x + v[j].y * v[j].y) + (v[j].z * v[j].z + v[j].w * v[j].w); }
            const float rstd = rsqrtf(wave_sum(s) * (1.f / 1024.f) + EPSN);
            float s2 = 0.f;
#pragma unroll
            for (int j = 0; j < 4; ++j) { const f32x4 gg = *((const f32x4*)INP(30) + lane + 64 * j); const f32x4 xx = *((const f32x4*)xr + lane + 64 * j);
                v[j].x = xx.x + v[j].x * rstd * gg.x; v[j].y = xx.y + v[j].y * rstd * gg.y; v[j].z = xx.z + v[j].z * rstd * gg.z; v[j].w = xx.w + v[j].w * rstd * gg.w;
                s2 += (v[j].x * v[j].x + v[j].y * v[j].y) + (v[j].z * v[j].z + v[j].w * v[j].w);
                *((f32x4*)(out + O_Y + (size_t)row * DM) + lane + 64 * j) = v[j]; }
            const float rstd2 = rsqrtf(wave_sum(s2) * (1.f / 1024.f) + EPSN);
#pragma unroll
            for (int j = 0; j < 4; ++j) { const f32x4 gg = *((const f32x4*)INP(31) + lane + 64 * j);
                u32x2 w; w.x = pk2(v[j].x * rstd2 * gg.x, v[j].y * rstd2 * gg.y); w.y = pk2(v[j].z * rstd2 * gg.z, v[j].w * rstd2 * gg.w);
                *((u32x2*)(XN + (size_t)row * DM) + lane + 64 * j) = w; }
        }
    }
    SEAM(7);

    if (IN(8)) REPS(8) {
        pg8::Gemm g{XN, (const bf16*)(ws + W_UP), MROWS, DFF, 1024}; pg8::StaticOrder S; S.init(MROWS, DFF, G, bid); EpiUp E{UB};
        pg8::gemm_phase<EpiUp, pg8::StaticOrder, true, true>(lds, g, S, E);
    }
    SEAM(8);

    if (IN(9)) REPS(9) {
        { pg8::Gemm g{UB, (const bf16*)(ws + W_DN), SEQ, 1024, DFF, 0}; pg8::StaticOrder S; S.init(SEQ, 1024, G, bid); EpiF32 E{MIX, 1024};
          pg8::gemm_phase<EpiF32, pg8::StaticOrder, true, true>(lds, g, S, E); }
        { pg8::Gemm g{UB, (const bf16*)(ws + W_DN), MROWS, 1024, DFF, 256}; PieceOrder S{16, 256, G, bid}; EpiPart E{(float*)(ws + WS_PART), 8};
          pg8::gemm_phase<EpiPart, PieceOrder, true, true>(lds, g, S, E); }
    }
    SEAM(9);

    if (IN(10)) {
        PHASE_IDS
        for (int row = gw; row < MROWS; row += NGW) {
            const f32x4* fr_ = (const f32x4*)(MIX + (size_t)row * DM) + lane;
            f32x4 v[4]; float s = 0.f;
#pragma unroll
            for (int j = 0; j < 4; ++j) {
                if (row < SEQ) v[j] = fr_[64 * j];
                else { const f32x4* pr = (const f32x4*)((const float*)(ws + WS_PART) + (size_t)(row - SEQ) * DM) + lane + 64 * j; v[j] = pr[0];
#pragma unroll
                    for (int sl = 1; sl < 16; ++sl) v[j] += pr[(size_t)sl * (512 * 1024 / 4)]; }
                s += (v[j].x * v[j].x + v[j].y * v[j].y) + (v[j].z * v[j].z + v[j].w * v[j].w); }
            const float rstd = rsqrtf(wave_sum(s) * (1.f / 1024.f) + EPSN);
#pragma unroll
            for (int j = 0; j < 4; ++j) { const f32x4 gg = *((const f32x4*)INP(34) + lane + 64 * j); f32x4* yp = (f32x4*)(out + O_Y + (size_t)row * DM) + lane + 64 * j; const f32x4 xx = *yp;
                f32x4 y; y.x = xx.x + v[j].x * rstd * gg.x; y.y = xx.y + v[j].y * rstd * gg.y; y.z = xx.z + v[j].z * rstd * gg.z; y.w = xx.w + v[j].w * rstd * gg.w; *yp = y; }
        }
    }
#undef IN
#undef SEAM
}

#ifndef MK_N_LAUNCHES
#define MK_N_LAUNCHES 1
#endif

extern "C" void kernel_launch(void* const* d_in, const int* in_sizes, int n_in, void* d_out, int out_size, void* d_ws, size_t ws_size, hipStream_t stream) {
    static int grid = 0;
    if (grid == 0) {
        if (n_in != 35 || out_size != (int)O_END || ws_size < WS_END) { fprintf(stderr, "kernel_launch: unexpected shapes: n_in %d out %d ws %zu\n", n_in, out_size, ws_size); grid = -1; return; }
        int dev = 0, cus = 0, per_cu = 0;
        hipGetDevice(&dev); hipDeviceGetAttribute(&cus, hipDeviceAttributeMultiprocessorCount, dev);
        if (hipFuncSetAttribute((const void*)fwd_kernel, hipFuncAttributeMaxDynamicSharedMemorySize, LDS_BYTES) != hipSuccess) { fprintf(stderr, "kernel_launch: hipFuncSetAttribute failed\n"); grid = -1; return; }
        hipOccupancyMaxActiveBlocksPerMultiprocessor(&per_cu, (const void*)fwd_kernel, 512, LDS_BYTES);
        (void)hipGetLastError();
        if (per_cu < 1) per_cu = 1;
        grid = cus;
    }
    if (grid < 0) return;
    Args a{};
    for (int i = 0; i < 35; ++i) a.in[i] = (const float*)d_in[i];
    a.out = (float*)d_out; a.ws = (unsigned char*)d_ws;
#if MK_N_LAUNCHES == 1
    a.ph_lo = 0; a.ph_hi = NPHASE;
    void* kargs[] = {&a};
    hipError_t e = hipLaunchCooperativeKernel((const void*)fwd_kernel, dim3(grid), dim3(512), kargs, LDS_BYTES, stream);
    if (e != hipSuccess) fprintf(stderr, "cooperative launch failed: %s (grid %d)\n", hipGetErrorString(e), grid);
#else
    for (int p = 0; p < NPHASE; ++p) { a.ph_lo = p; a.ph_hi = p + 1; hipLaunchKernelGGL(fwd_kernel, dim3(grid), dim3(512), LDS_BYTES, stream, a); }
#endif
}
```

```cpp
#include <hip/hip_runtime.h>
#include <hip/hip_cooperative_groups.h>
#include <cstdio>
#include <cstdint>
namespace cg = cooperative_groups;
namespace pg8 {
#define PG8_LAS __attribute__((address_space(3)))
typedef unsigned short bf16_t;
typedef short bf16x8 __attribute__((ext_vector_type(8)));
typedef float f32x4 __attribute__((ext_vector_type(4)));
typedef unsigned u32x4 __attribute__((ext_vector_type(4)));
constexpr int BM = 256, BK = 64, HALF = 128, HTB = HALF * BK * 2  , STAGE_BYTES = 8 * HTB, NXCD = 8, WGM = 8;

__host__ __device__ __forceinline__ int lds_byte(int r, int c) { const int st = (r >> 4) * 2 + (c >> 5), rr = r & 15, cc = c & 31, ob = rr * 64 + cc * 2; return st * 1024 + (ob ^ (((ob >> 9) & 1) << 5)); }
__host__ __device__ __forceinline__ void stage_rc(int b, int& R, int& C) { const int st = b / 1024, sb = b % 1024, swz = sb ^ (((sb >> 9) & 1) << 5); R = (st >> 1) * 16 + swz / 64; C = (st & 1) * 32 + (swz % 64) / 2; }
__host__ __device__ __forceinline__ int perm32(int rho) { const int n = rho >> 4, i = rho & 15; return 8 * (i >> 2) + 4 * n + (i & 3); }

struct Unit { int pm, pn, kofs; };
struct Gemm { const bf16_t* A; const bf16_t* Bt; int M, N, K, KL; };

struct StaticOrder {
    int nM, nN, nwg, G, c;
    __host__ __device__ void init(int M, int N, int G_, int c_) { nM = M / BM; nN = N / BM; nwg = nM * nN; G = G_; c = c_; }
    __host__ __device__ bool next(int i, Unit& u) const {
        const long L = (long)i * G + c; if (L >= nwg) return false;
        int wgid = (int)L; { const int q = nwg / NXCD, r = nwg % NXCD, xcd = wgid % NXCD, off = wgid / NXCD; wgid = (xcd < r ? xcd * (q + 1) : r * (q + 1) + (xcd - r) * q) + off; }
        const int nig = WGM * nN, gid = wgid / nig, fm = gid * WGM, gsz = (nM - fm) < WGM ? (nM - fm) : WGM;
        u.pm = fm + ((wgid % nig) % gsz); u.pn = (wgid % nig) / gsz; u.kofs = 0; return true;
    }
    __device__ __forceinline__ void a_ready(const Unit&) const {}
    __device__ __forceinline__ void done(const Unit&) const {}
};

__device__ __forceinline__ unsigned cvt_pk_bf16(float lo, float hi) { unsigned r; asm volatile("v_cvt_pk_bf16_f32 %0, %1, %2" : "=v"(r) : "v"(lo), "v"(hi)); return r; }
template <class Epi, class Sched, bool ALIGN_EPI = false, bool SP2 = false>
__device__ __forceinline__ void gemm_phase(PG8_LAS unsigned char* lds, const Gemm g, const Sched& S, const Epi& E) {
    int tid_l = threadIdx.x; asm volatile("" : "+v"(tid_l));
    const int tid = tid_l, wid = __builtin_amdgcn_readfirstlane(tid >> 6), lane = tid & 63, wr = wid >> 2, wc = wid & 3, fr = lane & 15, fq = lane >> 4;
    const int K = g.K, nt = (g.KL ? g.KL : K) / BK;
    unsigned voffA[2], voffB[2];
#pragma unroll
    for (int i = 0; i < 2; ++i) { int R, C; stage_rc(tid * 16 + i * 8192, R, C); const int Rb = Epi::PERM ? ((R & ~31) + perm32(R & 31)) : R;
        voffA[i] = (unsigned)(R * K + C) * 2u; voffB[i] = (unsigned)(Rb * K + C) * 2u; }
    const size_t kstep = (size_t)(BK * 2);
    const size_t hstep = (size_t)HALF * K * 2;
    const size_t tstep = 2 * hstep;
    const unsigned ldsw = (unsigned)wid * 1024u;
    const int aoff = lds_byte(wr * 64 + fr, fq * 8), boff = lds_byte(wc * 32 + fr, fq * 8);
#define PG8_SA(b, h) (((b) * 2 + (h)) * HTB)
#define PG8_SB(b, h) ((4 + (b) * 2 + (h)) * HTB)
#define PG8_STAGE(bufoff, gbase, voff) do { _Pragma("unroll") for (int _i = 0; _i < 2; ++_i) \
        __builtin_amdgcn_global_load_lds((const unsigned*)((const char*)(gbase) + (voff)[_i]), (PG8_LAS unsigned*)(lds + (bufoff) + ldsw + _i * 8192), 16, 0, 0); } while (0)
#define PG8_LDA(dst, b, h) do { _Pragma("unroll") for (int m = 0; m < 4; ++m) _Pragma("unroll") for (int k = 0; k < 2; ++k) dst[m][k] = *(const PG8_LAS bf16x8*)(lds + PG8_SA(b, h) + aoff + m * 2048 + k * 1024); } while (0)
#define PG8_LDB(dst, b, h) do { _Pragma("unroll") for (int n = 0; n < 2; ++n) _Pragma("unroll") for (int k = 0; k < 2; ++k) dst[n][k] = *(const PG8_LAS bf16x8*)(lds + PG8_SB(b, h) + boff + n * 2048 + k * 1024); } while (0)
#define PG8_MMA(ai, bj, At, Bt) do { __builtin_amdgcn_s_setprio(1); _Pragma("unroll") for (int m = 0; m < 4; ++m) _Pragma("unroll") for (int n = 0; n < 2; ++n) _Pragma("unroll") for (int k = 0; k < 2; ++k) \
        acc[ai][bj][m][n] = __builtin_amdgcn_mfma_f32_16x16x32_bf16(Bt[n][k], At[m][k], acc[ai][bj][m][n], 0, 0, 0); __builtin_amdgcn_s_setprio(0); } while (0)
#define PG8_WAIT_V(n) asm volatile("s_waitcnt vmcnt(" #n ")" ::: "memory")
#define PG8_WAIT_L(n) asm volatile("s_waitcnt lgkmcnt(" #n ")" ::: "memory")
#define PG8_BAR __builtin_amdgcn_s_barrier()
#define PG8_SCHED __builtin_amdgcn_sched_barrier(0)
    Unit cur, nxt; int ui = 0;
    if (!S.next(0, cur)) return;
    f32x4 acc[2][2][4][2];
#pragma unroll
    for (int a = 0; a < 2; ++a)
#pragma unroll
        for (int b = 0; b < 2; ++b)
#pragma unroll
            for (int m = 0; m < 4; ++m)
#pragma unroll
                for (int n = 0; n < 2; ++n) acc[a][b][m][n] = (f32x4){0.f, 0.f, 0.f, 0.f};
    bf16x8 At[4][2], B0[2][2], B1[2][2];
    const char* cA = (const char*)g.A + (size_t)cur.pm * tstep + (size_t)cur.kofs * 2; const char* cB = (const char*)g.Bt + (size_t)cur.pn * tstep + (size_t)cur.kofs * 2;
    S.a_ready(cur);
    if constexpr (SP2) {
        PG8_STAGE(PG8_SB(0, 0), cB, voffB); PG8_STAGE(PG8_SB(0, 1), cB + hstep, voffB); PG8_STAGE(PG8_SA(0, 0), cA, voffA); PG8_STAGE(PG8_SA(0, 1), cA + hstep, voffA);
        if (wr == 1) PG8_BAR;
        PG8_WAIT_V(2); PG8_BAR;
        PG8_STAGE(PG8_SB(1, 0), cB + kstep, voffB); PG8_STAGE(PG8_SA(1, 0), cA + kstep, voffA); PG8_STAGE(PG8_SB(1, 1), cB + hstep + kstep, voffB);
        PG8_WAIT_V(6); PG8_BAR;
    } else {
        PG8_STAGE(PG8_SB(0, 0), cB, voffB); PG8_STAGE(PG8_SA(0, 0), cA, voffA); PG8_STAGE(PG8_SB(0, 1), cB + hstep, voffB); PG8_STAGE(PG8_SA(0, 1), cA + hstep, voffA);
        if (wr == 1) PG8_BAR;
        PG8_WAIT_V(4); PG8_BAR;
        PG8_STAGE(PG8_SB(1, 0), cB + kstep, voffB); PG8_STAGE(PG8_SA(1, 0), cA + kstep, voffA); PG8_STAGE(PG8_SB(1, 1), cB + hstep + kstep, voffB);
        PG8_WAIT_V(6); PG8_BAR;
    }
    for (;;) {
        const bool has_next = S.next(ui + 1, nxt);
        const char* nA = has_next ? (const char*)g.A + (size_t)nxt.pm * tstep + (size_t)nxt.kofs * 2 : cA; const char* nB = has_next ? (const char*)g.Bt + (size_t)nxt.pn * tstep + (size_t)nxt.kofs * 2 : cB;
        _Pragma("unroll 1") for (int t = 0; t < nt; t += 2) {
            const bool last = (t == nt - 2);
            const char* a1 = cA + (size_t)(t + 1) * kstep;
            const char* a2 = last ? nA : cA + (size_t)(t + 2) * kstep; const char* b2 = last ? nB : cB + (size_t)(t + 2) * kstep;
            const char* a3 = a2 + kstep; const char* b3 = b2 + kstep;
            if (last && has_next) S.a_ready(nxt);
            if constexpr (SP2) {
            PG8_LDB(B0, 0, 0); PG8_LDB(B1, 0, 1); PG8_SCHED; PG8_LDA(At, 0, 0); PG8_STAGE(PG8_SA(1, 1), a1 + hstep, voffA);
            PG8_WAIT_V(8); PG8_WAIT_L(0); PG8_BAR; PG8_MMA(0, 0, At, B0); PG8_MMA(0, 1, At, B1); PG8_BAR; PG8_SCHED;
            PG8_LDA(At, 0, 1); PG8_STAGE(PG8_SB(0, 0), b2, voffB); PG8_STAGE(PG8_SB(0, 1), b2 + hstep, voffB); PG8_STAGE(PG8_SA(0, 0), a2, voffA);
            PG8_WAIT_V(8); PG8_WAIT_L(0); PG8_BAR; PG8_MMA(1, 0, At, B0); PG8_MMA(1, 1, At, B1); PG8_BAR; PG8_SCHED;
            PG8_LDB(B0, 1, 0); PG8_LDB(B1, 1, 1); PG8_SCHED; PG8_LDA(At, 1, 0); PG8_STAGE(PG8_SA(0, 1), a2 + hstep, voffA);
            PG8_WAIT_V(8); PG8_WAIT_L(0); PG8_BAR; PG8_MMA(0, 0, At, B0); PG8_MMA(0, 1, At, B1); PG8_BAR; PG8_SCHED;
            PG8_LDA(At, 1, 1); PG8_STAGE(PG8_SB(1, 0), b3, voffB); PG8_STAGE(PG8_SB(1, 1), b3 + hstep, voffB); PG8_STAGE(PG8_SA(1, 0), a3, voffA);
            PG8_WAIT_V(8); PG8_WAIT_L(0); PG8_BAR; PG8_MMA(1, 0, At, B0); PG8_MMA(1, 1, At, B1); PG8_BAR; PG8_SCHED;
            if constexpr (Epi::MID) { if (!last && ((t + 2) & 7) == 0) { E.mid(acc, cur, wr, wc, fr, fq, (t + 2) >> 3); PG8_SCHED; } }
            } else {
            PG8_LDB(B0, 0, 0); PG8_SCHED; PG8_LDA(At, 0, 0); PG8_STAGE(PG8_SA(1, 1), a1 + hstep, voffA);
            PG8_WAIT_L(8); PG8_BAR; PG8_WAIT_L(0); PG8_MMA(0, 0, At, B0); PG8_BAR; PG8_SCHED;
            PG8_LDB(B1, 0, 1); PG8_STAGE(PG8_SB(0, 0), b2, voffB);
            PG8_BAR; PG8_WAIT_L(0); PG8_MMA(0, 1, At, B1); PG8_BAR;
            PG8_LDA(At, 0, 1); PG8_STAGE(PG8_SA(0, 0), a2, voffA);
            PG8_BAR; PG8_WAIT_L(0); PG8_MMA(1, 0, At, B0); PG8_BAR; PG8_SCHED;
            PG8_STAGE(PG8_SB(0, 1), b2 + hstep, voffB);
            PG8_WAIT_V(6); PG8_BAR; PG8_MMA(1, 1, At, B1); PG8_BAR;
            PG8_LDB(B0, 1, 0); PG8_SCHED; PG8_LDA(At, 1, 0); PG8_STAGE(PG8_SA(0, 1), a2 + hstep, voffA);
            PG8_WAIT_L(8); PG8_BAR; PG8_WAIT_L(0); PG8_MMA(0, 0, At, B0); PG8_BAR; PG8_SCHED;
            PG8_LDB(B1, 1, 1); PG8_STAGE(PG8_SB(1, 0), b3, voffB);
            PG8_BAR; PG8_WAIT_L(0); PG8_MMA(0, 1, At, B1); PG8_BAR;
            PG8_LDA(At, 1, 1); PG8_STAGE(PG8_SA(1, 0), a3, voffA);
            PG8_BAR; PG8_WAIT_L(0); PG8_MMA(1, 0, At, B0); PG8_BAR; PG8_SCHED;
            PG8_STAGE(PG8_SB(1, 1), b3 + hstep, voffB);
            PG8_WAIT_V(6); PG8_BAR; PG8_MMA(1, 1, At, B1); PG8_BAR;
            }
        }
        if constexpr (ALIGN_EPI) { if (wr == 0) PG8_BAR; }
        if constexpr (!Epi::AFTER_DRAIN) { E(acc, cur, wr, wc, fr, fq); S.done(cur); }
        if (!has_next) break;
#pragma unroll
        for (int a = 0; a < 2; ++a)
#pragma unroll
            for (int b = 0; b < 2; ++b)
#pragma unroll
                for (int m = 0; m < 4; ++m)
#pragma unroll
                    for (int n = 0; n < 2; ++n) acc[a][b][m][n] = (f32x4){0.f, 0.f, 0.f, 0.f};
        cur = nxt; cA = nA; cB = nB; ++ui;
        if constexpr (ALIGN_EPI) { if (wr == 1) PG8_BAR; }
    }
    PG8_WAIT_V(0);
    if constexpr (!ALIGN_EPI) { if (wr == 0) PG8_BAR; }
    PG8_BAR;
    if constexpr (Epi::AFTER_DRAIN) { E.fused(acc, cur, wr, wc, fr, fq, lds, wid, lane); S.done(cur); }
#undef PG8_SA
#undef PG8_SB
#undef PG8_STAGE
#undef PG8_LDA
#undef PG8_LDB
#undef PG8_MMA
#undef PG8_WAIT_V
#undef PG8_WAIT_L
#undef PG8_BAR
#undef PG8_SCHED
}
}

#define LAS __attribute__((address_space(3)))
#define DI __device__ __forceinline__
typedef unsigned short bf16;
typedef unsigned u32x4 __attribute__((ext_vector_type(4)));
typedef unsigned u32x2 __attribute__((ext_vector_type(2)));
typedef float f32x4 __attribute__((ext_vector_type(4)));
typedef float f32x2 __attribute__((ext_vector_type(2)));
typedef float f32x16 __attribute__((ext_vector_type(16)));
typedef short bf16x8 __attribute__((ext_vector_type(8)));
typedef short s16x4 __attribute__((ext_vector_type(4)));
typedef __bf16 bf16x2_t __attribute__((ext_vector_type(2)));

constexpr int DM = 1024, SEQ = 16384, NSB = 16, NST = 32, PAST = 4096, NMEM = 256;
constexpr int MROWS = SEQ + NSB * NST;
constexpr int SKEYS = PAST + NST;
constexpr int MKROWS = SEQ + NSB * SKEYS;
constexpr int INWP = 2816, NING = INWP + 3072;
constexpr int DFF = 4096;
constexpr float EPSN = 1e-6f;
constexpr float LOG2E = 1.4426950408889634f;
constexpr float C_MLA = 0.10206207261596575f * LOG2E;
constexpr float C_DIFF = 0.17677669529663687f * LOG2E;
constexpr float C_MEM = 0.08838834764831845f * LOG2E;
constexpr float LAM_INIT = 0.2f;

constexpr size_t O_Y = 0;
constexpr size_t O_PCKV = (size_t)MROWS * DM;
constexpr size_t O_PKR = O_PCKV + (size_t)SEQ * 256;
constexpr size_t O_PDK = O_PKR + (size_t)SEQ * 32;
constexpr size_t O_PDV = O_PDK + (size_t)SEQ * 512;
constexpr size_t O_PMK = O_PDV + (size_t)SEQ * 512;
constexpr size_t O_PMV = O_PMK + (size_t)NMEM * 512;
constexpr size_t O_SCKV = O_PMV + (size_t)NMEM * 512;
constexpr size_t O_SKR = O_SCKV + (size_t)512 * 256;
constexpr size_t O_SDK = O_SKR + (size_t)512 * 32;
constexpr size_t O_SDV = O_SDK + (size_t)512 * 512;
constexpr size_t O_END = O_SDV + (size_t)512 * 512;

constexpr size_t MiB = 1u << 20;
constexpr size_t WS_TABM = 1 * MiB;
constexpr size_t WS_TABD = 3 * MiB;
constexpr size_t WS_W = 4 * MiB;
constexpr size_t W_ING = WS_W;
constexpr size_t W_UQ = W_ING + (size_t)NING * 1024 * 2;
constexpr size_t W_UKV = W_UQ + (size_t)768 * 384 * 2;
constexpr size_t W_MEM = W_UKV + (size_t)1024 * 256 * 2;
constexpr size_t W_OM = W_MEM + (size_t)1024 * 1024 * 2;
constexpr size_t W_OUT = W_OM + (size_t)3 * 1024 * 512 * 2;
constexpr size_t W_UP = W_OUT + (size_t)1024 * 1024 * 2;
constexpr size_t W_DN = W_UP + (size_t)4096 * 1024 * 2;
constexpr size_t W_END = W_DN + (size_t)1024 * 4096 * 2;
static_assert(W_END <= 44 * MiB, "weights");
constexpr size_t WS_G = 44 * MiB;
constexpr size_t WS_MIX = 44 * MiB;
constexpr size_t WS_DQ = 148 * MiB;
constexpr size_t WS_MQ = 165 * MiB;
constexpr size_t WS_QM = 182 * MiB;
constexpr size_t WS_DKP = 208 * MiB;
constexpr size_t WS_DVP = 225 * MiB;
constexpr size_t WS_KR = 242 * MiB;
constexpr size_t WS_MK = 248 * MiB;
constexpr size_t WS_MV = 253 * MiB;
constexpr size_t WS_LAT = 258 * MiB;
constexpr size_t WS_CQN = 299 * MiB;
constexpr size_t WS_OA = 258 * MiB;
constexpr size_t WS_XN = 312 * MiB;
constexpr size_t WS_CQ = 346 * MiB;
constexpr size_t WS_KN = 312 * MiB;
constexpr size_t WS_VM = 393 * MiB;
constexpr size_t WS_MRG = 348 * MiB;
constexpr size_t WS_MRGB = 416 * MiB;
constexpr size_t WS_U = 348 * MiB;
constexpr size_t WS_PART = 480 * MiB;
constexpr size_t WS_END = 512 * MiB;
static_assert(WS_KR + (size_t)MKROWS * 32 * 2 <= WS_MK && WS_LAT + (size_t)MKROWS * 256 * 2 <= WS_CQN && WS_CQN + (size_t)MROWS * 384 * 2 <= WS_XN, "ws map 1");
static_assert(WS_OA + (size_t)3 * MROWS * 512 * 2 <= WS_XN && WS_XN + (size_t)MROWS * 1024 * 2 <= WS_CQ && WS_KN + (size_t)MKROWS * 512 * 2 <= WS_VM, "ws map 2");
static_assert(WS_VM + (size_t)MKROWS * 512 * 2 <= WS_END && WS_MRG + (size_t)MROWS * 1024 * 4 <= WS_MRGB && WS_U + (size_t)MROWS * 4096 * 2 <= WS_END, "ws map 3");
static_assert(WS_G + (size_t)MROWS * 3072 * 2 <= WS_DQ && WS_QM + (size_t)MROWS * 768 * 2 <= WS_DKP && WS_MK + (size_t)17 * 256 * 512 * 2 <= WS_MV && WS_MV + (size_t)17 * 256 * 512 * 2 <= WS_LAT, "ws map 4");

DI unsigned pk2(float lo, float hi) { f32x2 v = {lo, hi}; bf16x2_t b = __builtin_convertvector(v, bf16x2_t); return __builtin_bit_cast(unsigned, b); }
DI u32x4 pk8(f32x4 a, f32x4 b) { u32x4 w; w.x = pk2(a[0], a[1]); w.y = pk2(a[2], a[3]); w.z = pk2(b[0], b[1]); w.w = pk2(b[2], b[3]); return w; }
DI float bf_lo(unsigned u) { return __uint_as_float(u << 16); }
DI float bf_hi(unsigned u) { return __uint_as_float(u & 0xffff0000u); }
DI float wave_sum(float v) {
#pragma unroll
    for (int o = 1; o < 64; o <<= 1) v += __shfl_xor(v, o);
    return v;
}
DI int row_pos(int row) { return row < SEQ ? row : PAST + ((row - SEQ) & 31); }
DI int row_krow(int row) { if (row < SEQ) return row; const int rs = row - SEQ; return SEQ + (rs >> 5) * SKEYS + PAST + (rs & 31); }
DI float* out_row(float* out, int row, size_t offP, size_t offS, int W) { return row < SEQ ? out + offP + (size_t)row * W : out + offS + (size_t)(row - SEQ) * W; }

#define EPI_ROWS_BEGIN _Pragma("unroll") for (int ai = 0; ai < 2; ++ai) _Pragma("unroll") for (int m = 0; m < 4; ++m) { int row = row0 + ai * 128 + m * 16; asm volatile("" : "+v"(row)); f32x4 v0 = acc[ai][bj][m][0], v1 = acc[ai][bj][m][1];
#define EPI_ROWS_END asm volatile("" ::: "memory"); }

#ifndef TST_GATE
#define TST_GATE 1
#endif
#ifndef TST_KR
#define TST_KR 1
#endif
#ifndef TST_DQ
#define TST_DQ 1
#endif
struct EpiP1 {
    static constexpr bool PERM = true, AFTER_DRAIN = false, MID = false;
    bf16* CQ; bf16* KR; bf16* DQ; bf16* DKP; bf16* DVP; bf16* MQ; bf16* G; float* out; const float* bgate; const float* tabm; const float* tabd;
    DI void operator()(const f32x4 (&acc)[2][2][4][2], const pg8::Unit& u, int wr, int wc, int fr, int fq) const {
        const int row0 = u.pm * 256 + wr * 64 + fr;
#pragma unroll
        for (int bj = 0; bj < 2; ++bj) {
            const int cgp = u.pn * 256 + bj * 128 + wc * 32;
            const int c = cgp + 8 * fq;
            if (TST_GATE && cgp >= INWP) {
                const int gc = c - INWP;
                EPI_ROWS_BEGIN
                    v0 += *(const f32x4*)(bgate + gc); v1 += *(const f32x4*)(bgate + gc + 4);
#pragma unroll
                    for (int e = 0; e < 4; ++e) { v0[e] = 1.f / (1.f + __expf(-v0[e])); v1[e] = 1.f / (1.f + __expf(-v1[e])); }
                    *(u32x4*)(G + (size_t)row * 3072 + gc) = pk8(v0, v1);
                EPI_ROWS_END
            } else if (cgp < 384) {
                EPI_ROWS_BEGIN
                    *(u32x4*)(CQ + (size_t)row * 384 + c) = pk8(v0, v1);
                EPI_ROWS_END
            } else if (cgp < 640) {
                EPI_ROWS_BEGIN
                    float* p = out_row(out, row, O_PCKV, O_SCKV, 256) + (c - 384);
                    *(f32x4*)p = v0; *(f32x4*)(p + 4) = v1;
                EPI_ROWS_END
            } else if (TST_KR && cgp < 672) {
                EPI_ROWS_BEGIN
                    const float* tb = tabm + (size_t)row_pos(row) * 32 + 8 * (fq & 1);
                    float* p = out_row(out, row, O_PKR, O_SKR, 32) + (c - 640);
                    const float sg = fq < 2 ? -1.f : 1.f;
                    f32x4 pv;
#pragma unroll
                    for (int e = 0; e < 4; ++e) pv[e] = __shfl_xor(v0[e], 32);
                    const f32x4 o0 = v0 * *(const f32x4*)tb + pv * (*(const f32x4*)(tb + 16) * sg);
                    asm volatile("" ::: "memory");
#pragma unroll
                    for (int e = 0; e < 4; ++e) pv[e] = __shfl_xor(v1[e], 32);
                    const f32x4 o1 = v1 * *(const f32x4*)(tb + 4) + pv * (*(const f32x4*)(tb + 20) * sg);
                    *(f32x4*)p = o0; *(f32x4*)(p + 4) = o1;
                    *(u32x4*)(KR + (size_t)row_krow(row) * 32 + (c - 640)) = pk8(o0, o1);
                EPI_ROWS_END
            } else if (TST_DQ && cgp < 1696) {
                const bool isq = cgp < 1184;
                EPI_ROWS_BEGIN
                    if (fq == 0) {
                        const float* tb = tabd + (size_t)row_pos(row) * 8;
                        const f32x4 cc = *(const f32x4*)tb, ss = *(const f32x4*)(tb + 4);
                        const f32x4 n0 = v0 * cc - v1 * ss, n1 = v1 * cc + v0 * ss; v0 = n0; v1 = n1;
                    }
                    if (isq) { v0 *= C_DIFF; v1 *= C_DIFF; *(u32x4*)(DQ + (size_t)row * 512 + (c - 672)) = pk8(v0, v1); }
                    else {
                        float* p = out_row(out, row, O_PDK, O_SDK, 512) + (c - 1184);
                        *(f32x4*)p = v0; *(f32x4*)(p + 4) = v1;
                        if (row < SEQ) *(u32x4*)(DKP + (size_t)row * 512 + (c - 1184)) = pk8(v0, v1);
                    }
                EPI_ROWS_END
            } else if (cgp < 2208) {
                EPI_ROWS_BEGIN
                    float* p = out_row(out, row, O_PDV, O_SDV, 512) + (c - 1696);
                    *(f32x4*)p = v0; *(f32x4*)(p + 4) = v1;
                    if (row < SEQ) *(u32x4*)(DVP + (size_t)row * 512 + (c - 1696)) = pk8(v0, v1);
                EPI_ROWS_END
            } else if (cgp < 2720) {
                EPI_ROWS_BEGIN
                    v0 *= C_MEM; v1 *= C_MEM;
                    *(u32x4*)(MQ + (size_t)row * 512 + (c - 2208)) = pk8(v0, v1);
                EPI_ROWS_END
            }
        }
    }
};

struct EpiMemKV {
    static constexpr bool PERM = true, AFTER_DRAIN = false, MID = false;
    float* out; bf16* MK; bf16* MV;
    DI void operator()(const f32x4 (&acc)[2][2][4][2], const pg8::Unit& u, int wr, int wc, int fr, int fq) const {
        const int row0 = u.pm * 256 + wr * 64 + fr;
#pragma unroll
        for (int bj = 0; bj < 2; ++bj) {
            const int c = u.pn * 256 + bj * 128 + wc * 32 + 8 * fq;
            const bool isk = c < 512; const int cc = isk ? c : c - 512;
            float* ob = out + (isk ? O_PMK : O_PMV); bf16* bb = isk ? MK : MV;
            EPI_ROWS_BEGIN
                float* p = ob + (size_t)row * 512 + cc; *(f32x4*)p = v0; *(f32x4*)(p + 4) = v1;
                *(u32x4*)(bb + (size_t)row * 512 + cc) = pk8(v0, v1);
            EPI_ROWS_END
        }
    }
};

struct EpiUQ {
    static constexpr bool PERM = true, AFTER_DRAIN = false, MID = false;
    bf16* QM; const float* tabm;
    DI void operator()(const f32x4 (&acc)[2][2][4][2], const pg8::Unit& u, int wr, int wc, int fr, int fq) const {
        const int row0 = u.pm * 256 + wr * 64 + fr;
#pragma unroll
        for (int bj = 0; bj < 2; ++bj) {
            const int cgp = u.pn * 256 + bj * 128 + wc * 32; const int c = cgp + 8 * fq;
            const bool isrope = ((cgp >> 5) % 3) == 2;
            if (isrope) {
                EPI_ROWS_BEGIN
                    f32x4 p0, p1;
#pragma unroll
                    for (int e = 0; e < 4; ++e) { p0[e] = __shfl_xor(v0[e], 32); p1[e] = __shfl_xor(v1[e], 32); }
                    const float* tb = tabm + (size_t)row_pos(row) * 32 + 8 * (fq & 1);
                    const f32x4 c0 = *(const f32x4*)tb, c1 = *(const f32x4*)(tb + 4), s0 = *(const f32x4*)(tb + 16), s1 = *(const f32x4*)(tb + 20);
                    f32x4 o0, o1;
                    if (fq < 2) { o0 = v0 * c0 - p0 * s0; o1 = v1 * c1 - p1 * s1; } else { o0 = v0 * c0 + p0 * s0; o1 = v1 * c1 + p1 * s1; }
                    o0 *= C_MLA; o1 *= C_MLA;
                    *(u32x4*)(QM + (size_t)row * 768 + c) = pk8(o0, o1);
                    asm volatile("" ::: "memory");
                EPI_ROWS_END
            } else {
                EPI_ROWS_BEGIN
                    v0 *= C_MLA; v1 *= C_MLA;
                    *(u32x4*)(QM + (size_t)row * 768 + c) = pk8(v0, v1);
                EPI_ROWS_END
            }
        }
    }
};

struct EpiBf16Split {
    static constexpr bool PERM = true, AFTER_DRAIN = false, MID = false;
    bf16* A; bf16* B;
    DI void operator()(const f32x4 (&acc)[2][2][4][2], const pg8::Unit& u, int wr, int wc, int fr, int fq) const {
        const int row0 = u.pm * 256 + wr * 64 + fr;
#pragma unroll
        for (int bj = 0; bj < 2; ++bj) {
            const int c = u.pn * 256 + bj * 128 + wc * 32 + 8 * fq;
            bf16* bb = c < 512 ? A + c : B + (c - 512);
            EPI_ROWS_BEGIN
                *(u32x4*)(bb + (size_t)row * 512) = pk8(v0, v1);
            EPI_ROWS_END
        }
    }
};

template <int BR> struct EpiMerge {
    static constexpr bool PERM = true, AFTER_DRAIN = false, MID = false;
    const bf16* G; float* MRG; bf16* MRGB;
    DI void operator()(const f32x4 (&acc)[2][2][4][2], const pg8::Unit& u, int wr, int wc, int fr, int fq) const {
        const int row0 = u.pm * 256 + wr * 64 + fr;
#pragma unroll
        for (int bj = 0; bj < 2; ++bj) {
            const int c = u.pn * 256 + bj * 128 + wc * 32 + 8 * fq;
            EPI_ROWS_BEGIN
                const u32x4 g = *(const u32x4*)(G + (size_t)row * 3072 + BR * 1024 + c);
                const f32x4 g0 = {bf_lo(g.x), bf_hi(g.x), bf_lo(g.y), bf_hi(g.y)}, g1 = {bf_lo(g.z), bf_hi(g.z), bf_lo(g.w), bf_hi(g.w)};
                v0 *= g0; v1 *= g1;
                float* p = MRG + (size_t)row * 1024 + c;
                if (BR > 0) { v0 += *(const f32x4*)p; v1 += *(const f32x4*)(p + 4); }
                if (BR < 2) { *(f32x4*)p = v0; *(f32x4*)(p + 4) = v1; }
                else *(u32x4*)(MRGB + (size_t)row * 1024 + c) = pk8(v0, v1);
            EPI_ROWS_END
        }
    }
};

struct EpiMergeK {
    static constexpr bool PERM = true, AFTER_DRAIN = false, MID = true;
    const bf16* G; bf16* MRGB;
    static DI void gates8(const bf16* p, f32x4& g0, f32x4& g1) { const u32x4 g = *(const u32x4*)p;
        g0 = (f32x4){bf_lo(g.x), bf_hi(g.x), bf_lo(g.y), bf_hi(g.y)}; g1 = (f32x4){bf_lo(g.z), bf_hi(g.z), bf_lo(g.w), bf_hi(g.w)};
#pragma unroll
        for (int e = 0; e < 4; ++e) { g0[e] = fmaxf(g0[e], 1e-18f); g1[e] = fmaxf(g1[e], 1e-18f); } }
    DI void mid(f32x4 (&acc)[2][2][4][2], const pg8::Unit& u, int wr, int wc, int fr, int fq, int br) const {
        const int row0 = u.pm * 256 + wr * 64 + fr;
#pragma unroll
        for (int bj = 0; bj < 2; ++bj) {
            const int c = u.pn * 256 + bj * 128 + wc * 32 + 8 * fq;
#pragma unroll
            for (int ai = 0; ai < 2; ++ai)
#pragma unroll
                for (int m = 0; m < 4; ++m) { int row = row0 + ai * 128 + m * 16; asm volatile("" : "+v"(row));
                    f32x4 p0, p1, c0, c1; gates8(G + (size_t)row * 3072 + (br - 1) * 1024 + c, p0, p1); gates8(G + (size_t)row * 3072 + br * 1024 + c, c0, c1);
#pragma unroll
                    for (int e = 0; e < 4; ++e) { acc[ai][bj][m][0][e] *= p0[e] * __builtin_amdgcn_rcpf(c0[e]); acc[ai][bj][m][1][e] *= p1[e] * __builtin_amdgcn_rcpf(c1[e]); }
                    asm volatile("" ::: "memory"); }
        }
    }
    DI void operator()(const f32x4 (&acc)[2][2][4][2], const pg8::Unit& u, int wr, int wc, int fr, int fq) const {
        const int row0 = u.pm * 256 + wr * 64 + fr;
#pragma unroll
        for (int bj = 0; bj < 2; ++bj) {
            const int c = u.pn * 256 + bj * 128 + wc * 32 + 8 * fq;
            EPI_ROWS_BEGIN
                f32x4 g0, g1; gates8(G + (size_t)row * 3072 + 2048 + c, g0, g1);
                v0 *= g0; v1 *= g1;
                *(u32x4*)(MRGB + (size_t)row * 1024 + c) = pk8(v0, v1);
            EPI_ROWS_END
        }
    }
};

struct EpiF32 {
    static constexpr bool PERM = true, AFTER_DRAIN = false, MID = false;
    float* O; int ldc;
    DI void operator()(const f32x4 (&acc)[2][2][4][2], const pg8::Unit& u, int wr, int wc, int fr, int fq) const {
        const int row0 = u.pm * 256 + wr * 64 + fr;
#pragma unroll
        for (int bj = 0; bj < 2; ++bj) {
            const int c = u.pn * 256 + bj * 128 + wc * 32 + 8 * fq;
            EPI_ROWS_BEGIN
                float* p = O + (size_t)row * ldc + c; *(f32x4*)p = v0; *(f32x4*)(p + 4) = v1;
            EPI_ROWS_END
        }
    }
};

struct EpiUp {
    static constexpr bool PERM = true, AFTER_DRAIN = false, MID = false;
    bf16* U;
    DI void operator()(const f32x4 (&acc)[2][2][4][2], const pg8::Unit& u, int wr, int wc, int fr, int fq) const {
        const int row0 = u.pm * 256 + wr * 64 + fr;
#pragma unroll
        for (int bj = 0; bj < 2; ++bj) {
            const int c = u.pn * 256 + bj * 128 + wc * 32 + 8 * fq;
            EPI_ROWS_BEGIN
#pragma unroll
                for (int e = 0; e < 4; ++e) { const float a = fmaxf(v0[e], 0.f), b = fmaxf(v1[e], 0.f); v0[e] = a * a; v1[e] = b * b; }
                *(u32x4*)(U + (size_t)row * DFF + c) = pk8(v0, v1);
            EPI_ROWS_END
        }
    }
};

struct PieceOrder {
    int S, KL, G, c;
    DI bool next(int i, pg8::Unit& u) const { const int L = i * G + c; if (L >= 8 * S) return false; const int tile = L / S, sl = L % S; u.pm = 64 + (tile >> 2); u.pn = tile & 3; u.kofs = sl * KL; return true; }
    DI void a_ready(const pg8::Unit&) const {}
    DI void done(const pg8::Unit&) const {}
};
struct EpiPart {
    static constexpr bool PERM = true, AFTER_DRAIN = false, MID = false;
    float* P; int KSH;
    DI void operator()(const f32x4 (&acc)[2][2][4][2], const pg8::Unit& u, int wr, int wc, int fr, int fq) const {
        const int row0 = (u.pm - 64) * 256 + wr * 64 + fr; float* base = P + (size_t)(u.kofs >> KSH) * (512 * 1024);
#pragma unroll
        for (int bj = 0; bj < 2; ++bj) {
            const int c = u.pn * 256 + bj * 128 + wc * 32 + 8 * fq;
            EPI_ROWS_BEGIN
                float* p = base + (size_t)row * 1024 + c; *(f32x4*)p = v0; *(f32x4*)(p + 4) = v1;
            EPI_ROWS_END
        }
    }
};

struct Chunk { u32x4 a, b; };
template <bool F32> DI void ld_chunk(Chunk& c, const void* base, size_t eoff, bool valid) {
    c.a = (u32x4){0u, 0u, 0u, 0u}; c.b = (u32x4){0u, 0u, 0u, 0u};
    if (valid) {
        if (F32) { const __attribute__((address_space(1))) float* p = (const __attribute__((address_space(1))) float*)base + eoff; c.a = *(const __attribute__((address_space(1))) u32x4*)p; c.b = *(const __attribute__((address_space(1))) u32x4*)(p + 4); }
        else { c.a = *(const __attribute__((address_space(1))) u32x4*)((const __attribute__((address_space(1))) bf16*)base + eoff); }
    }
}
#define GASP __attribute__((address_space(1)))
template <bool F32> DI void ld_chunk2(Chunk& c, const GASP unsigned char* p, bool valid) {
    c.a = (u32x4){0u, 0u, 0u, 0u}; c.b = (u32x4){0u, 0u, 0u, 0u};
    if (valid) { c.a = *(const GASP u32x4*)p; if (F32) c.b = *(const GASP u32x4*)(p + 16); }
}
template <bool F32> DI u32x4 cvt_chunk(const Chunk& c) {
    if (!F32) return c.a;
    u32x4 w;
    w.x = pk2(__uint_as_float(c.a.x), __uint_as_float(c.a.y)); w.y = pk2(__uint_as_float(c.a.z), __uint_as_float(c.a.w));
    w.z = pk2(__uint_as_float(c.b.x), __uint_as_float(c.b.y)); w.w = pk2(__uint_as_float(c.b.z), __uint_as_float(c.b.w));
    return w;
}
typedef short v4i16_t __attribute__((ext_vector_type(4)));
DI s16x4 vtr(const LAS unsigned char* p) { return __builtin_bit_cast(s16x4, __builtin_amdgcn_ds_read_tr16_b64_v4i16((LAS v4i16_t*)p)); }
DI bf16x8 pack8(const f32x16& s, int b) {
    u32x4 w; w.x = pk2(s[b], s[b + 1]); w.y = pk2(s[b + 2], s[b + 3]); w.z = pk2(s[b + 4], s[b + 5]); w.w = pk2(s[b + 6], s[b + 7]);
    return __builtin_bit_cast(bf16x8, w);
}

struct AU {
    const bf16* Q; int ldq; int qrow0; int nq;
    const void* Ka; const void* Kb; int ldk; int nsplit;
    const bf16* Kr; int ldkr;
    const void* Va; const void* Vb; int ldv;
    int nkeys; int limbase;
    bf16* O; int ldo;
    float lam; const float* subg;
};

template <int MODE, bool F32>
DI void attn_unit(LAS unsigned char* lds, const AU& a, const int tid_in) {
    int tid = tid_in; asm volatile("" : "+v"(tid));
    constexpr int NS = (MODE == 1) ? 2 : 1;
    constexpr int DQK = (MODE == 0) ? 96 : (MODE == 1 ? 64 : 128);
    constexpr int DV = (MODE == 2) ? 128 : 64;
    constexpr int NKS = DQK / 16, NDB = DV / 32;
    constexpr int KSTR = DQK * 2 + 16, VSTR = DV * 2 + 16, KBY = 64 * KSTR, VBY = 64 * VSTR;
    constexpr int KC = (MODE == 0) ? 64 : DQK, KCH = KC / 8, NKJ = KC / 64, VCH = DV / 8, NVJ = DV / 64;
    constexpr bool PREF = (MODE != 2);
    constexpr int NDH = 1;
    constexpr bool PVA = (MODE != 1);
    constexpr float THR = 8.f;
    const int lane = tid & 63, wave = __builtin_amdgcn_readfirstlane(tid >> 6), r = lane & 31, h = lane >> 5;
    const int NT = (a.nkeys + 63) >> 6;
    int lim = a.limbase + (wave >> 1); if (lim > NT - 1) lim = NT - 1;
    const bool active = wave * 32 < a.nq;
    const int ntw = active ? lim + 1 : 0;
#ifndef AT_STAGGER
#define AT_STAGGER 0
#endif
    const bool late = AT_STAGGER && wave >= 4;
    bf16x8 qf[NKS];
#pragma unroll
    for (int s = 0; s < NKS; ++s) {
        qf[s] = (bf16x8){0, 0, 0, 0, 0, 0, 0, 0};
        if (active) qf[s] = *(const bf16x8*)(a.Q + (size_t)(a.qrow0 + wave * 32 + r) * a.ldq + 16 * s + 8 * h);
    }
    float mrun[NS], lrun[NS]; f32x16 o[NS][NDB]; f32x16 sA, sB; f32x16 negm[NS]; bf16x8 pf[NS][2][2];
#pragma unroll
    for (int c = 0; c < NS; ++c) { mrun[c] = 0.f; lrun[c] = 0.f;
#pragma unroll
        for (int i = 0; i < 16; ++i) { sA[i] = 0.f; sB[i] = 0.f; negm[c][i] = 0.f; }
#pragma unroll
        for (int x = 0; x < 4; ++x) pf[c][x >> 1][x & 1] = (bf16x8){0, 0, 0, 0, 0, 0, 0, 0};
#pragma unroll
        for (int d = 0; d < NDB; ++d)
#pragma unroll
            for (int i = 0; i < 16; ++i) o[c][d][i] = 0.f; }
    Chunk ck[NKJ], cr, cv[NVJ];
    constexpr int ESZ = F32 ? 4 : 2;
    int koff_[NKJ], krw_[NKJ], voff_[NVJ], vrw_[NVJ];
#pragma unroll
    for (int j = 0; j < NKJ; ++j) { const int q_ = tid + 512 * j; krw_[j] = q_ / KCH; koff_[j] = (krw_[j] * 512 + (q_ % KCH) * 8) * ESZ; }
#pragma unroll
    for (int j = 0; j < NVJ; ++j) { const int q_ = tid + 512 * j; vrw_[j] = q_ / VCH; voff_[j] = (vrw_[j] * 512 + (q_ % VCH) * 8) * ESZ; }
    cr.a = (u32x4){0u, 0u, 0u, 0u}; cr.b = cr.a;
    const int qq = (lane & 15) >> 2, pp = lane & 3, blk = (lane >> 4) & 1;
    const int kroff = r * KSTR + h * 16, vroff = (4 * h + qq) * VSTR + (16 * blk + 4 * pp) * 2;
#define AT_LOAD(t) do { const int kv0_ = (t) * 64; const bool fs_ = kv0_ < a.nsplit; const size_t tb_ = (size_t)(fs_ ? kv0_ : kv0_ - a.nsplit) * 512; \
        const GASP unsigned char* kbs_ = (const GASP unsigned char*)(fs_ ? a.Ka : a.Kb) + tb_ * ESZ; const GASP unsigned char* vbs_ = (const GASP unsigned char*)(fs_ ? a.Va : a.Vb) + tb_ * ESZ; \
        _Pragma("unroll") for (int j = 0; j < NKJ; ++j) ld_chunk2<F32>(ck[j], kbs_ + koff_[j], kv0_ + krw_[j] < a.nkeys); \
        if (MODE == 0) { if (tid < 256) ld_chunk2<false>(cr, (const GASP unsigned char*)a.Kr + (size_t)kv0_ * 64 + (size_t)((tid >> 2) * 64 + (tid & 3) * 16), kv0_ + (tid >> 2) < a.nkeys); } \
        _Pragma("unroll") for (int j = 0; j < NVJ; ++j) ld_chunk2<F32>(cv[j], vbs_ + voff_[j], kv0_ + vrw_[j] < a.nkeys); } while (0)
#define AT_COMMIT(t) do { LAS unsigned char* kb_ = lds + ((t) % 3) * KBY; LAS unsigned char* vb_ = lds + 3 * KBY + ((t) & 3) * VBY; \
        _Pragma("unroll") for (int j = 0; j < NKJ; ++j) { const int q_ = tid + 512 * j, rw_ = q_ / KCH, ch_ = q_ % KCH; *(LAS u32x4*)(kb_ + rw_ * KSTR + ch_ * 16) = cvt_chunk<F32>(ck[j]); } \
        if (MODE == 0) { if (tid < 256) { const int rw_ = tid >> 2, ch_ = tid & 3; *(LAS u32x4*)(kb_ + rw_ * KSTR + 128 + ch_ * 16) = cr.a; } } \
        _Pragma("unroll") for (int j = 0; j < NVJ; ++j) { const int q_ = tid + 512 * j, rw_ = q_ / VCH, ch_ = q_ % VCH; *(LAS u32x4*)(vb_ + rw_ * VSTR + ch_ * 16) = cvt_chunk<F32>(cv[j]); } } while (0)
#define AT_QKC(tt, c) do { const LAS unsigned char* kp_ = lds + (((tt) % 3) * KBY + kroff); const bool halft_ = (a.nkeys - (tt) * 64) <= 32; \
        f32x16 s0_ = negm[c], s1_ = negm[c];     \
        constexpr int KSN_ = (MODE == 1) ? 2 : NKS; constexpr int KBT_ = (KSN_ > 4) ? ((KSN_ % 4 == 0) ? 4 : 3) : KSN_; \
        _Pragma("unroll") for (int kb0 = 0; kb0 < KSN_; kb0 += KBT_) { \
            bf16x8 kf_[2 * KBT_]; \
            _Pragma("unroll") for (int ks = 0; ks < KBT_; ++ks) { const int kk = ((MODE == 1) ? 2 * (c) : 0) + kb0 + ks; \
                kf_[2 * ks] = *(const LAS bf16x8*)(kp_ + kk * 32); kf_[2 * ks + 1] = *(const LAS bf16x8*)(kp_ + 32 * KSTR + kk * 32); } \
            __builtin_amdgcn_sched_barrier(0); \
            _Pragma("unroll") for (int ks = 0; ks < KBT_; ++ks) { const int kk = ((MODE == 1) ? 2 * (c) : 0) + kb0 + ks; \
                s0_ = __builtin_amdgcn_mfma_f32_32x32x16_bf16(kf_[2 * ks], qf[kk], s0_, 0, 0, 0); \
                s1_ = __builtin_amdgcn_mfma_f32_32x32x16_bf16(kf_[2 * ks + 1], qf[kk], s1_, 0, 0, 0); } \
            __builtin_amdgcn_sched_barrier(0); } \
        if (halft_) { _Pragma("unroll") for (int i = 0; i < 16; ++i) s1_[i] = -1e30f; } \
        sA = s0_; sB = s1_; } while (0)
#define AT_SM(tt, c) do { \
        float mx = fmaxf(sA[0], sB[0]); \
        _Pragma("unroll") for (int i = 1; i < 16; ++i) mx = fmaxf(fmaxf(sA[i], sB[i]), mx); \
        mx = fmaxf(mx, __shfl_xor(mx, 32)); \
        if ((tt) == 0) {     \
            mrun[c] = mx; \
            _Pragma("unroll") for (int i = 0; i < 16; ++i) { sA[i] -= mx; sB[i] -= mx; negm[c][i] = -mx; } \
        } else if (__any(mx > THR)) {     \
            const float dl = fmaxf(mx, 0.f); const float al = __builtin_amdgcn_exp2f(-dl); mrun[c] += dl; lrun[c] *= al; \
            _Pragma("unroll") for (int d = 0; d < NDB; ++d) _Pragma("unroll") for (int i = 0; i < 16; ++i) o[c][d][i] *= al; \
            const float nm = -mrun[c]; \
            _Pragma("unroll") for (int i = 0; i < 16; ++i) { sA[i] -= dl; sB[i] -= dl; negm[c][i] = nm; } } \
        float ps = 0.f; \
        _Pragma("unroll") for (int i = 0; i < 16; ++i) { sA[i] = __builtin_amdgcn_exp2f(sA[i]); sB[i] = __builtin_amdgcn_exp2f(sB[i]); ps += sA[i] + sB[i]; } \
        lrun[c] += ps; \
        pf[c][0][0] = pack8(sA, 0); pf[c][0][1] = pack8(sA, 8); pf[c][1][0] = pack8(sB, 0); pf[c][1][1] = pack8(sB, 8); } while (0)
#define AT_VRD(tt, d0) do { const LAS unsigned char* vp0_ = lds + (3 * KBY + ((tt) & 3) * VBY + vroff); \
        _Pragma("unroll") for (int dd = 0; dd < NDH; ++dd) _Pragma("unroll") for (int kb = 0; kb < 2; ++kb) _Pragma("unroll") for (int sp = 0; sp < 2; ++sp) { \
            const LAS unsigned char* vp = vp0_ + ((kb * 32 + sp * 16) * VSTR + ((d0) + dd) * 64); \
            vlo_[dd * 4 + kb * 2 + sp] = vtr(vp); vhi_[dd * 4 + kb * 2 + sp] = vtr(vp + 8 * VSTR); } } while (0)
#define AT_PVM(d0) do { _Pragma("unroll") for (int dd = 0; dd < NDH; ++dd) _Pragma("unroll") for (int kb = 0; kb < 2; ++kb) _Pragma("unroll") for (int sp = 0; sp < 2; ++sp) { \
            const s16x4 lo = vlo_[dd * 4 + kb * 2 + sp], hi = vhi_[dd * 4 + kb * 2 + sp]; \
            const bf16x8 vf = (bf16x8){lo[0], lo[1], lo[2], lo[3], hi[0], hi[1], hi[2], hi[3]}; \
            _Pragma("unroll") for (int c = 0; c < NS; ++c) o[c][(d0) + dd] = __builtin_amdgcn_mfma_f32_32x32x16_bf16(vf, pf[c][kb][sp], o[c][(d0) + dd], 0, 0, 0); } } while (0)
#define AT_PHA(tt) do { AT_QKC(tt, 0); if (MODE == 1) { AT_SM(tt, 0); } } while (0)
#define AT_PHB(tt) do { s16x4 vlo_[NDH * 4], vhi_[NDH * 4]; \
        AT_VRD(tt, 0); \
        __builtin_amdgcn_sched_barrier(0); \
        if (MODE == 1) { AT_QKC(tt, 1); AT_SM(tt, NS - 1); } else { AT_SM(tt, 0); } \
        __builtin_amdgcn_sched_barrier(0); \
        AT_PVM(0); \
        _Pragma("unroll") for (int d0 = NDH; d0 < NDB; d0 += NDH) { __builtin_amdgcn_sched_barrier(0); AT_VRD(tt, d0); __builtin_amdgcn_sched_barrier(0); AT_PVM(d0); } } while (0)
#define AT_BAR() asm volatile("s_waitcnt lgkmcnt(0)\n\ts_barrier" ::: "memory")
    AT_LOAD(0); AT_COMMIT(0);
    if (NT > 1) { AT_LOAD(1); AT_COMMIT(1); }
    AT_BAR();
    if (late) AT_BAR();
    for (int t = 0; t < NT; ++t) {
        if (PREF && t + 2 < NT) AT_LOAD(t + 2);
        if (PVA) {
            const bool pvok = t >= 1 && t - 1 < ntw;
            s16x4 vlo_[NDH * 4], vhi_[NDH * 4];
            if (pvok) AT_VRD(t - 1, 0);
            __builtin_amdgcn_sched_barrier(0);
            if (t < ntw) AT_QKC(t, 0);
            if (pvok) { AT_PVM(0);
#pragma unroll
                for (int d0 = NDH; d0 < NDB; d0 += NDH) { __builtin_amdgcn_sched_barrier(0); AT_VRD(t - 1, d0); __builtin_amdgcn_sched_barrier(0); AT_PVM(d0); } }
        } else { if (t < ntw) AT_PHA(t); }
        if (AT_STAGGER) AT_BAR();
        if (t < ntw) { if (PVA) { AT_SM(t, 0); } else { AT_PHB(t); } }
        if (t + 2 < NT) { if (!PREF) AT_LOAD(t + 2); AT_COMMIT(t + 2); }
        AT_BAR();
    }
    if (PVA && ntw == NT && ntw > 0) {
        s16x4 vlo_[NDH * 4], vhi_[NDH * 4];
#pragma unroll
        for (int d0 = 0; d0 < NDB; d0 += NDH) { AT_VRD(NT - 1, d0); __builtin_amdgcn_sched_barrier(0); AT_PVM(d0); __builtin_amdgcn_sched_barrier(0); }
    }
    if (AT_STAGGER && !late) AT_BAR();
    AT_BAR();
#undef AT_LOAD
#undef AT_COMMIT
#undef AT_QKC
#undef AT_SM
#undef AT_PHA
#undef AT_PHB
#undef AT_VRD
#undef AT_PVM
#undef AT_BAR
    if (active) {
        const int qi = wave * 32 + r;
        float inv[NS];
#pragma unroll
        for (int c = 0; c < NS; ++c) { const float lt = lrun[c] + __shfl_xor(lrun[c], 32); inv[c] = 1.f / lt; }
        float rs = 1.f;
        if (MODE == 1) {
            float ss = 0.f;
#pragma unroll
            for (int d = 0; d < NDB; ++d)
#pragma unroll
                for (int i = 0; i < 16; ++i) { const float v = o[0][d][i] * inv[0] - a.lam * (o[NS - 1][d][i] * inv[NS - 1]); o[0][d][i] = v; ss += v * v; }
            ss += __shfl_xor(ss, 32);
            rs = rsqrtf(ss * (1.f / 64.f) + EPSN) * (1.f - LAM_INIT);
        } else rs = inv[0];
        bf16* op = a.O + (size_t)(a.qrow0 + qi) * 1536;
#pragma unroll
        for (int d = 0; d < NDB; ++d)
#pragma unroll
            for (int g4 = 0; g4 < 4; ++g4) {
                const int dc = d * 32 + 8 * g4 + 4 * h;
                float w0 = o[0][d][4 * g4] * rs, w1 = o[0][d][4 * g4 + 1] * rs, w2 = o[0][d][4 * g4 + 2] * rs, w3 = o[0][d][4 * g4 + 3] * rs;
                if (MODE == 1) { const f32x4 gg = *(const f32x4*)(a.subg + dc); w0 *= gg[0]; w1 *= gg[1]; w2 *= gg[2]; w3 *= gg[3]; }
                u32x2 w; w.x = pk2(w0, w1); w.y = pk2(w2, w3);
                if (qi < a.nq) *(u32x2*)(op + dc) = w;
            }
    }
}

DI void p0_transpose_item(const float* W, int K, int N, bf16* WT, int row_off, LAS float* scr, int item, int lane, int ldw = 0, int kcol = 0) {
    if (ldw == 0) ldw = K;
    const int nblk = N / 32, kb = item / nblk, nb = item % nblk, k0 = 64 * kb, n0 = 32 * nb;
#pragma unroll 8
    for (int i = 0; i < 32; ++i) { const int kk = 2 * i + (lane >> 5); scr[kk * 33 + (lane & 31)] = W[(size_t)(k0 + kk) * N + n0 + (lane & 31)]; }
    asm volatile("s_waitcnt lgkmcnt(0)" ::: "memory");
    const int c = lane & 7;
#pragma unroll
    for (int j = 0; j < 4; ++j) { const int n = (lane >> 3) + 8 * j; const LAS float* s = scr + (8 * c) * 33 + n;
        u32x4 o; o.x = pk2(s[0 * 33], s[1 * 33]); o.y = pk2(s[2 * 33], s[3 * 33]); o.z = pk2(s[4 * 33], s[5 * 33]); o.w = pk2(s[6 * 33], s[7 * 33]);
        *(u32x4*)(WT + (size_t)(row_off + n0 + n) * ldw + kcol + k0 + 8 * c) = o; }
    asm volatile("s_waitcnt lgkmcnt(0)" ::: "memory");
}
DI void rms_row_1024(const float* xrow, const float* g, bf16* orow, int lane) {
    const f32x4* xr = (const f32x4*)xrow + lane; const f32x4* gr = (const f32x4*)g + lane;
    f32x4 v[4]; float s = 0.f;
#pragma unroll
    for (int j = 0; j < 4; ++j) { v[j] = xr[64 * j]; s += (v[j].x * v[j].x + v[j].y * v[j].y) + (v[j].z * v[j].z + v[j].w * v[j].w); }
    const float rstd = rsqrtf(wave_sum(s) * (1.f / 1024.f) + EPSN);
    u32x2* o8 = (u32x2*)orow + lane;
#pragma unroll
    for (int j = 0; j < 4; ++j) { const f32x4 gg = gr[64 * j]; u32x2 w; w.x = pk2(v[j].x * rstd * gg.x, v[j].y * rstd * gg.y); w.y = pk2(v[j].z * rstd * gg.z, v[j].w * rstd * gg.w); o8[64 * j] = w; }
}


template <int K> DI const float* inp_ld() {
    auto kp = __builtin_amdgcn_kernarg_segment_ptr();
    unsigned long long v;
    asm volatile("s_load_dwordx2 %0, %1, %2\n\ts_waitcnt lgkmcnt(0)" : "=s"(v) : "s"(kp), "n"(K * 8));
    return (const float*)(const __attribute__((address_space(1))) float*)v;
}
#define INP(k) inp_ld<k>()


#define RLX_AGENT __ATOMIC_RELAXED, __HIP_MEMORY_SCOPE_AGENT
#define XB_TMO      128
#define XB_XCNT(j)  (256  + 64 * (j))
#define XB_XSUB(j)  (1280 + 64 * (j))
#define XB_XGEN(j)  (2304 + 64 * (j))
#define XB_TOP      3328
#define XB_TOPGEN   3392
#define XCD_BAR_WORDS 3456
#define XB_SPIN_CAP (1u << 18)

__device__ __forceinline__ unsigned xb_ld(unsigned* p)              { return __hip_atomic_load(p, __ATOMIC_RELAXED, __HIP_MEMORY_SCOPE_AGENT); }
__device__ __forceinline__ unsigned xb_add(unsigned* p, unsigned v) { return __hip_atomic_fetch_add(p, v, __ATOMIC_RELAXED, __HIP_MEMORY_SCOPE_AGENT); }
__device__ __forceinline__ unsigned xb_xcc_id() { return (unsigned)__builtin_amdgcn_s_getreg((3 << 11) | 20) & 0xFu; }
#define XB_SPIN(cond, bar) do { unsigned _sp = 0; while (cond) { __builtin_amdgcn_s_sleep(1); \
    if ((++_sp & 255u) == 0u) { if (xb_ld(&(bar)[XB_TMO])) break; if (_sp > XB_SPIN_CAP) { atomicAdd(&(bar)[XB_TMO], 1u); break; } } } } while (0)

struct XcdBarrier {
    unsigned* bar; unsigned x;
    volatile LAS unsigned* st;
};

__device__ __forceinline__ XcdBarrier xcd_barrier_post(unsigned* bar, volatile LAS unsigned* st) {
    XcdBarrier b; b.bar = bar; b.x = xb_xcc_id(); b.st = st;
    if (threadIdx.x == 0) (void)xb_add(&bar[XB_XCNT(b.x)], 1u);
    return b;
}
__device__ __forceinline__ void xcd_barrier_complete(unsigned* bar, unsigned x, unsigned& nloc, unsigned& nx) {
    const unsigned G = gridDim.x * gridDim.y * gridDim.z;
    unsigned sum, cnt, mine, sp = 0u;
    for (;;) {
        sum = 0u; cnt = 0u; mine = 0u;
#pragma unroll
        for (unsigned j = 0; j < 16; ++j) { const unsigned c = xb_ld(&bar[XB_XCNT(j)]); sum += c; cnt += (c > 0u) ? 1u : 0u; mine = (j == x) ? c : mine; }
        if (sum == G) break;
        __builtin_amdgcn_s_sleep(1);
        if ((++sp & 255u) == 0u) { if (xb_ld(&bar[XB_TMO])) break; if (sp > XB_SPIN_CAP) { atomicAdd(&bar[XB_TMO], 1u); break; } }
    }
    nloc = mine > 0u ? mine : 1u; nx = cnt > 0u ? cnt : 1u;
}

__device__ __forceinline__ void xcd_barrier(const XcdBarrier& b) {
    asm volatile("s_waitcnt vmcnt(0)" ::: "memory");
    __syncthreads();
    if (threadIdx.x == 0) {
        unsigned* bar = b.bar;
        __builtin_amdgcn_s_waitcnt(0);
        unsigned nloc = b.st[0], nx = b.st[1];
        if (nloc == 0u) { xcd_barrier_complete(bar, b.x, nloc, nx); b.st[0] = nloc; b.st[1] = nx; }
        const unsigned old = xb_add(&bar[XB_XSUB(b.x)], 1u);
        const unsigned gen = old / nloc;
        if (old + 1u == (gen + 1u) * nloc) {
            __builtin_amdgcn_fence(__ATOMIC_RELEASE, "agent");
            asm volatile("s_waitcnt vmcnt(0)" ::: "memory");
            const unsigned og = xb_add(&bar[XB_TOP], 1u);
            const unsigned tg = og / nx;
            if (og + 1u == (tg + 1u) * nx) xb_add(&bar[XB_TOPGEN], 1u);
            else XB_SPIN(xb_ld(&bar[XB_TOPGEN]) == tg, bar);
            __builtin_amdgcn_fence(__ATOMIC_ACQUIRE, "agent");
            xb_add(&bar[XB_XGEN(b.x)], 1u);
            asm volatile("s_waitcnt vmcnt(0)" ::: "memory");
        } else {
            XB_SPIN(xb_ld(&bar[XB_XGEN(b.x)]) == gen, bar);
            __builtin_amdgcn_fence(__ATOMIC_ACQUIRE, "agent");
            asm volatile("s_waitcnt vmcnt(0)" ::: "memory");
        }
    }
    __syncthreads();
}

struct Args { const float* in[35]; float* out; unsigned char* ws; int ph_lo, ph_hi; };

constexpr int NPHASE = 11;
constexpr int LDS_BYTES = 147456;

__global__ void __launch_bounds__(512, 2) fwd_kernel(Args args) {
    extern __shared__ __attribute__((aligned(16))) unsigned char lds_raw[];
    LAS unsigned char* lds = (LAS unsigned char*)lds_raw;
    cg::grid_group grid = cg::this_grid();
    volatile LAS unsigned* MISC = (volatile LAS unsigned*)(lds + 131072 + 320);
    if (threadIdx.x < 64) MISC[threadIdx.x] = 0u;
    __syncthreads();
    XcdBarrier xbar; xbar.bar = (unsigned*)args.ws; xbar.x = 0; xbar.st = MISC + 8;
    const int G = gridDim.x, bid = blockIdx.x;
    const int NGW = G * 8;
#define PHASE_IDS int tid = threadIdx.x; asm volatile("" : "+v"(tid)); const int lane = tid & 63, wave = __builtin_amdgcn_readfirstlane(tid >> 6); const int gw = bid * 8 + wave; (void)lane; (void)gw;
    unsigned char* ws = args.ws; float* out = args.out;
    const int lo = args.ph_lo, hi = args.ph_hi;
#ifndef PHM
#define PHM 0x7ff
#endif
#define IN(k) (((PHM >> (k)) & 1) && lo <= (k) && (k) < hi)
#ifndef REPM
#define REPM 0
#endif
#define REPS(k) for (int rq_ = 0; rq_ < (((REPM >> (k)) & 1) ? 2 : 1); ++rq_)
#define SEAM(k) do { if (IN(k) && IN((k) + 1)) { if ((k) == 0) { grid.sync(); xbar = xcd_barrier_post((unsigned*)args.ws, MISC + 8); } else xcd_barrier(xbar); } } while (0)
#define XN ((bf16*)(ws + WS_XN))
#define GB ((bf16*)(ws + WS_G))
#define CQ ((bf16*)(ws + WS_CQ))
#define CQN ((bf16*)(ws + WS_CQN))
#define QM ((bf16*)(ws + WS_QM))
#define DQ ((bf16*)(ws + WS_DQ))
#define MQ ((bf16*)(ws + WS_MQ))
#define DKP ((bf16*)(ws + WS_DKP))
#define DVP ((bf16*)(ws + WS_DVP))
#define KR ((bf16*)(ws + WS_KR))
#define MKB ((bf16*)(ws + WS_MK))
#define MVB ((bf16*)(ws + WS_MV))
#define LAT ((bf16*)(ws + WS_LAT))
#define KN ((bf16*)(ws + WS_KN))
#define VM ((bf16*)(ws + WS_VM))
#define OA ((bf16*)(ws + WS_OA))
#define MRG ((float*)(ws + WS_MRG))
#define MRGB ((bf16*)(ws + WS_MRGB))
#define MIX ((float*)(ws + WS_MIX))
#define UB ((bf16*)(ws + WS_U))
#define TABM ((float*)(ws + WS_TABM))
#define TABD ((float*)(ws + WS_TABD))

    if (IN(0)) REPS(0) {
        PHASE_IDS
        LAS float* scr = (LAS float*)(lds + wave * 16384);
        {
            constexpr int I_IN = 16 * 85, I_G = 16 * 96, I_UQ = 6 * 24, I_UK = 4 * 16, I_MK = 16 * 16, I_O = 8 * 32, I_OUT = 16 * 32, I_UP = 16 * 128, I_DN = 64 * 32;
            constexpr int NITEMS = I_IN + I_G + I_UQ + 2 * I_UK + 2 * I_MK + 3 * I_O + I_OUT + I_UP + I_DN;
            for (int it = gw; it < NITEMS; it += NGW) {
                int r = it;
                if (r < I_IN) { p0_transpose_item(INP(10), 1024, 2720, (bf16*)(ws + W_ING), 0, scr, r, lane); continue; } r -= I_IN;
                if (r < I_G) { p0_transpose_item(INP(27), 1024, 3072, (bf16*)(ws + W_ING), INWP, scr, r, lane); continue; } r -= I_G;
                if (r < I_UQ) { p0_transpose_item(INP(12), 384, 768, (bf16*)(ws + W_UQ), 0, scr, r, lane); continue; } r -= I_UQ;
                if (r < I_UK) { p0_transpose_item(INP(14), 256, 512, (bf16*)(ws + W_UKV), 0, scr, r, lane); continue; } r -= I_UK;
                if (r < I_UK) { p0_transpose_item(INP(15), 256, 512, (bf16*)(ws + W_UKV), 512, scr, r, lane); continue; } r -= I_UK;
                if (r < I_MK) { p0_transpose_item(INP(22), 1024, 512, (bf16*)(ws + W_MEM), 0, scr, r, lane); continue; } r -= I_MK;
                if (r < I_MK) { p0_transpose_item(INP(23), 1024, 512, (bf16*)(ws + W_MEM), 512, scr, r, lane); continue; } r -= I_MK;
                if (r < I_O) { p0_transpose_item(INP(24), 512, 1024, (bf16*)(ws + W_OM), 0, scr, r, lane, 1536, 0); continue; } r -= I_O;
                if (r < I_O) { p0_transpose_item(INP(25), 512, 1024, (bf16*)(ws + W_OM), 0, scr, r, lane, 1536, 512); continue; } r -= I_O;
                if (r < I_O) { p0_transpose_item(INP(26), 512, 1024, (bf16*)(ws + W_OM), 0, scr, r, lane, 1536, 1024); continue; } r -= I_O;
                if (r < I_OUT) { p0_transpose_item(INP(29), 1024, 1024, (bf16*)(ws + W_OUT), 0, scr, r, lane); continue; } r -= I_OUT;
                if (r < I_UP) { p0_transpose_item(INP(32), 1024, 4096, (bf16*)(ws + W_UP), 0, scr, r, lane); continue; } r -= I_UP;
                p0_transpose_item(INP(33), 4096, 1024, (bf16*)(ws + W_DN), 0, scr, r, lane);
            }
        }
        if (bid == 0) for (int i = tid; i < XCD_BAR_WORDS; i += 512) __hip_atomic_store((unsigned*)ws + i, 0u, RLX_AGENT);
        for (int i = gw * 64 + lane; i < 96 * 1024 / 8; i += NGW * 64) *(u32x4*)((bf16*)(ws + W_ING) + (size_t)2720 * 1024 + (size_t)i * 8) = (u32x4){0u, 0u, 0u, 0u};
        for (int m = gw; m < MROWS + NMEM; m += NGW) {
            if (m < SEQ) rms_row_1024(INP(0) + (size_t)m * DM, INP(9), XN + (size_t)m * DM, lane);
            else if (m < MROWS) rms_row_1024(INP(1) + (size_t)(m - SEQ) * DM, INP(9), XN + (size_t)m * DM, lane);
            else rms_row_1024(INP(8) + (size_t)(m - MROWS) * DM, INP(21), MRGB + (size_t)(m - MROWS) * DM, lane);
        }
        for (int i = gw; i < NSB * PAST; i += NGW) {
            const int b = i >> 12, s = i & 4095;
            const f32x4 v = *((const f32x4*)(INP(2) + (size_t)i * 256) + lane);
            u32x2 w; w.x = pk2(v.x, v.y); w.y = pk2(v.z, v.w);
            *((u32x2*)(LAT + (size_t)(SEQ + b * SKEYS + s) * 256) + lane) = w;
        }
        for (int i = gw; i < NSB * PAST / 8; i += NGW) {
            const int rowi = i * 8 + (lane >> 3); const int b = rowi >> 12, s = rowi & 4095;
            const f32x4 v = *((const f32x4*)(INP(3) + (size_t)rowi * 32) + (lane & 7));
            u32x2 w; w.x = pk2(v.x, v.y); w.y = pk2(v.z, v.w);
            *((u32x2*)(KR + (size_t)(SEQ + b * SKEYS + s) * 32) + (lane & 7)) = w;
        }
        for (int i = gw * 64 + lane; i < NSB * NMEM * 512 / 4; i += NGW * 64) {
            const f32x4 a = *((const f32x4*)INP(6) + i), b = *((const f32x4*)INP(7) + i);
            u32x2 w; w.x = pk2(a.x, a.y); w.y = pk2(a.z, a.w); *((u32x2*)(MKB + (size_t)NMEM * 512) + i) = w;
            w.x = pk2(b.x, b.y); w.y = pk2(b.z, b.w); *((u32x2*)(MVB + (size_t)NMEM * 512) + i) = w;
        }
        for (int i = gw * 64 + lane; i < SEQ * 16; i += NGW * 64) {
            const int pos = i >> 4, f = i & 15;
            const float inv = powf(10000.0f, -(float)f * (2.0f / 32.0f)); const float ang = (float)pos * inv;
            TABM[(size_t)pos * 32 + f] = cosf(ang); TABM[(size_t)pos * 32 + 16 + f] = sinf(ang);
        }
        for (int i = gw * 64 + lane; i < SEQ * 4; i += NGW * 64) {
            const int pos = i >> 2, f = i & 3;
            const float inv = powf(500000.0f, -(float)f * (2.0f / 8.0f)); const float ang = (float)pos * inv;
            TABD[(size_t)pos * 8 + f] = cosf(ang); TABD[(size_t)pos * 8 + 4 + f] = sinf(ang);
        }
        asm volatile("s_waitcnt vmcnt(0) lgkmcnt(0)" ::: "memory");
        __syncthreads();
    }
    SEAM(0);

    if (IN(1)) REPS(1) {
        {
            pg8::Gemm g{MRGB, (const bf16*)(ws + W_MEM), NMEM, 1024, 1024}; pg8::StaticOrder S; S.init(NMEM, 1024, G, (bid + 4) % G);
            EpiMemKV E{out, MKB, MVB};
            pg8::gemm_phase<EpiMemKV, pg8::StaticOrder, true, true>(lds, g, S, E);
        }
        {
            pg8::Gemm g{XN, (const bf16*)(ws + W_ING), MROWS, NING, 1024}; pg8::StaticOrder S; S.init(MROWS, NING, G, bid);
            EpiP1 E{CQ, KR, DQ, DKP, DVP, MQ, GB, out, INP(28), TABM, TABD};
            pg8::gemm_phase<EpiP1, pg8::StaticOrder, true, true>(lds, g, S, E);
        }
    }
    SEAM(1);

    if (IN(2)) {
        PHASE_IDS
        for (int row = gw; row < MROWS; row += NGW) {
            {
                u32x4 raw = (u32x4){0u, 0u, 0u, 0u};
                if (lane < 48) raw = *((const u32x4*)(CQ + (size_t)row * 384) + lane);
                float v[8] = {bf_lo(raw.x), bf_hi(raw.x), bf_lo(raw.y), bf_hi(raw.y), bf_lo(raw.z), bf_hi(raw.z), bf_lo(raw.w), bf_hi(raw.w)};
                float s = 0.f;
#pragma unroll
                for (int e = 0; e < 8; ++e) s += v[e] * v[e];
                const float rstd = rsqrtf(wave_sum(s) * (1.f / 384.f) + EPSN);
                if (lane < 48) {
                    const f32x4 g0 = *((const f32x4*)INP(11) + 2 * lane), g1 = *((const f32x4*)INP(11) + 2 * lane + 1);
                    u32x4 w; w.x = pk2(v[0] * rstd * g0.x, v[1] * rstd * g0.y); w.y = pk2(v[2] * rstd * g0.z, v[3] * rstd * g0.w);
                    w.z = pk2(v[4] * rstd * g1.x, v[5] * rstd * g1.y); w.w = pk2(v[6] * rstd * g1.z, v[7] * rstd * g1.w);
                    *((u32x4*)(CQN + (size_t)row * 384) + lane) = w;
                }
            }
            {
                float* p = out_row(out, row, O_PCKV, O_SCKV, 256);
                f32x4 v = *((const f32x4*)p + lane);
                const float s = (v.x * v.x + v.y * v.y) + (v.z * v.z + v.w * v.w);
                const float rstd = rsqrtf(wave_sum(s) * (1.f / 256.f) + EPSN);
                const f32x4 gg = *((const f32x4*)INP(13) + lane);
                v.x *= rstd * gg.x; v.y *= rstd * gg.y; v.z *= rstd * gg.z; v.w *= rstd * gg.w;
                *((f32x4*)p + lane) = v;
                u32x2 w; w.x = pk2(v.x, v.y); w.y = pk2(v.z, v.w);
                *((u32x2*)(LAT + (size_t)row_krow(row) * 256) + lane) = w;
            }
        }
    }
    SEAM(2);

    if (IN(3)) REPS(3) {
#ifndef NO_P3A
        {
            pg8::Gemm g{CQN, (const bf16*)(ws + W_UQ), MROWS, 768, 384}; pg8::StaticOrder S; S.init(MROWS, 768, G, bid);
            EpiUQ E{QM, TABM};
            pg8::gemm_phase<EpiUQ, pg8::StaticOrder, true, true>(lds, g, S, E);
        }
#endif
#ifndef NO_P3B
        {
            pg8::Gemm g{LAT, (const bf16*)(ws + W_UKV), MKROWS, 1024, 256}; pg8::StaticOrder S; S.init(MKROWS, 1024, G, bid);
            EpiBf16Split E{KN, VM};
            pg8::gemm_phase<EpiBf16Split, pg8::StaticOrder, true, true>(lds, g, S, E);
        }
#endif
    }
    SEAM(3);

#ifndef REP_P4
#define REP_P4 1
#endif
    if (IN(4)) for (int rep_ = 0; rep_ < REP_P4; ++rep_) {
        PHASE_IDS
        float lam;
        {
            float sa = 0.f, sb = 0.f;
            if (lane < 32) { sa = INP(16)[lane] * INP(17)[lane]; sb = INP(18)[lane] * INP(19)[lane]; }
            sa = wave_sum(sa); sb = wave_sum(sb);
            lam = expf(sa) - expf(sb) + LAM_INIT;
        }
        constexpr int BIG = 1 << 30;
#define O_MLA OA
#define O_DIFF (OA + 512)
#define O_MEM (OA + 1024)
#ifndef KMASK
#define KMASK 15
#endif
#define AU_INIT(a) AU a; a.lam = lam; a.subg = INP(20); a.ldo = 512; a.Kb = nullptr; a.Vb = nullptr; a.Kr = KR; a.ldkr = 32; a.nsplit = BIG; a.ldk = 512; a.ldv = 512; a.limbase = BIG / 2;
#ifndef REP_MLA
#define REP_MLA 1
#endif
        if (KMASK & 1) for (int rp_ = 0; rp_ < REP_MLA; ++rp_) for (int it = bid; it < (rp_ == 0 ? 384 : 256); it += G) {
            const int ne = it < 256 ? 2 : 1;
#pragma unroll 1
            for (int e = 0; e < ne; ++e) {
                AU_INIT(a)
                if (it < 256) { const int head = it & 7, pair = it >> 3, qb = e == 0 ? 63 - pair : pair;
                    a.qrow0 = qb * 256; a.nq = 256; a.nkeys = (qb + 1) * 256; a.limbase = 4 * qb;
                    a.Q = QM + head * 96; a.ldq = 768; a.Ka = KN + head * 64; a.Va = VM + head * 64; a.O = O_MLA + head * 64;
                } else { const int jj = it - 256, b = jj >> 3, head = jj & 7; const size_t k0 = (size_t)SEQ + (size_t)b * SKEYS;
                    a.qrow0 = SEQ + b * 32; a.nq = 32; a.nkeys = SKEYS;
                    a.Q = QM + head * 96; a.ldq = 768; a.Ka = KN + k0 * 512 + head * 64; a.Kr = KR + k0 * 32; a.Va = VM + k0 * 512 + head * 64; a.O = O_MLA + head * 64; }
                attn_unit<0, false>(lds, a, tid);
            }
        }
#ifndef REP_DIFF
#define REP_DIFF 1
#endif
        if (KMASK & 2) for (int rp_ = 0; rp_ < REP_DIFF; ++rp_) for (int it = bid; it < 256; it += G) {
#pragma unroll 1
            for (int e = 0; e < 2; ++e) {
                AU_INIT(a)
                const int head = it & 7, pair = it >> 3, qb = e == 0 ? 63 - pair : pair;
                a.qrow0 = qb * 256; a.nq = 256; a.nkeys = (qb + 1) * 256; a.limbase = 4 * qb;
                a.Q = DQ + head * 64; a.ldq = 512; a.Ka = DKP + head * 64; a.Va = DVP + head * 64; a.O = O_DIFF + head * 64;
                attn_unit<1, false>(lds, a, tid);
            }
        }
        if (KMASK & 4) for (int it = (bid + G / 2) % G; it < 128; it += G) {
            AU_INIT(a)
            const int b = it >> 3, head = it & 7;
            a.qrow0 = SEQ + b * 32; a.nq = 32; a.nkeys = SKEYS; a.Q = DQ + head * 64; a.ldq = 512; a.nsplit = PAST;
            a.Ka = INP(4) + (size_t)b * PAST * 512 + head * 64; a.Kb = out + O_SDK + (size_t)b * 32 * 512 + head * 64;
            a.Va = INP(5) + (size_t)b * PAST * 512 + head * 64; a.Vb = out + O_SDV + (size_t)b * 32 * 512 + head * 64;
            a.O = O_DIFF + head * 64;
            attn_unit<1, true>(lds, a, tid);
        }
        if (KMASK & 8) for (int it = bid; it < 320; it += G) {
            AU_INIT(a)
            a.nkeys = NMEM; a.ldq = 512;
            if (it < 256) { const int qb = it >> 2, hm = it & 3; a.qrow0 = qb * 256; a.nq = 256; a.Q = MQ + hm * 128; a.Ka = MKB + hm * 128; a.Va = MVB + hm * 128; a.O = O_MEM + hm * 128; }
            else { const int jj = it - 256, b = jj >> 2, hm = jj & 3; a.qrow0 = SEQ + b * 32; a.nq = 32; a.Q = MQ + hm * 128;
                a.Ka = MKB + (size_t)(1 + b) * NMEM * 512 + hm * 128; a.Va = MVB + (size_t)(1 + b) * NMEM * 512 + hm * 128; a.O = O_MEM + hm * 128; }
            attn_unit<2, false>(lds, a, tid);
        }
#undef AU_INIT
    }
    SEAM(4);

    if (IN(5)) REPS(5) {
        pg8::Gemm g{OA, (const bf16*)(ws + W_OM), MROWS, 1024, 1536, 0}; pg8::StaticOrder S; S.init(MROWS, 1024, G, bid); EpiMergeK E{GB, MRGB};
        pg8::gemm_phase<EpiMergeK, pg8::StaticOrder, true, true>(lds, g, S, E);
    }
    SEAM(5);

    if (IN(6)) REPS(6) {
        { pg8::Gemm g{MRGB, (const bf16*)(ws + W_OUT), SEQ, 1024, 1024, 0}; pg8::StaticOrder S; S.init(SEQ, 1024, G, bid); EpiF32 E{MIX, 1024};
          pg8::gemm_phase<EpiF32, pg8::StaticOrder, true, true>(lds, g, S, E); }
        { int kl = 128; asm volatile("" : "+s"(kl));
          pg8::Gemm g{MRGB, (const bf16*)(ws + W_OUT), MROWS, 1024, 1024, kl}; PieceOrder S{8, kl, G, (bid + 96) % G}; EpiPart E{(float*)(ws + WS_PART), 7};
          pg8::gemm_phase<EpiPart, PieceOrder, true, true>(lds, g, S, E); }
    }
    SEAM(6);

    if (IN(7)) REPS(7) {
        PHASE_IDS
        for (int row = gw; row < MROWS; row += NGW) {
            const float* xr = row < SEQ ? INP(0) + (size_t)row * DM : INP(1) + (size_t)(row - SEQ) * DM;
            const f32x4* mr = (const f32x4*)(MIX + (size_t)row * DM) + lane;
            f32x4 v[4]; float s = 0.f;
#pragma unroll
            for (int j = 0; j < 4; ++j) {
                if (row < SEQ) v[j] = mr[64 * j];
                else { const f32x4* pr = (const f32x4*)((const float*)(ws + WS_PART) + (size_t)(row - SEQ) * DM) + lane + 64 * j; v[j] = pr[0];
#pragma unroll
                    for (int sl = 1; sl < 8; ++sl) v[j] += pr[(size_t)sl * (512 * 1024 / 4)]; }
                s += (v[j].x * v[j].x + v[j].y * v[j].y) + (v[j].z * v[j].z + v[j].w * v[j].w); }
            const float rstd = rsqrtf(wave_sum(s) * (1.f / 1024.f) + EPSN);
            float s2 = 0.f;
#pragma unroll
            for (int j = 0; j < 4; ++j) { const f32x4 gg = *((const f32x4*)INP(30) + lane + 64 * j); const f32x4 xx = *((const f32x4*)xr + lane + 64 * j);
                v[j].x = xx.x + v[j].x * rstd * gg.x; v[j].y = xx.y + v[j].y * rstd * gg.y; v[j].z = xx.z + v[j].z * rstd * gg.z; v[j].w = xx.w + v[j].w * rstd * gg.w;
                s2 += (v[j].x * v[j].x + v[j].y * v[j].y) + (v[j].z * v[j].z + v[j].w * v[j].w);
                *((f32x4*)(out + O_Y + (size_t)row * DM) + lane + 64 * j) = v[j]; }
            const float rstd2 = rsqrtf(wave_sum(s2) * (1.f / 1024.f) + EPSN);
#pragma unroll
            for (int j = 0; j < 4; ++j) { const f32x4 gg = *((const f32x4*)INP(31) + lane + 64 * j);
                u32x2 w; w.x = pk2(v[j].x * rstd2 * gg.x, v[j].y * rstd2 * gg.y); w.y = pk2(v[j].z * rstd2 * gg.z, v[j].w * rstd2 * gg.w);
                *((u32x2*)(XN + (size_t)row * DM) + lane + 64 * j) = w; }
        }
    }
    SEAM(7);

    if (IN(8)) REPS(8) {
        pg8::Gemm g{XN, (const bf16*)(ws + W_UP), MROWS, DFF, 1024}; pg8::StaticOrder S; S.init(MROWS, DFF, G, bid); EpiUp E{UB};
        pg8::gemm_phase<EpiUp, pg8::StaticOrder, true, true>(lds, g, S, E);
    }
    SEAM(8);

    if (IN(9)) REPS(9) {
        { pg8::Gemm g{UB, (const bf16*)(ws + W_DN), SEQ, 1024, DFF, 0}; pg8::StaticOrder S; S.init(SEQ, 1024, G, bid); EpiF32 E{MIX, 1024};
          pg8::gemm_phase<EpiF32, pg8::StaticOrder, true, true>(lds, g, S, E); }
        { pg8::Gemm g{UB, (const bf16*)(ws + W_DN), MROWS, 1024, DFF, 256}; PieceOrder S{16, 256, G, bid}; EpiPart E{(float*)(ws + WS_PART), 8};
          pg8::gemm_phase<EpiPart, PieceOrder, true, true>(lds, g, S, E); }
    }
    SEAM(9);

    if (IN(10)) {
        PHASE_IDS
        for (int row = gw; row < MROWS; row += NGW) {
            const f32x4* fr_ = (const f32x4*)(MIX + (size_t)row * DM) + lane;
            f32x4 v[4]; float s = 0.f;
#pragma unroll
            for (int j = 0; j < 4; ++j) {
                if (row < SEQ) v[j] = fr_[64 * j];
                else { const f32x4* pr = (const f32x4*)((const float*)(ws + WS_PART) + (size_t)(row - SEQ) * DM) + lane + 64 * j; v[j] = pr[0];
#pragma unroll
                    for (int sl = 1; sl < 16; ++sl) v[j] += pr[(size_t)sl * (512 * 1024 / 4)]; }
                s += (v[j].x * v[j].x + v[j].y * v[j].y) + (v[j].z * v[j].z + v[j].w * v[j].w); }
            const float rstd = rsqrtf(wave_sum(s) * (1.f / 1024.f) + EPSN);
#pragma unroll
            for (int j = 0; j < 4; ++j) { const f32x4 gg = *((const f32x4*)INP(34) + lane + 64 * j); f32x4* yp = (f32x4*)(out + O_Y + (size_t)row * DM) + lane + 64 * j; const f32x4 xx = *yp;
                f32x4 y; y.x = xx.x + v[j].x * rstd * gg.x; y.y = xx.y + v[j].y * rstd * gg.y; y.z = xx.z + v[j].z * rstd * gg.z; y.w = xx.w + v[j].w * rstd * gg.w; *yp = y; }
        }
    }
#undef IN
#undef SEAM
}

#ifndef MK_N_LAUNCHES
#define MK_N_LAUNCHES 1
#endif

extern "C" void kernel_launch(void* const* d_in, const int* in_sizes, int n_in, void* d_out, int out_size, void* d_ws, size_t ws_size, hipStream_t stream) {
    static int grid = 0;
    if (grid == 0) {
        if (n_in != 35 || out_size != (int)O_END || ws_size < WS_END) { fprintf(stderr, "kernel_launch: unexpected shapes: n_in %d out %d ws %zu\n", n_in, out_size, ws_size); grid = -1; return; }
        int dev = 0, cus = 0, per_cu = 0;
        hipGetDevice(&dev); hipDeviceGetAttribute(&cus, hipDeviceAttributeMultiprocessorCount, dev);
        if (hipFuncSetAttribute((const void*)fwd_kernel, hipFuncAttributeMaxDynamicSharedMemorySize, LDS_BYTES) != hipSuccess) { fprintf(stderr, "kernel_launch: hipFuncSetAttribute failed\n"); grid = -1; return; }
        hipOccupancyMaxActiveBlocksPerMultiprocessor(&per_cu, (const void*)fwd_kernel, 512, LDS_BYTES);
        (void)hipGetLastError();
        if (per_cu < 1) per_cu = 1;
        grid = cus;
    }
    if (grid < 0) return;
    Args a{};
    for (int i = 0; i < 35; ++i) a.in[i] = (const float*)d_in[i];
    a.out = (float*)d_out; a.ws = (unsigned char*)d_ws;
#if MK_N_LAUNCHES == 1
    a.ph_lo = 0; a.ph_hi = NPHASE;
    void* kargs[] = {&a};
    hipError_t e = hipLaunchCooperativeKernel((const void*)fwd_kernel, dim3(grid), dim3(512), kargs, LDS_BYTES, stream);
    if (e != hipSuccess) fprintf(stderr, "cooperative launch failed: %s (grid %d)\n", hipGetErrorString(e), grid);
#else
    for (int p = 0; p < NPHASE; ++p) { a.ph_lo = p; a.ph_hi = p + 1; hipLaunchKernelGGL(fwd_kernel, dim3(grid), dim3(512), LDS_BYTES, stream, a); }
#endif
}
```

```cpp
#include <hip/hip_runtime.h>
#include <hip/hip_cooperative_groups.h>
#include <cstdio>
#include <cstdint>
namespace cg = cooperative_groups;
namespace pg8 {
#define PG8_LAS __attribute__((address_space(3)))
typedef unsigned short bf16_t;
typedef short bf16x8 __attribute__((ext_vector_type(8)));
typedef float f32x4 __attribute__((ext_vector_type(4)));
typedef unsigned u32x4 __attribute__((ext_vector_type(4)));
constexpr int BM = 256, BK = 64, HALF = 128, HTB = HALF * BK * 2  , STAGE_BYTES = 8 * HTB, NXCD = 8, WGM = 8;

__host__ __device__ __forceinline__ int lds_byte(int r, int c) { const int st = (r >> 4) * 2 + (c >> 5), rr = r & 15, cc = c & 31, ob = rr * 64 + cc * 2; return st * 1024 + (ob ^ (((ob >> 9) & 1) << 5)); }
__host__ __device__ __forceinline__ void stage_rc(int b, int& R, int& C) { const int st = b / 1024, sb = b % 1024, swz = sb ^ (((sb >> 9) & 1) << 5); R = (st >> 1) * 16 + swz / 64; C = (st & 1) * 32 + (swz % 64) / 2; }
__host__ __device__ __forceinline__ int perm32(int rho) { const int n = rho >> 4, i = rho & 15; return 8 * (i >> 2) + 4 * n + (i & 3); }

struct Unit { int pm, pn, kofs; };
struct Gemm { const bf16_t* A; const bf16_t* Bt; int M, N, K, KL; };

struct StaticOrder {
    int nM, nN, nwg, G, c;
    __host__ __device__ void init(int M, int N, int G_, int c_) { nM = M / BM; nN = N / BM; nwg = nM * nN; G = G_; c = c_; }
    __host__ __device__ bool next(int i, Unit& u) const {
        const long L = (long)i * G + c; if (L >= nwg) return false;
        int wgid = (int)L; { const int q = nwg / NXCD, r = nwg % NXCD, xcd = wgid % NXCD, off = wgid / NXCD; wgid = (xcd < r ? xcd * (q + 1) : r * (q + 1) + (xcd - r) * q) + off; }
        const int nig = WGM * nN, gid = wgid / nig, fm = gid * WGM, gsz = (nM - fm) < WGM ? (nM - fm) : WGM;
        u.pm = fm + ((wgid % nig) % gsz); u.pn = (wgid % nig) / gsz; u.kofs = 0; return true;
    }
    __device__ __forceinline__ void a_ready(const Unit&) const {}
    __device__ __forceinline__ void done(const Unit&) const {}
};

__device__ __forceinline__ unsigned cvt_pk_bf16(float lo, float hi) { unsigned r; asm volatile("v_cvt_pk_bf16_f32 %0, %1, %2" : "=v"(r) : "v"(lo), "v"(hi)); return r; }
template <class Epi, class Sched, bool ALIGN_EPI = false, bool SP2 = false>
__device__ __forceinline__ void gemm_phase(PG8_LAS unsigned char* lds, const Gemm g, const Sched& S, const Epi& E) {
    int tid_l = threadIdx.x; asm volatile("" : "+v"(tid_l));
    const int tid = tid_l, wid = __builtin_amdgcn_readfirstlane(tid >> 6), lane = tid & 63, wr = wid >> 2, wc = wid & 3, fr = lane & 15, fq = lane >> 4;
    const int K = g.K, nt = (g.KL ? g.KL : K) / BK;
    unsigned voffA[2], voffB[2];
#pragma unroll
    for (int i = 0; i < 2; ++i) { int R, C; stage_rc(tid * 16 + i * 8192, R, C); const int Rb = Epi::PERM ? ((R & ~31) + perm32(R & 31)) : R;
        voffA[i] = (unsigned)(R * K + C) * 2u; voffB[i] = (unsigned)(Rb * K + C) * 2u; }
    const size_t kstep = (size_t)(BK * 2);
    const size_t hstep = (size_t)HALF * K * 2;
    const size_t tstep = 2 * hstep;
    const unsigned ldsw = (unsigned)wid * 1024u;
    const int aoff = lds_byte(wr * 64 + fr, fq * 8), boff = lds_byte(wc * 32 + fr, fq * 8);
#define PG8_SA(b, h) (((b) * 2 + (h)) * HTB)
#define PG8_SB(b, h) ((4 + (b) * 2 + (h)) * HTB)
#define PG8_STAGE(bufoff, gbase, voff) do { _Pragma("unroll") for (int _i = 0; _i < 2; ++_i) \
        __builtin_amdgcn_global_load_lds((const unsigned*)((const char*)(gbase) + (voff)[_i]), (PG8_LAS unsigned*)(lds + (bufoff) + ldsw + _i * 8192), 16, 0, 0); } while (0)
#define PG8_LDA(dst, b, h) do { _Pragma("unroll") for (int m = 0; m < 4; ++m) _Pragma("unroll") for (int k = 0; k < 2; ++k) dst[m][k] = *(const PG8_LAS bf16x8*)(lds + PG8_SA(b, h) + aoff + m * 2048 + k * 1024); } while (0)
#define PG8_LDB(dst, b, h) do { _Pragma("unroll") for (int n = 0; n < 2; ++n) _Pragma("unroll") for (int k = 0; k < 2; ++k) dst[n][k] = *(const PG8_LAS bf16x8*)(lds + PG8_SB(b, h) + boff + n * 2048 + k * 1024); } while (0)
#define PG8_MMA(ai, bj, At, Bt) do { __builtin_amdgcn_s_setprio(1); _Pragma("unroll") for (int m = 0; m < 4; ++m) _Pragma("unroll") for (int n = 0; n < 2; ++n) _Pragma("unroll") for (int k = 0; k < 2; ++k) \
        acc[ai][bj][m][n] = __builtin_amdgcn_mfma_f32_16x16x32_bf16(Bt[n][k], At[m][k], acc[ai][bj][m][n], 0, 0, 0); __builtin_amdgcn_s_setprio(0); } while (0)
#define PG8_WAIT_V(n) asm volatile("s_waitcnt vmcnt(" #n ")" ::: "memory")
#define PG8_WAIT_L(n) asm volatile("s_waitcnt lgkmcnt(" #n ")" ::: "memory")
#define PG8_BAR __builtin_amdgcn_s_barrier()
#define PG8_SCHED __builtin_amdgcn_sched_barrier(0)
    Unit cur, nxt; int ui = 0;
    if (!S.next(0, cur)) return;
    f32x4 acc[2][2][4][2];
#pragma unroll
    for (int a = 0; a < 2; ++a)
#pragma unroll
        for (int b = 0; b < 2; ++b)
#pragma unroll
            for (int m = 0; m < 4; ++m)
#pragma unroll
                for (int n = 0; n < 2; ++n) acc[a][b][m][n] = (f32x4){0.f, 0.f, 0.f, 0.f};
    bf16x8 At[4][2], B0[2][2], B1[2][2];
    const char* cA = (const char*)g.A + (size_t)cur.pm * tstep + (size_t)cur.kofs * 2; const char* cB = (const char*)g.Bt + (size_t)cur.pn * tstep + (size_t)cur.kofs * 2;
    S.a_ready(cur);
    if constexpr (SP2) {
        PG8_STAGE(PG8_SB(0, 0), cB, voffB); PG8_STAGE(PG8_SB(0, 1), cB + hstep, voffB); PG8_STAGE(PG8_SA(0, 0), cA, voffA); PG8_STAGE(PG8_SA(0, 1), cA + hstep, voffA);
        if (wr == 1) PG8_BAR;
        PG8_WAIT_V(2); PG8_BAR;
        PG8_STAGE(PG8_SB(1, 0), cB + kstep, voffB); PG8_STAGE(PG8_SA(1, 0), cA + kstep, voffA); PG8_STAGE(PG8_SB(1, 1), cB + hstep + kstep, voffB);
        PG8_WAIT_V(6); PG8_BAR;
    } else {
        PG8_STAGE(PG8_SB(0, 0), cB, voffB); PG8_STAGE(PG8_SA(0, 0), cA, voffA); PG8_STAGE(PG8_SB(0, 1), cB + hstep, voffB); PG8_STAGE(PG8_SA(0, 1), cA + hstep, voffA);
        if (wr == 1) PG8_BAR;
        PG8_WAIT_V(4); PG8_BAR;
        PG8_STAGE(PG8_SB(1, 0), cB + kstep, voffB); PG8_STAGE(PG8_SA(1, 0), cA + kstep, voffA); PG8_STAGE(PG8_SB(1, 1), cB + hstep + kstep, voffB);
        PG8_WAIT_V(6); PG8_BAR;
    }
    for (;;) {
        const bool has_next = S.next(ui + 1, nxt);
        const char* nA = has_next ? (const char*)g.A + (size_t)nxt.pm * tstep + (size_t)nxt.kofs * 2 : cA; const char* nB = has_next ? (const char*)g.Bt + (size_t)nxt.pn * tstep + (size_t)nxt.kofs * 2 : cB;
        _Pragma("unroll 1") for (int t = 0; t < nt; t += 2) {
            const bool last = (t == nt - 2);
            const char* a1 = cA + (size_t)(t + 1) * kstep;
            const char* a2 = last ? nA : cA + (size_t)(t + 2) * kstep; const char* b2 = last ? nB : cB + (size_t)(t + 2) * kstep;
            const char* a3 = a2 + kstep; const char* b3 = b2 + kstep;
            if (last && has_next) S.a_ready(nxt);
            if constexpr (SP2) {
            PG8_LDB(B0, 0, 0); PG8_LDB(B1, 0, 1); PG8_SCHED; PG8_LDA(At, 0, 0); PG8_STAGE(PG8_SA(1, 1), a1 + hstep, voffA);
            PG8_WAIT_V(8); PG8_WAIT_L(0); PG8_BAR; PG8_MMA(0, 0, At, B0); PG8_MMA(0, 1, At, B1); PG8_BAR; PG8_SCHED;
            PG8_LDA(At, 0, 1); PG8_STAGE(PG8_SB(0, 0), b2, voffB); PG8_STAGE(PG8_SB(0, 1), b2 + hstep, voffB); PG8_STAGE(PG8_SA(0, 0), a2, voffA);
            PG8_WAIT_V(8); PG8_WAIT_L(0); PG8_BAR; PG8_MMA(1, 0, At, B0); PG8_MMA(1, 1, At, B1); PG8_BAR; PG8_SCHED;
            PG8_LDB(B0, 1, 0); PG8_LDB(B1, 1, 1); PG8_SCHED; PG8_LDA(At, 1, 0); PG8_STAGE(PG8_SA(0, 1), a2 + hstep, voffA);
            PG8_WAIT_V(8); PG8_WAIT_L(0); PG8_BAR; PG8_MMA(0, 0, At, B0); PG8_MMA(0, 1, At, B1); PG8_BAR; PG8_SCHED;
            PG8_LDA(At, 1, 1); PG8_STAGE(PG8_SB(1, 0), b3, voffB); PG8_STAGE(PG8_SB(1, 1), b3 + hstep, voffB); PG8_STAGE(PG8_SA(1, 0), a3, voffA);
            PG8_WAIT_V(8); PG8_WAIT_L(0); PG8_BAR; PG8_MMA(1, 0, At, B0); PG8_MMA(1, 1, At, B1); PG8_BAR; PG8_SCHED;
            if constexpr (Epi::MID) { if (!last && ((t + 2) & 7) == 0) { E.mid(acc, cur, wr, wc, fr, fq, (t + 2) >> 3); PG8_SCHED; } }
            } else {
            PG8_LDB(B0, 0, 0); PG8_SCHED; PG8_LDA(At, 0, 0); PG8_STAGE(PG8_SA(1, 1), a1 + hstep, voffA);
            PG8_WAIT_L(8); PG8_BAR; PG8_WAIT_L(0); PG8_MMA(0, 0, At, B0); PG8_BAR; PG8_SCHED;
            PG8_LDB(B1, 0, 1); PG8_STAGE(PG8_SB(0, 0), b2, voffB);
            PG8_BAR; PG8_WAIT_L(0); PG8_MMA(0, 1, At, B1); PG8_BAR;
            PG8_LDA(At, 0, 1); PG8_STAGE(PG8_SA(0, 0), a2, voffA);
            PG8_BAR; PG8_WAIT_L(0); PG8_MMA(1, 0, At, B0); PG8_BAR; PG8_SCHED;
            PG8_STAGE(PG8_SB(0, 1), b2 + hstep, voffB);
            PG8_WAIT_V(6); PG8_BAR; PG8_MMA(1, 1, At, B1); PG8_BAR;
            PG8_LDB(B0, 1, 0); PG8_SCHED; PG8_LDA(At, 1, 0); PG8_STAGE(PG8_SA(0, 1), a2 + hstep, voffA);
            PG8_WAIT_L(8); PG8_BAR; PG8_WAIT_L(0); PG8_MMA(0, 0, At, B0); PG8_BAR; PG8_SCHED;
            PG8_LDB(B1, 1, 1); PG8_STAGE(PG8_SB(1, 0), b3, voffB);
            PG8_BAR; PG8_WAIT_L(0); PG8_MMA(0, 1, At, B1); PG8_BAR;
            PG8_LDA(At, 1, 1); PG8_STAGE(PG8_SA(1, 0), a3, voffA);
            PG8_BAR; PG8_WAIT_L(0); PG8_MMA(1, 0, At, B0); PG8_BAR; PG8_SCHED;
            PG8_STAGE(PG8_SB(1, 1), b3 + hstep, voffB);
            PG8_WAIT_V(6); PG8_BAR; PG8_MMA(1, 1, At, B1); PG8_BAR;
            }
        }
        if constexpr (ALIGN_EPI) { if (wr == 0) PG8_BAR; }
        if constexpr (!Epi::AFTER_DRAIN) { E(acc, cur, wr, wc, fr, fq); S.done(cur); }
        if (!has_next) break;
#pragma unroll
        for (int a = 0; a < 2; ++a)
#pragma unroll
            for (int b = 0; b < 2; ++b)
#pragma unroll
                for (int m = 0; m < 4; ++m)
#pragma unroll
                    for (int n = 0; n < 2; ++n) acc[a][b][m][n] = (f32x4){0.f, 0.f, 0.f, 0.f};
        cur = nxt; cA = nA; cB = nB; ++ui;
        if constexpr (ALIGN_EPI) { if (wr == 1) PG8_BAR; }
    }
    PG8_WAIT_V(0);
    if constexpr (!ALIGN_EPI) { if (wr == 0) PG8_BAR; }
    PG8_BAR;
    if constexpr (Epi::AFTER_DRAIN) { E.fused(acc, cur, wr, wc, fr, fq, lds, wid, lane); S.done(cur); }
#undef PG8_SA
#undef PG8_SB
#undef PG8_STAGE
#undef PG8_LDA
#undef PG8_LDB
#undef PG8_MMA
#undef PG8_WAIT_V
#undef PG8_WAIT_L
#undef PG8_BAR
#undef PG8_SCHED
}
}

#define LAS __attribute__((address_space(3)))
#define DI __device__ __forceinline__
typedef unsigned short bf16;
typedef unsigned u32x4 __attribute__((ext_vector_type(4)));
typedef unsigned u32x2 __attribute__((ext_vector_type(2)));
typedef float f32x4 __attribute__((ext_vector_type(4)));
typedef float f32x2 __attribute__((ext_vector_type(2)));
typedef float f32x16 __attribute__((ext_vector_type(16)));
typedef short bf16x8 __attribute__((ext_vector_type(8)));
typedef short s16x4 __attribute__((ext_vector_type(4)));
typedef __bf16 bf16x2_t __attribute__((ext_vector_type(2)));

constexpr int DM = 1024, SEQ = 16384, NSB = 16, NST = 32, PAST = 4096, NMEM = 256;
constexpr int MROWS = SEQ + NSB * NST;
constexpr int SKEYS = PAST + NST;
constexpr int MKROWS = SEQ + NSB * SKEYS;
constexpr int INWP = 2816, NING = INWP + 3072;
constexpr int DFF = 4096;
constexpr float EPSN = 1e-6f;
constexpr float LOG2E = 1.4426950408889634f;
constexpr float C_MLA = 0.10206207261596575f * LOG2E;
constexpr float C_DIFF = 0.17677669529663687f * LOG2E;
constexpr float C_MEM = 0.08838834764831845f * LOG2E;
constexpr float LAM_INIT = 0.2f;

constexpr size_t O_Y = 0;
constexpr size_t O_PCKV = (size_t)MROWS * DM;
constexpr size_t O_PKR = O_PCKV + (size_t)SEQ * 256;
constexpr size_t O_PDK = O_PKR + (size_t)SEQ * 32;
constexpr size_t O_PDV = O_PDK + (size_t)SEQ * 512;
constexpr size_t O_PMK = O_PDV + (size_t)SEQ * 512;
constexpr size_t O_PMV = O_PMK + (size_t)NMEM * 512;
constexpr size_t O_SCKV = O_PMV + (size_t)NMEM * 512;
constexpr size_t O_SKR = O_SCKV + (size_t)512 * 256;
constexpr size_t O_SDK = O_SKR + (size_t)512 * 32;
constexpr size_t O_SDV = O_SDK + (size_t)512 * 512;
constexpr size_t O_END = O_SDV + (size_t)512 * 512;

constexpr size_t MiB = 1u << 20;
constexpr size_t WS_TABM = 1 * MiB;
constexpr size_t WS_TABD = 3 * MiB;
constexpr size_t WS_W = 4 * MiB;
constexpr size_t W_ING = WS_W;
constexpr size_t W_UQ = W_ING + (size_t)NING * 1024 * 2;
constexpr size_t W_UKV = W_UQ + (size_t)768 * 384 * 2;
constexpr size_t W_MEM = W_UKV + (size_t)1024 * 256 * 2;
constexpr size_t W_OM = W_MEM + (size_t)1024 * 1024 * 2;
constexpr size_t W_OUT = W_OM + (size_t)3 * 1024 * 512 * 2;
constexpr size_t W_UP = W_OUT + (size_t)1024 * 1024 * 2;
constexpr size_t W_DN = W_UP + (size_t)4096 * 1024 * 2;
constexpr size_t W_END = W_DN + (size_t)1024 * 4096 * 2;
static_assert(W_END <= 44 * MiB, "weights");
constexpr size_t WS_G = 44 * MiB;
constexpr size_t WS_MIX = 44 * MiB;
constexpr size_t WS_DQ = 148 * MiB;
constexpr size_t WS_MQ = 165 * MiB;
constexpr size_t WS_QM = 182 * MiB;
constexpr size_t WS_DKP = 208 * MiB;
constexpr size_t WS_DVP = 225 * MiB;
constexpr size_t WS_KR = 242 * MiB;
constexpr size_t WS_MK = 248 * MiB;
constexpr size_t WS_MV = 253 * MiB;
constexpr size_t WS_LAT = 258 * MiB;
constexpr size_t WS_CQN = 299 * MiB;
constexpr size_t WS_OA = 258 * MiB;
constexpr size_t WS_XN = 312 * MiB;
constexpr size_t WS_CQ = 346 * MiB;
constexpr size_t WS_KN = 312 * MiB;
constexpr size_t WS_VM = 393 * MiB;
constexpr size_t WS_MRG = 348 * MiB;
constexpr size_t WS_MRGB = 416 * MiB;
constexpr size_t WS_U = 348 * MiB;
constexpr size_t WS_PART = 480 * MiB;
constexpr size_t WS_END = 512 * MiB;
static_assert(WS_KR + (size_t)MKROWS * 32 * 2 <= WS_MK && WS_LAT + (size_t)MKROWS * 256 * 2 <= WS_CQN && WS_CQN + (size_t)MROWS * 384 * 2 <= WS_XN, "ws map 1");
static_assert(WS_OA + (size_t)3 * MROWS * 512 * 2 <= WS_XN && WS_XN + (size_t)MROWS * 1024 * 2 <= WS_CQ && WS_KN + (size_t)MKROWS * 512 * 2 <= WS_VM, "ws map 2");
static_assert(WS_VM + (size_t)MKROWS * 512 * 2 <= WS_END && WS_MRG + (size_t)MROWS * 1024 * 4 <= WS_MRGB && WS_U + (size_t)MROWS * 4096 * 2 <= WS_END, "ws map 3");
static_assert(WS_G + (size_t)MROWS * 3072 * 2 <= WS_DQ && WS_QM + (size_t)MROWS * 768 * 2 <= WS_DKP && WS_MK + (size_t)17 * 256 * 512 * 2 <= WS_MV && WS_MV + (size_t)17 * 256 * 512 * 2 <= WS_LAT, "ws map 4");

DI unsigned pk2(float lo, float hi) { f32x2 v = {lo, hi}; bf16x2_t b = __builtin_convertvector(v, bf16x2_t); return __builtin_bit_cast(unsigned, b); }
DI u32x4 pk8(f32x4 a, f32x4 b) { u32x4 w; w.x = pk2(a[0], a[1]); w.y = pk2(a[2], a[3]); w.z = pk2(b[0], b[1]); w.w = pk2(b[2], b[3]); return w; }
DI float bf_lo(unsigned u) { return __uint_as_float(u << 16); }
DI float bf_hi(unsigned u) { return __uint_as_float(u & 0xffff0000u); }
DI float wave_sum(float v) {
#pragma unroll
    for (int o = 1; o < 64; o <<= 1) v += __shfl_xor(v, o);
    return v;
}
DI int row_pos(int row) { return row < SEQ ? row : PAST + ((row - SEQ) & 31); }
DI int row_krow(int row) { if (row < SEQ) return row; const int rs = row - SEQ; return SEQ + (rs >> 5) * SKEYS + PAST + (rs & 31); }
DI float* out_row(float* out, int row, size_t offP, size_t offS, int W) { return row < SEQ ? out + offP + (size_t)row * W : out + offS + (size_t)(row - SEQ) * W; }

#define EPI_ROWS_BEGIN _Pragma("unroll") for (int ai = 0; ai < 2; ++ai) _Pragma("unroll") for (int m = 0; m < 4; ++m) { int row = row0 + ai * 128 + m * 16; asm volatile("" : "+v"(row)); f32x4 v0 = acc[ai][bj][m][0], v1 = acc[ai][bj][m][1];
#define EPI_ROWS_END asm volatile("" ::: "memory"); }

#ifndef TST_GATE
#define TST_GATE 1
#endif
#ifndef TST_KR
#define TST_KR 1
#endif
#ifndef TST_DQ
#define TST_DQ 1
#endif
struct EpiP1 {
    static constexpr bool PERM = true, AFTER_DRAIN = false, MID = false;
    bf16* CQ; bf16* KR; bf16* DQ; bf16* DKP; bf16* DVP; bf16* MQ; bf16* G; float* out; const float* bgate; const float* tabm; const float* tabd;
    DI void operator()(const f32x4 (&acc)[2][2][4][2], const pg8::Unit& u, int wr, int wc, int fr, int fq) const {
        const int row0 = u.pm * 256 + wr * 64 + fr;
#pragma unroll
        for (int bj = 0; bj < 2; ++bj) {
            const int cgp = u.pn * 256 + bj * 128 + wc * 32;
            const int c = cgp + 8 * fq;
            if (TST_GATE && cgp >= INWP) {
                const int gc = c - INWP;
                EPI_ROWS_BEGIN
                    v0 += *(const f32x4*)(bgate + gc); v1 += *(const f32x4*)(bgate + gc + 4);
#pragma unroll
                    for (int e = 0; e < 4; ++e) { v0[e] = 1.f / (1.f + __expf(-v0[e])); v1[e] = 1.f / (1.f + __expf(-v1[e])); }
                    *(u32x4*)(G + (size_t)row * 3072 + gc) = pk8(v0, v1);
                EPI_ROWS_END
            } else if (cgp < 384) {
                EPI_ROWS_BEGIN
                    *(u32x4*)(CQ + (size_t)row * 384 + c) = pk8(v0, v1);
                EPI_ROWS_END
            } else if (cgp < 640) {
                EPI_ROWS_BEGIN
                    float* p = out_row(out, row, O_PCKV, O_SCKV, 256) + (c - 384);
                    *(f32x4*)p = v0; *(f32x4*)(p + 4) = v1;
                EPI_ROWS_END
            } else if (TST_KR && cgp < 672) {
                EPI_ROWS_BEGIN
                    const float* tb = tabm + (size_t)row_pos(row) * 32 + 8 * (fq & 1);
                    float* p = out_row(out, row, O_PKR, O_SKR, 32) + (c - 640);
                    const float sg = fq < 2 ? -1.f : 1.f;
                    f32x4 pv;
#pragma unroll
                    for (int e = 0; e < 4; ++e) pv[e] = __shfl_xor(v0[e], 32);
                    const f32x4 o0 = v0 * *(const f32x4*)tb + pv * (*(const f32x4*)(tb + 16) * sg);
                    asm volatile("" ::: "memory");
#pragma unroll
                    for (int e = 0; e < 4; ++e) pv[e] = __shfl_xor(v1[e], 32);
                    const f32x4 o1 = v1 * *(const f32x4*)(tb + 4) + pv * (*(const f32x4*)(tb + 20) * sg);
                    *(f32x4*)p = o0; *(f32x4*)(p + 4) = o1;
                    *(u32x4*)(KR + (size_t)row_krow(row) * 32 + (c - 640)) = pk8(o0, o1);
                EPI_ROWS_END
            } else if (TST_DQ && cgp < 1696) {
                const bool isq = cgp < 1184;
                EPI_ROWS_BEGIN
                    if (fq == 0) {
                        const float* tb = tabd + (size_t)row_pos(row) * 8;
                        const f32x4 cc = *(const f32x4*)tb, ss = *(const f32x4*)(tb + 4);
                        const f32x4 n0 = v0 * cc - v1 * ss, n1 = v1 * cc + v0 * ss; v0 = n0; v1 = n1;
                    }
                    if (isq) { v0 *= C_DIFF; v1 *= C_DIFF; *(u32x4*)(DQ + (size_t)row * 512 + (c - 672)) = pk8(v0, v1); }
                    else {
                        float* p = out_row(out, row, O_PDK, O_SDK, 512) + (c - 1184);
                        *(f32x4*)p = v0; *(f32x4*)(p + 4) = v1;
                        if (row < SEQ) *(u32x4*)(DKP + (size_t)row * 512 + (c - 1184)) = pk8(v0, v1);
                    }
                EPI_ROWS_END
            } else if (cgp < 2208) {
                EPI_ROWS_BEGIN
                    float* p = out_row(out, row, O_PDV, O_SDV, 512) + (c - 1696);
                    *(f32x4*)p = v0; *(f32x4*)(p + 4) = v1;
                    if (row < SEQ) *(u32x4*)(DVP + (size_t)row * 512 + (c - 1696)) = pk8(v0, v1);
                EPI_ROWS_END
            } else if (cgp < 2720) {
                EPI_ROWS_BEGIN
                    v0 *= C_MEM; v1 *= C_MEM;
                    *(u32x4*)(MQ + (size_t)row * 512 + (c - 2208)) = pk8(v0, v1);
                EPI_ROWS_END
            }
        }
    }
};

struct EpiMemKV {
    static constexpr bool PERM = true, AFTER_DRAIN = false, MID = false;
    float* out; bf16* MK; bf16* MV;
    DI void operator()(const f32x4 (&acc)[2][2][4][2], const pg8::Unit& u, int wr, int wc, int fr, int fq) const {
        const int row0 = u.pm * 256 + wr * 64 + fr;
#pragma unroll
        for (int bj = 0; bj < 2; ++bj) {
            const int c = u.pn * 256 + bj * 128 + wc * 32 + 8 * fq;
            const bool isk = c < 512; const int cc = isk ? c : c - 512;
            float* ob = out + (isk ? O_PMK : O_PMV); bf16* bb = isk ? MK : MV;
            EPI_ROWS_BEGIN
                float* p = ob + (size_t)row * 512 + cc; *(f32x4*)p = v0; *(f32x4*)(p + 4) = v1;
                *(u32x4*)(bb + (size_t)row * 512 + cc) = pk8(v0, v1);
            EPI_ROWS_END
        }
    }
};

struct EpiUQ {
    static constexpr bool PERM = true, AFTER_DRAIN = false, MID = false;
    bf16* QM; const float* tabm;
    DI void operator()(const f32x4 (&acc)[2][2][4][2], const pg8::Unit& u, int wr, int wc, int fr, int fq) const {
        const int row0 = u.pm * 256 + wr * 64 + fr;
#pragma unroll
        for (int bj = 0; bj < 2; ++bj) {
            const int cgp = u.pn * 256 + bj * 128 + wc * 32; const int c = cgp + 8 * fq;
            const bool isrope = ((cgp >> 5) % 3) == 2;
            if (isrope) {
                EPI_ROWS_BEGIN
                    f32x4 p0, p1;
#pragma unroll
                    for (int e = 0; e < 4; ++e) { p0[e] = __shfl_xor(v0[e], 32); p1[e] = __shfl_xor(v1[e], 32); }
                    const float* tb = tabm + (size_t)row_pos(row) * 32 + 8 * (fq & 1);
                    const f32x4 c0 = *(const f32x4*)tb, c1 = *(const f32x4*)(tb + 4), s0 = *(const f32x4*)(tb + 16), s1 = *(const f32x4*)(tb + 20);
                    f32x4 o0, o1;
                    if (fq < 2) { o0 = v0 * c0 - p0 * s0; o1 = v1 * c1 - p1 * s1; } else { o0 = v0 * c0 + p0 * s0; o1 = v1 * c1 + p1 * s1; }
                    o0 *= C_MLA; o1 *= C_MLA;
                    *(u32x4*)(QM + (size_t)row * 768 + c) = pk8(o0, o1);
                    asm volatile("" ::: "memory");
                EPI_ROWS_END
            } else {
                EPI_ROWS_BEGIN
                    v0 *= C_MLA; v1 *= C_MLA;
                    *(u32x4*)(QM + (size_t)row * 768 + c) = pk8(v0, v1);
                EPI_ROWS_END
            }
        }
    }
};

struct EpiBf16Split {
    static constexpr bool PERM = true, AFTER_DRAIN = false, MID = false;
    bf16* A; bf16* B;
    DI void operator()(const f32x4 (&acc)[2][2][4][2], const pg8::Unit& u, int wr, int wc, int fr, int fq) const {
        const int row0 = u.pm * 256 + wr * 64 + fr;
#pragma unroll
        for (int bj = 0; bj < 2; ++bj) {
            const int c = u.pn * 256 + bj * 128 + wc * 32 + 8 * fq;
            bf16* bb = c < 512 ? A + c : B + (c - 512);
            EPI_ROWS_BEGIN
                *(u32x4*)(bb + (size_t)row * 512) = pk8(v0, v1);
            EPI_ROWS_END
        }
    }
};

template <int BR> struct EpiMerge {
    static constexpr bool PERM = true, AFTER_DRAIN = false, MID = false;
    const bf16* G; float* MRG; bf16* MRGB;
    DI void operator()(const f32x4 (&acc)[2][2][4][2], const pg8::Unit& u, int wr, int wc, int fr, int fq) const {
        const int row0 = u.pm * 256 + wr * 64 + fr;
#pragma unroll
        for (int bj = 0; bj < 2; ++bj) {
            const int c = u.pn * 256 + bj * 128 + wc * 32 + 8 * fq;
            EPI_ROWS_BEGIN
                const u32x4 g = *(const u32x4*)(G + (size_t)row * 3072 + BR * 1024 + c);
                const f32x4 g0 = {bf_lo(g.x), bf_hi(g.x), bf_lo(g.y), bf_hi(g.y)}, g1 = {bf_lo(g.z), bf_hi(g.z), bf_lo(g.w), bf_hi(g.w)};
                v0 *= g0; v1 *= g1;
                float* p = MRG + (size_t)row * 1024 + c;
                if (BR > 0) { v0 += *(const f32x4*)p; v1 += *(const f32x4*)(p + 4); }
                if (BR < 2) { *(f32x4*)p = v0; *(f32x4*)(p + 4) = v1; }
                else *(u32x4*)(MRGB + (size_t)row * 1024 + c) = pk8(v0, v1);
            EPI_ROWS_END
        }
    }
};

struct EpiMergeK {
    static constexpr bool PERM = true, AFTER_DRAIN = false, MID = true;
    const bf16* G; bf16* MRGB;
    static DI void gates8(const bf16* p, f32x4& g0, f32x4& g1) { const u32x4 g = *(const u32x4*)p;
        g0 = (f32x4){bf_lo(g.x), bf_hi(g.x), bf_lo(g.y), bf_hi(g.y)}; g1 = (f32x4){bf_lo(g.z), bf_hi(g.z), bf_lo(g.w), bf_hi(g.w)};
#pragma unroll
        for (int e = 0; e < 4; ++e) { g0[e] = fmaxf(g0[e], 1e-18f); g1[e] = fmaxf(g1[e], 1e-18f); } }
    DI void mid(f32x4 (&acc)[2][2][4][2], const pg8::Unit& u, int wr, int wc, int fr, int fq, int br) const {
        const int row0 = u.pm * 256 + wr * 64 + fr;
#pragma unroll
        for (int bj = 0; bj < 2; ++bj) {
            const int c = u.pn * 256 + bj * 128 + wc * 32 + 8 * fq;
#pragma unroll
            for (int ai = 0; ai < 2; ++ai)
#pragma unroll
                for (int m = 0; m < 4; ++m) { int row = row0 + ai * 128 + m * 16; asm volatile("" : "+v"(row));
                    f32x4 p0, p1, c0, c1; gates8(G + (size_t)row * 3072 + (br - 1) * 1024 + c, p0, p1); gates8(G + (size_t)row * 3072 + br * 1024 + c, c0, c1);
#pragma unroll
                    for (int e = 0; e < 4; ++e) { acc[ai][bj][m][0][e] *= p0[e] * __builtin_amdgcn_rcpf(c0[e]); acc[ai][bj][m][1][e] *= p1[e] * __builtin_amdgcn_rcpf(c1[e]); }
                    asm volatile("" ::: "memory"); }
        }
    }
    DI void operator()(const f32x4 (&acc)[2][2][4][2], const pg8::Unit& u, int wr, int wc, int fr, int fq) const {
        const int row0 = u.pm * 256 + wr * 64 + fr;
#pragma unroll
        for (int bj = 0; bj < 2; ++bj) {
            const int c = u.pn * 256 + bj * 128 + wc * 32 + 8 * fq;
            EPI_ROWS_BEGIN
                f32x4 g0, g1; gates8(G + (size_t)row * 3072 + 2048 + c, g0, g1);
                v0 *= g0; v1 *= g1;
                *(u32x4*)(MRGB + (size_t)row * 1024 + c) = pk8(v0, v1);
            EPI_ROWS_END
        }
    }
};

struct EpiF32 {
    static constexpr bool PERM = true, AFTER_DRAIN = false, MID = false;
    float* O; int ldc;
    DI void operator()(const f32x4 (&acc)[2][2][4][2], const pg8::Unit& u, int wr, int wc, int fr, int fq) const {
        const int row0 = u.pm * 256 + wr * 64 + fr;
#pragma unroll
        for (int bj = 0; bj < 2; ++bj) {
            const int c = u.pn * 256 + bj * 128 + wc * 32 + 8 * fq;
            EPI_ROWS_BEGIN
                float* p = O + (size_t)row * ldc + c; *(f32x4*)p = v0; *(f32x4*)(p + 4) = v1;
            EPI_ROWS_END
        }
    }
};

struct EpiUp {
    static constexpr bool PERM = true, AFTER_DRAIN = false, MID = false;
    bf16* U;
    DI void operator()(const f32x4 (&acc)[2][2][4][2], const pg8::Unit& u, int wr, int wc, int fr, int fq) const {
        const int row0 = u.pm * 256 + wr * 64 + fr;
#pragma unroll
        for (int bj = 0; bj < 2; ++bj) {
            const int c = u.pn * 256 + bj * 128 + wc * 32 + 8 * fq;
            EPI_ROWS_BEGIN
#pragma unroll
                for (int e = 0; e < 4; ++e) { const float a = fmaxf(v0[e], 0.f), b = fmaxf(v1[e], 0.f); v0[e] = a * a; v1[e] = b * b; }
                *(u32x4*)(U + (size_t)row * DFF + c) = pk8(v0, v1);
            EPI_ROWS_END
        }
    }
};

struct PieceOrder {
    int S, KL, G, c;
    DI bool next(int i, pg8::Unit& u) const { const int L = i * G + c; if (L >= 8 * S) return false; const int tile = L / S, sl = L % S; u.pm = 64 + (tile >> 2); u.pn = tile & 3; u.kofs = sl * KL; return true; }
    DI void a_ready(const pg8::Unit&) const {}
    DI void done(const pg8::Unit&) const {}
};
struct EpiPart {
    static constexpr bool PERM = true, AFTER_DRAIN = false, MID = false;
    float* P; int KSH;
    DI void operator()(const f32x4 (&acc)[2][2][4][2], const pg8::Unit& u, int wr, int wc, int fr, int fq) const {
        const int row0 = (u.pm - 64) * 256 + wr * 64 + fr; float* base = P + (size_t)(u.kofs >> KSH) * (512 * 1024);
#pragma unroll
        for (int bj = 0; bj < 2; ++bj) {
            const int c = u.pn * 256 + bj * 128 + wc * 32 + 8 * fq;
            EPI_ROWS_BEGIN
                float* p = base + (size_t)row * 1024 + c; *(f32x4*)p = v0; *(f32x4*)(p + 4) = v1;
            EPI_ROWS_END
        }
    }
};

struct Chunk { u32x4 a, b; };
template <bool F32> DI void ld_chunk(Chunk& c, const void* base, size_t eoff, bool valid) {
    c.a = (u32x4){0u, 0u, 0u, 0u}; c.b = (u32x4){0u, 0u, 0u, 0u};
    if (valid) {
        if (F32) { const __attribute__((address_space(1))) float* p = (const __attribute__((address_space(1))) float*)base + eoff; c.a = *(const __attribute__((address_space(1))) u32x4*)p; c.b = *(const __attribute__((address_space(1))) u32x4*)(p + 4); }
        else { c.a = *(const __attribute__((address_space(1))) u32x4*)((const __attribute__((address_space(1))) bf16*)base + eoff); }
    }
}
#define GASP __attribute__((address_space(1)))
template <bool F32> DI void ld_chunk2(Chunk& c, const GASP unsigned char* p, bool valid) {
    c.a = (u32x4){0u, 0u, 0u, 0u}; c.b = (u32x4){0u, 0u, 0u, 0u};
    if (valid) { c.a = *(const GASP u32x4*)p; if (F32) c.b = *(const GASP u32x4*)(p + 16); }
}
template <bool F32> DI u32x4 cvt_chunk(const Chunk& c) {
    if (!F32) return c.a;
    u32x4 w;
    w.x = pk2(__uint_as_float(c.a.x), __uint_as_float(c.a.y)); w.y = pk2(__uint_as_float(c.a.z), __uint_as_float(c.a.w));
    w.z = pk2(__uint_as_float(c.b.x), __uint_as_float(c.b.y)); w.w = pk2(__uint_as_float(c.b.z), __uint_as_float(c.b.w));
    return w;
}
typedef short v4i16_t __attribute__((ext_vector_type(4)));
DI s16x4 vtr(const LAS unsigned char* p) { return __builtin_bit_cast(s16x4, __builtin_amdgcn_ds_read_tr16_b64_v4i16((LAS v4i16_t*)p)); }
DI bf16x8 pack8(const f32x16& s, int b) {
    u32x4 w; w.x = pk2(s[b], s[b + 1]); w.y = pk2(s[b + 2], s[b + 3]); w.z = pk2(s[b + 4], s[b + 5]); w.w = pk2(s[b + 6], s[b + 7]);
    return __builtin_bit_cast(bf16x8, w);
}

struct AU {
    const bf16* Q; int ldq; int qrow0; int nq;
    const void* Ka; const void* Kb; int ldk; int nsplit;
    const bf16* Kr; int ldkr;
    const void* Va; const void* Vb; int ldv;
    int nkeys; int limbase;
    bf16* O; int ldo;
    float lam; const float* subg;
};

template <int MODE, bool F32, bool FULL>
DI void attn_unit(LAS unsigned char* lds, const AU& a, const int tid_in) {
    int tid = tid_in; asm volatile("" : "+v"(tid));
    constexpr int NS = (MODE == 1) ? 2 : 1;
    constexpr int DQK = (MODE == 0) ? 96 : (MODE == 1 ? 64 : 128);
    constexpr int DV = (MODE == 2) ? 128 : 64;
    constexpr int NKS = DQK / 16, NDB = DV / 32;
    constexpr int KSTR = DQK * 2 + 16, VSTR = DV * 2 + 16, KBY = 64 * KSTR, VBY = 64 * VSTR;
    constexpr int KC = (MODE == 0) ? 64 : DQK, KCH = KC / 8, NKJ = KC / 64, VCH = DV / 8, NVJ = DV / 64;
    constexpr bool PREF = (MODE != 2);
    constexpr int NDH = 1;
    constexpr bool PVA = (MODE != 1);
    constexpr float THR = 8.f;
    const int lane = tid & 63, wave = __builtin_amdgcn_readfirstlane(tid >> 6), r = lane & 31, h = lane >> 5;
    const int NT = (a.nkeys + 63) >> 6;
    int lim = a.limbase + (wave >> 1); if (lim > NT - 1) lim = NT - 1;
    const bool active = wave * 32 < a.nq;
    const int ntw = active ? lim + 1 : 0;
#ifndef AT_STAGGER
#define AT_STAGGER 0
#endif
    const bool late = AT_STAGGER && wave >= 4;
    bf16x8 qf[NKS];
#pragma unroll
    for (int s = 0; s < NKS; ++s) {
        qf[s] = (bf16x8){0, 0, 0, 0, 0, 0, 0, 0};
        if (active) qf[s] = *(const bf16x8*)(a.Q + (size_t)(a.qrow0 + wave * 32 + r) * a.ldq + 16 * s + 8 * h);
    }
    float mrun[NS], lrun[NS]; f32x16 o[NS][NDB]; f32x16 sA, sB; f32x16 negm[NS]; bf16x8 pf[NS][2][2];
#pragma unroll
    for (int c = 0; c < NS; ++c) { mrun[c] = 0.f; lrun[c] = 0.f;
#pragma unroll
        for (int i = 0; i < 16; ++i) { sA[i] = 0.f; sB[i] = 0.f; negm[c][i] = 0.f; }
#pragma unroll
        for (int x = 0; x < 4; ++x) pf[c][x >> 1][x & 1] = (bf16x8){0, 0, 0, 0, 0, 0, 0, 0};
#pragma unroll
        for (int d = 0; d < NDB; ++d)
#pragma unroll
            for (int i = 0; i < 16; ++i) o[c][d][i] = 0.f; }
    Chunk ck[NKJ], cr, cv[NVJ];
    constexpr int ESZ = F32 ? 4 : 2;
    int koff_[NKJ], krw_[NKJ], voff_[NVJ], vrw_[NVJ];
#pragma unroll
    for (int j = 0; j < NKJ; ++j) { const int q_ = tid + 512 * j; krw_[j] = q_ / KCH; koff_[j] = (krw_[j] * 512 + (q_ % KCH) * 8) * ESZ; }
#pragma unroll
    for (int j = 0; j < NVJ; ++j) { const int q_ = tid + 512 * j; vrw_[j] = q_ / VCH; voff_[j] = (vrw_[j] * 512 + (q_ % VCH) * 8) * ESZ; }
    cr.a = (u32x4){0u, 0u, 0u, 0u}; cr.b = cr.a;
    const int qq = (lane & 15) >> 2, pp = lane & 3, blk = (lane >> 4) & 1;
    const int kroff = r * KSTR + h * 16, vroff = (4 * h + qq) * VSTR + (16 * blk + 4 * pp) * 2;
#define AT_LOAD(t) do { const int kv0_ = (t) * 64; const bool fs_ = FULL || kv0_ < a.nsplit; const size_t tb_ = (size_t)(fs_ ? kv0_ : kv0_ - a.nsplit) * 512; \
        const GASP unsigned char* kbs_ = (const GASP unsigned char*)(fs_ ? a.Ka : a.Kb) + tb_ * ESZ; const GASP unsigned char* vbs_ = (const GASP unsigned char*)(fs_ ? a.Va : a.Vb) + tb_ * ESZ; \
        _Pragma("unroll") for (int j = 0; j < NKJ; ++j) ld_chunk2<F32>(ck[j], kbs_ + koff_[j], FULL || kv0_ + krw_[j] < a.nkeys); \
        if (MODE == 0) { if (tid < 256) ld_chunk2<false>(cr, (const GASP unsigned char*)a.Kr + (size_t)kv0_ * 64 + (size_t)((tid >> 2) * 64 + (tid & 3) * 16), FULL || kv0_ + (tid >> 2) < a.nkeys); } \
        _Pragma("unroll") for (int j = 0; j < NVJ; ++j) ld_chunk2<F32>(cv[j], vbs_ + voff_[j], FULL || kv0_ + vrw_[j] < a.nkeys); } while (0)
#define AT_COMMIT(t) do { LAS unsigned char* kb_ = lds + ((t) % 3) * KBY; LAS unsigned char* vb_ = lds + 3 * KBY + ((t) & 3) * VBY; \
        _Pragma("unroll") for (int j = 0; j < NKJ; ++j) { const int q_ = tid + 512 * j, rw_ = q_ / KCH, ch_ = q_ % KCH; *(LAS u32x4*)(kb_ + rw_ * KSTR + ch_ * 16) = cvt_chunk<F32>(ck[j]); } \
        if (MODE == 0) { if (tid < 256) { const int rw_ = tid >> 2, ch_ = tid & 3; *(LAS u32x4*)(kb_ + rw_ * KSTR + 128 + ch_ * 16) = cr.a; } } \
        _Pragma("unroll") for (int j = 0; j < NVJ; ++j) { const int q_ = tid + 512 * j, rw_ = q_ / VCH, ch_ = q_ % VCH; *(LAS u32x4*)(vb_ + rw_ * VSTR + ch_ * 16) = cvt_chunk<F32>(cv[j]); } } while (0)
#define AT_QKC(tt, c) do { const LAS unsigned char* kp_ = lds + (((tt) % 3) * KBY + kroff); const bool halft_ = !FULL && (a.nkeys - (tt) * 64) <= 32; \
        f32x16 s0_ = negm[c], s1_ = negm[c];     \
        constexpr int KSN_ = (MODE == 1) ? 2 : NKS; constexpr int KBT_ = (KSN_ > 4) ? ((KSN_ % 4 == 0) ? 4 : 3) : KSN_; \
        _Pragma("unroll") for (int kb0 = 0; kb0 < KSN_; kb0 += KBT_) { \
            bf16x8 kf_[2 * KBT_]; \
            _Pragma("unroll") for (int ks = 0; ks < KBT_; ++ks) { const int kk = ((MODE == 1) ? 2 * (c) : 0) + kb0 + ks; \
                kf_[2 * ks] = *(const LAS bf16x8*)(kp_ + kk * 32); kf_[2 * ks + 1] = *(const LAS bf16x8*)(kp_ + 32 * KSTR + kk * 32); } \
            __builtin_amdgcn_sched_barrier(0); \
            _Pragma("unroll") for (int ks = 0; ks < KBT_; ++ks) { const int kk = ((MODE == 1) ? 2 * (c) : 0) + kb0 + ks; \
                s0_ = __builtin_amdgcn_mfma_f32_32x32x16_bf16(kf_[2 * ks], qf[kk], s0_, 0, 0, 0); \
                s1_ = __builtin_amdgcn_mfma_f32_32x32x16_bf16(kf_[2 * ks + 1], qf[kk], s1_, 0, 0, 0); } \
            __builtin_amdgcn_sched_barrier(0); } \
        if (halft_) { _Pragma("unroll") for (int i = 0; i < 16; ++i) s1_[i] = -1e30f; } \
        sA = s0_; sB = s1_; } while (0)
#define AT_SM(tt, c) do { \
        float mx = fmaxf(sA[0], sB[0]); \
        _Pragma("unroll") for (int i = 1; i < 16; ++i) mx = fmaxf(fmaxf(sA[i], sB[i]), mx); \
        mx = fmaxf(mx, __shfl_xor(mx, 32)); \
        if ((tt) == 0) {     \
            mrun[c] = mx; \
            _Pragma("unroll") for (int i = 0; i < 16; ++i) { sA[i] -= mx; sB[i] -= mx; negm[c][i] = -mx; } \
        } else if (__any(mx > THR)) {     \
            const float dl = fmaxf(mx, 0.f); const float al = __builtin_amdgcn_exp2f(-dl); mrun[c] += dl; lrun[c] *= al; \
            _Pragma("unroll") for (int d = 0; d < NDB; ++d) _Pragma("unroll") for (int i = 0; i < 16; ++i) o[c][d][i] *= al; \
            const float nm = -mrun[c]; \
            _Pragma("unroll") for (int i = 0; i < 16; ++i) { sA[i] -= dl; sB[i] -= dl; negm[c][i] = nm; } } \
        float ps = 0.f; \
        _Pragma("unroll") for (int i = 0; i < 16; ++i) { sA[i] = __builtin_amdgcn_exp2f(sA[i]); sB[i] = __builtin_amdgcn_exp2f(sB[i]); ps += sA[i] + sB[i]; } \
        lrun[c] += ps; \
        pf[c][0][0] = pack8(sA, 0); pf[c][0][1] = pack8(sA, 8); pf[c][1][0] = pack8(sB, 0); pf[c][1][1] = pack8(sB, 8); } while (0)
#define AT_VRD(tt, d0) do { const LAS unsigned char* vp0_ = lds + (3 * KBY + ((tt) & 3) * VBY + vroff); \
        _Pragma("unroll") for (int dd = 0; dd < NDH; ++dd) _Pragma("unroll") for (int kb = 0; kb < 2; ++kb) _Pragma("unroll") for (int sp = 0; sp < 2; ++sp) { \
            const LAS unsigned char* vp = vp0_ + ((kb * 32 + sp * 16) * VSTR + ((d0) + dd) * 64); \
            vlo_[dd * 4 + kb * 2 + sp] = vtr(vp); vhi_[dd * 4 + kb * 2 + sp] = vtr(vp + 8 * VSTR); } } while (0)
#define AT_PVM(d0) do { _Pragma("unroll") for (int dd = 0; dd < NDH; ++dd) _Pragma("unroll") for (int kb = 0; kb < 2; ++kb) _Pragma("unroll") for (int sp = 0; sp < 2; ++sp) { \
            const s16x4 lo = vlo_[dd * 4 + kb * 2 + sp], hi = vhi_[dd * 4 + kb * 2 + sp]; \
            const bf16x8 vf = (bf16x8){lo[0], lo[1], lo[2], lo[3], hi[0], hi[1], hi[2], hi[3]}; \
            _Pragma("unroll") for (int c = 0; c < NS; ++c) o[c][(d0) + dd] = __builtin_amdgcn_mfma_f32_32x32x16_bf16(vf, pf[c][kb][sp], o[c][(d0) + dd], 0, 0, 0); } } while (0)
#define AT_PHA(tt) do { AT_QKC(tt, 0); if (MODE == 1) { AT_SM(tt, 0); } } while (0)
#define AT_PHB(tt) do { s16x4 vlo_[NDH * 4], vhi_[NDH * 4]; \
        AT_VRD(tt, 0); \
        __builtin_amdgcn_sched_barrier(0); \
        if (MODE == 1) { AT_QKC(tt, 1); AT_SM(tt, NS - 1); } else { AT_SM(tt, 0); } \
        __builtin_amdgcn_sched_barrier(0); \
        AT_PVM(0); \
        _Pragma("unroll") for (int d0 = NDH; d0 < NDB; d0 += NDH) { __builtin_amdgcn_sched_barrier(0); AT_VRD(tt, d0); __builtin_amdgcn_sched_barrier(0); AT_PVM(d0); } } while (0)
#define AT_BAR() asm volatile("s_waitcnt lgkmcnt(0)\n\ts_barrier" ::: "memory")
    AT_LOAD(0); AT_COMMIT(0);
    if (NT > 1) { AT_LOAD(1); AT_COMMIT(1); }
    AT_BAR();
    if (late) AT_BAR();
    for (int t = 0; t < NT; ++t) {
        if (PREF && t + 2 < NT) AT_LOAD(t + 2);
        if (PVA) {
            const bool pvok = t >= 1 && t - 1 < ntw;
            s16x4 vlo_[NDH * 4], vhi_[NDH * 4];
            if (pvok) AT_VRD(t - 1, 0);
            __builtin_amdgcn_sched_barrier(0);
            if (t < ntw) AT_QKC(t, 0);
            if (pvok) { AT_PVM(0);
#pragma unroll
                for (int d0 = NDH; d0 < NDB; d0 += NDH) { __builtin_amdgcn_sched_barrier(0); AT_VRD(t - 1, d0); __builtin_amdgcn_sched_barrier(0); AT_PVM(d0); } }
        } else { if (t < ntw) AT_PHA(t); }
        if (AT_STAGGER) AT_BAR();
        if (t < ntw) { if (PVA) { AT_SM(t, 0); } else { AT_PHB(t); } }
        if (t + 2 < NT) { if (!PREF) AT_LOAD(t + 2); AT_COMMIT(t + 2); }
        AT_BAR();
    }
    if (PVA && ntw == NT && ntw > 0) {
        s16x4 vlo_[NDH * 4], vhi_[NDH * 4];
#pragma unroll
        for (int d0 = 0; d0 < NDB; d0 += NDH) { AT_VRD(NT - 1, d0); __builtin_amdgcn_sched_barrier(0); AT_PVM(d0); __builtin_amdgcn_sched_barrier(0); }
    }
    if (AT_STAGGER && !late) AT_BAR();
    AT_BAR();
#undef AT_LOAD
#undef AT_COMMIT
#undef AT_QKC
#undef AT_SM
#undef AT_PHA
#undef AT_PHB
#undef AT_VRD
#undef AT_PVM
#undef AT_BAR
    if (active) {
        const int qi = wave * 32 + r;
        float inv[NS];
#pragma unroll
        for (int c = 0; c < NS; ++c) { const float lt = lrun[c] + __shfl_xor(lrun[c], 32); inv[c] = 1.f / lt; }
        float rs = 1.f;
        if (MODE == 1) {
            float ss = 0.f;
#pragma unroll
            for (int d = 0; d < NDB; ++d)
#pragma unroll
                for (int i = 0; i < 16; ++i) { const float v = o[0][d][i] * inv[0] - a.lam * (o[NS - 1][d][i] * inv[NS - 1]); o[0][d][i] = v; ss += v * v; }
            ss += __shfl_xor(ss, 32);
            rs = rsqrtf(ss * (1.f / 64.f) + EPSN) * (1.f - LAM_INIT);
        } else rs = inv[0];
        bf16* op = a.O + (size_t)(a.qrow0 + qi) * 1536;
#pragma unroll
        for (int d = 0; d < NDB; ++d)
#pragma unroll
            for (int g4 = 0; g4 < 4; ++g4) {
                const int dc = d * 32 + 8 * g4 + 4 * h;
                float w0 = o[0][d][4 * g4] * rs, w1 = o[0][d][4 * g4 + 1] * rs, w2 = o[0][d][4 * g4 + 2] * rs, w3 = o[0][d][4 * g4 + 3] * rs;
                if (MODE == 1) { const f32x4 gg = *(const f32x4*)(a.subg + dc); w0 *= gg[0]; w1 *= gg[1]; w2 *= gg[2]; w3 *= gg[3]; }
                u32x2 w; w.x = pk2(w0, w1); w.y = pk2(w2, w3);
                if (qi < a.nq) *(u32x2*)(op + dc) = w;
            }
    }
}

DI void p0_transpose_item(const float* W, int K, int N, bf16* WT, int row_off, LAS float* scr, int item, int lane, int ldw = 0, int kcol = 0) {
    if (ldw == 0) ldw = K;
    const int nblk = N / 32, kb = item / nblk, nb = item % nblk, k0 = 64 * kb, n0 = 32 * nb;
#pragma unroll 8
    for (int i = 0; i < 32; ++i) { const int kk = 2 * i + (lane >> 5); scr[kk * 33 + (lane & 31)] = W[(size_t)(k0 + kk) * N + n0 + (lane & 31)]; }
    asm volatile("s_waitcnt lgkmcnt(0)" ::: "memory");
    const int c = lane & 7;
#pragma unroll
    for (int j = 0; j < 4; ++j) { const int n = (lane >> 3) + 8 * j; const LAS float* s = scr + (8 * c) * 33 + n;
        u32x4 o; o.x = pk2(s[0 * 33], s[1 * 33]); o.y = pk2(s[2 * 33], s[3 * 33]); o.z = pk2(s[4 * 33], s[5 * 33]); o.w = pk2(s[6 * 33], s[7 * 33]);
        *(u32x4*)(WT + (size_t)(row_off + n0 + n) * ldw + kcol + k0 + 8 * c) = o; }
    asm volatile("s_waitcnt lgkmcnt(0)" ::: "memory");
}
DI void rms_row_1024(const float* xrow, const float* g, bf16* orow, int lane) {
    const f32x4* xr = (const f32x4*)xrow + lane; const f32x4* gr = (const f32x4*)g + lane;
    f32x4 v[4]; float s = 0.f;
#pragma unroll
    for (int j = 0; j < 4; ++j) { v[j] = xr[64 * j]; s += (v[j].x * v[j].x + v[j].y * v[j].y) + (v[j].z * v[j].z + v[j].w * v[j].w); }
    const float rstd = rsqrtf(wave_sum(s) * (1.f / 1024.f) + EPSN);
    u32x2* o8 = (u32x2*)orow + lane;
#pragma unroll
    for (int j = 0; j < 4; ++j) { const f32x4 gg = gr[64 * j]; u32x2 w; w.x = pk2(v[j].x * rstd * gg.x, v[j].y * rstd * gg.y); w.y = pk2(v[j].z * rstd * gg.z, v[j].w * rstd * gg.w); o8[64 * j] = w; }
}


template <int K> DI const float* inp_ld() {
    auto kp = __builtin_amdgcn_kernarg_segment_ptr();
    unsigned long long v;
    asm volatile("s_load_dwordx2 %0, %1, %2\n\ts_waitcnt lgkmcnt(0)" : "=s"(v) : "s"(kp), "n"(K * 8));
    return (const float*)(const __attribute__((address_space(1))) float*)v;
}
#define INP(k) inp_ld<k>()


#define RLX_AGENT __ATOMIC_RELAXED, __HIP_MEMORY_SCOPE_AGENT
#define XB_TMO      128
#define XB_XCNT(j)  (256  + 64 * (j))
#define XB_XSUB(j)  (1280 + 64 * (j))
#define XB_XGEN(j)  (2304 + 64 * (j))
#define XB_TOP      3328
#define XB_TOPGEN   3392
#define XCD_BAR_WORDS 3456
#define XB_SPIN_CAP (1u << 18)

__device__ __forceinline__ unsigned xb_ld(unsigned* p)              { return __hip_atomic_load(p, __ATOMIC_RELAXED, __HIP_MEMORY_SCOPE_AGENT); }
__device__ __forceinline__ unsigned xb_add(unsigned* p, unsigned v) { return __hip_atomic_fetch_add(p, v, __ATOMIC_RELAXED, __HIP_MEMORY_SCOPE_AGENT); }
__device__ __forceinline__ unsigned xb_xcc_id() { return (unsigned)__builtin_amdgcn_s_getreg((3 << 11) | 20) & 0xFu; }
#define XB_SPIN(cond, bar) do { unsigned _sp = 0; while (cond) { __builtin_amdgcn_s_sleep(1); \
    if ((++_sp & 255u) == 0u) { if (xb_ld(&(bar)[XB_TMO])) break; if (_sp > XB_SPIN_CAP) { atomicAdd(&(bar)[XB_TMO], 1u); break; } } } } while (0)

struct XcdBarrier {
    unsigned* bar; unsigned x;
    volatile LAS unsigned* st;
};

__device__ __forceinline__ XcdBarrier xcd_barrier_post(unsigned* bar, volatile LAS unsigned* st) {
    XcdBarrier b; b.bar = bar; b.x = xb_xcc_id(); b.st = st;
    if (threadIdx.x == 0) (void)xb_add(&bar[XB_XCNT(b.x)], 1u);
    return b;
}
__device__ __forceinline__ void xcd_barrier_complete(unsigned* bar, unsigned x, unsigned& nloc, unsigned& nx) {
    const unsigned G = gridDim.x * gridDim.y * gridDim.z;
    unsigned sum, cnt, mine, sp = 0u;
    for (;;) {
        sum = 0u; cnt = 0u; mine = 0u;
#pragma unroll
        for (unsigned j = 0; j < 16; ++j) { const unsigned c = xb_ld(&bar[XB_XCNT(j)]); sum += c; cnt += (c > 0u) ? 1u : 0u; mine = (j == x) ? c : mine; }
        if (sum == G) break;
        __builtin_amdgcn_s_sleep(1);
        if ((++sp & 255u) == 0u) { if (xb_ld(&bar[XB_TMO])) break; if (sp > XB_SPIN_CAP) { atomicAdd(&bar[XB_TMO], 1u); break; } }
    }
    nloc = mine > 0u ? mine : 1u; nx = cnt > 0u ? cnt : 1u;
}

__device__ __forceinline__ void xcd_barrier(const XcdBarrier& b) {
    asm volatile("s_waitcnt vmcnt(0)" ::: "memory");
    __syncthreads();
    if (threadIdx.x == 0) {
        unsigned* bar = b.bar;
        __builtin_amdgcn_s_waitcnt(0);
        unsigned nloc = b.st[0], nx = b.st[1];
        if (nloc == 0u) { xcd_barrier_complete(bar, b.x, nloc, nx); b.st[0] = nloc; b.st[1] = nx; }
        const unsigned old = xb_add(&bar[XB_XSUB(b.x)], 1u);
        const unsigned gen = old / nloc;
        if (old + 1u == (gen + 1u) * nloc) {
            __builtin_amdgcn_fence(__ATOMIC_RELEASE, "agent");
            asm volatile("s_waitcnt vmcnt(0)" ::: "memory");
            const unsigned og = xb_add(&bar[XB_TOP], 1u);
            const unsigned tg = og / nx;
            if (og + 1u == (tg + 1u) * nx) xb_add(&bar[XB_TOPGEN], 1u);
            else XB_SPIN(xb_ld(&bar[XB_TOPGEN]) == tg, bar);
            __builtin_amdgcn_fence(__ATOMIC_ACQUIRE, "agent");
            xb_add(&bar[XB_XGEN(b.x)], 1u);
            asm volatile("s_waitcnt vmcnt(0)" ::: "memory");
        } else {
            XB_SPIN(xb_ld(&bar[XB_XGEN(b.x)]) == gen, bar);
            __builtin_amdgcn_fence(__ATOMIC_ACQUIRE, "agent");
            asm volatile("s_waitcnt vmcnt(0)" ::: "memory");
        }
    }
    __syncthreads();
}

struct Args { const float* in[35]; float* out; unsigned char* ws; int ph_lo, ph_hi; };

constexpr int NPHASE = 11;
constexpr int LDS_BYTES = 147456;

__global__ void __launch_bounds__(512, 2) fwd_kernel(Args args) {
    extern __shared__ __attribute__((aligned(16))) unsigned char lds_raw[];
    LAS unsigned char* lds = (LAS unsigned char*)lds_raw;
    cg::grid_group grid = cg::this_grid();
    volatile LAS unsigned* MISC = (volatile LAS unsigned*)(lds + 131072 + 320);
    if (threadIdx.x < 64) MISC[threadIdx.x] = 0u;
    __syncthreads();
    XcdBarrier xbar = xcd_barrier_post((unsigned*)args.ws, MISC + 8);
    const int G = gridDim.x, bid = blockIdx.x;
    const int NGW = G * 8;
#define PHASE_IDS int tid = threadIdx.x; asm volatile("" : "+v"(tid)); const int lane = tid & 63, wave = __builtin_amdgcn_readfirstlane(tid >> 6); const int gw = bid * 8 + wave; (void)lane; (void)gw;
    unsigned char* ws = args.ws; float* out = args.out;
    const int lo = args.ph_lo, hi = args.ph_hi;
#ifndef PHM
#define PHM 0x7ff
#endif
#define IN(k) (((PHM >> (k)) & 1) && lo <= (k) && (k) < hi)
#ifndef REPM
#define REPM 0
#endif
#define REPS(k) for (int rq_ = 0; rq_ < (((REPM >> (k)) & 1) ? 2 : 1); ++rq_)
#define SEAM(k) do { if (IN(k) && IN((k) + 1)) { if (lo < 0) grid.sync(); xcd_barrier(xbar); } } while (0)
#define XN ((bf16*)(ws + WS_XN))
#define GB ((bf16*)(ws + WS_G))
#define CQ ((bf16*)(ws + WS_CQ))
#define CQN ((bf16*)(ws + WS_CQN))
#define QM ((bf16*)(ws + WS_QM))
#define DQ ((bf16*)(ws + WS_DQ))
#define MQ ((bf16*)(ws + WS_MQ))
#define DKP ((bf16*)(ws + WS_DKP))
#define DVP ((bf16*)(ws + WS_DVP))
#define KR ((bf16*)(ws + WS_KR))
#define MKB ((bf16*)(ws + WS_MK))
#define MVB ((bf16*)(ws + WS_MV))
#define LAT ((bf16*)(ws + WS_LAT))
#define KN ((bf16*)(ws + WS_KN))
#define VM ((bf16*)(ws + WS_VM))
#define OA ((bf16*)(ws + WS_OA))
#define MRG ((float*)(ws + WS_MRG))
#define MRGB ((bf16*)(ws + WS_MRGB))
#define MIX ((float*)(ws + WS_MIX))
#define UB ((bf16*)(ws + WS_U))
#define TABM ((float*)(ws + WS_TABM))
#define TABD ((float*)(ws + WS_TABD))

    if (IN(0)) REPS(0) {
        PHASE_IDS
        LAS float* scr = (LAS float*)(lds + wave * 16384);
        {
            constexpr int I_IN = 16 * 85, I_G = 16 * 96, I_UQ = 6 * 24, I_UK = 4 * 16, I_MK = 16 * 16, I_O = 8 * 32, I_OUT = 16 * 32, I_UP = 16 * 128, I_DN = 64 * 32;
            constexpr int NITEMS = I_IN + I_G + I_UQ + 2 * I_UK + 2 * I_MK + 3 * I_O + I_OUT + I_UP + I_DN;
            for (int it = gw; it < NITEMS; it += NGW) {
                int r = it;
                if (r < I_IN) { p0_transpose_item(INP(10), 1024, 2720, (bf16*)(ws + W_ING), 0, scr, r, lane); continue; } r -= I_IN;
                if (r < I_G) { p0_transpose_item(INP(27), 1024, 3072, (bf16*)(ws + W_ING), INWP, scr, r, lane); continue; } r -= I_G;
                if (r < I_UQ) { p0_transpose_item(INP(12), 384, 768, (bf16*)(ws + W_UQ), 0, scr, r, lane); continue; } r -= I_UQ;
                if (r < I_UK) { p0_transpose_item(INP(14), 256, 512, (bf16*)(ws + W_UKV), 0, scr, r, lane); continue; } r -= I_UK;
                if (r < I_UK) { p0_transpose_item(INP(15), 256, 512, (bf16*)(ws + W_UKV), 512, scr, r, lane); continue; } r -= I_UK;
                if (r < I_MK) { p0_transpose_item(INP(22), 1024, 512, (bf16*)(ws + W_MEM), 0, scr, r, lane); continue; } r -= I_MK;
                if (r < I_MK) { p0_transpose_item(INP(23), 1024, 512, (bf16*)(ws + W_MEM), 512, scr, r, lane); continue; } r -= I_MK;
                if (r < I_O) { p0_transpose_item(INP(24), 512, 1024, (bf16*)(ws + W_OM), 0, scr, r, lane, 1536, 0); continue; } r -= I_O;
                if (r < I_O) { p0_transpose_item(INP(25), 512, 1024, (bf16*)(ws + W_OM), 0, scr, r, lane, 1536, 512); continue; } r -= I_O;
                if (r < I_O) { p0_transpose_item(INP(26), 512, 1024, (bf16*)(ws + W_OM), 0, scr, r, lane, 1536, 1024); continue; } r -= I_O;
                if (r < I_OUT) { p0_transpose_item(INP(29), 1024, 1024, (bf16*)(ws + W_OUT), 0, scr, r, lane); continue; } r -= I_OUT;
                if (r < I_UP) { p0_transpose_item(INP(32), 1024, 4096, (bf16*)(ws + W_UP), 0, scr, r, lane); continue; } r -= I_UP;
                p0_transpose_item(INP(33), 4096, 1024, (bf16*)(ws + W_DN), 0, scr, r, lane);
            }
        }
        for (int i = gw * 64 + lane; i < 96 * 1024 / 8; i += NGW * 64) *(u32x4*)((bf16*)(ws + W_ING) + (size_t)2720 * 1024 + (size_t)i * 8) = (u32x4){0u, 0u, 0u, 0u};
        for (int m = gw; m < MROWS + NMEM; m += NGW) {
            if (m < SEQ) rms_row_1024(INP(0) + (size_t)m * DM, INP(9), XN + (size_t)m * DM, lane);
            else if (m < MROWS) rms_row_1024(INP(1) + (size_t)(m - SEQ) * DM, INP(9), XN + (size_t)m * DM, lane);
            else rms_row_1024(INP(8) + (size_t)(m - MROWS) * DM, INP(21), MRGB + (size_t)(m - MROWS) * DM, lane);
        }
        for (int i = gw; i < NSB * PAST; i += NGW) {
            const int b = i >> 12, s = i & 4095;
            const f32x4 v = *((const f32x4*)(INP(2) + (size_t)i * 256) + lane);
            u32x2 w; w.x = pk2(v.x, v.y); w.y = pk2(v.z, v.w);
            *((u32x2*)(LAT + (size_t)(SEQ + b * SKEYS + s) * 256) + lane) = w;
        }
        for (int i = gw; i < NSB * PAST / 8; i += NGW) {
            const int rowi = i * 8 + (lane >> 3); const int b = rowi >> 12, s = rowi & 4095;
            const f32x4 v = *((const f32x4*)(INP(3) + (size_t)rowi * 32) + (lane & 7));
            u32x2 w; w.x = pk2(v.x, v.y); w.y = pk2(v.z, v.w);
            *((u32x2*)(KR + (size_t)(SEQ + b * SKEYS + s) * 32) + (lane & 7)) = w;
        }
        for (int i = gw * 64 + lane; i < NSB * NMEM * 512 / 4; i += NGW * 64) {
            const f32x4 a = *((const f32x4*)INP(6) + i), b = *((const f32x4*)INP(7) + i);
            u32x2 w; w.x = pk2(a.x, a.y); w.y = pk2(a.z, a.w); *((u32x2*)(MKB + (size_t)NMEM * 512) + i) = w;
            w.x = pk2(b.x, b.y); w.y = pk2(b.z, b.w); *((u32x2*)(MVB + (size_t)NMEM * 512) + i) = w;
        }
        for (int i = gw * 64 + lane; i < SEQ * 16; i += NGW * 64) {
            const int pos = i >> 4, f = i & 15;
            const float inv = powf(10000.0f, -(float)f * (2.0f / 32.0f)); const float ang = (float)pos * inv;
            TABM[(size_t)pos * 32 + f] = cosf(ang); TABM[(size_t)pos * 32 + 16 + f] = sinf(ang);
        }
        for (int i = gw * 64 + lane; i < SEQ * 4; i += NGW * 64) {
            const int pos = i >> 2, f = i & 3;
            const float inv = powf(500000.0f, -(float)f * (2.0f / 8.0f)); const float ang = (float)pos * inv;
            TABD[(size_t)pos * 8 + f] = cosf(ang); TABD[(size_t)pos * 8 + 4 + f] = sinf(ang);
        }
        asm volatile("s_waitcnt vmcnt(0) lgkmcnt(0)" ::: "memory");
        __syncthreads();
    }
    SEAM(0);

    if (IN(1)) REPS(1) {
        {
            pg8::Gemm g{MRGB, (const bf16*)(ws + W_MEM), NMEM, 1024, 1024}; pg8::StaticOrder S; S.init(NMEM, 1024, G, (bid + 4) % G);
            EpiMemKV E{out, MKB, MVB};
            pg8::gemm_phase<EpiMemKV, pg8::StaticOrder, true, true>(lds, g, S, E);
        }
        {
            pg8::Gemm g{XN, (const bf16*)(ws + W_ING), MROWS, NING, 1024}; pg8::StaticOrder S; S.init(MROWS, NING, G, bid);
            EpiP1 E{CQ, KR, DQ, DKP, DVP, MQ, GB, out, INP(28), TABM, TABD};
            pg8::gemm_phase<EpiP1, pg8::StaticOrder, true, true>(lds, g, S, E);
        }
    }
    SEAM(1);

    if (IN(2)) {
        PHASE_IDS
        for (int row = gw; row < MROWS; row += NGW) {
            {
                u32x4 raw = (u32x4){0u, 0u, 0u, 0u};
                if (lane < 48) raw = *((const u32x4*)(CQ + (size_t)row * 384) + lane);
                float v[8] = {bf_lo(raw.x), bf_hi(raw.x), bf_lo(raw.y), bf_hi(raw.y), bf_lo(raw.z), bf_hi(raw.z), bf_lo(raw.w), bf_hi(raw.w)};
                float s = 0.f;
#pragma unroll
                for (int e = 0; e < 8; ++e) s += v[e] * v[e];
                const float rstd = rsqrtf(wave_sum(s) * (1.f / 384.f) + EPSN);
                if (lane < 48) {
                    const f32x4 g0 = *((const f32x4*)INP(11) + 2 * lane), g1 = *((const f32x4*)INP(11) + 2 * lane + 1);
                    u32x4 w; w.x = pk2(v[0] * rstd * g0.x, v[1] * rstd * g0.y); w.y = pk2(v[2] * rstd * g0.z, v[3] * rstd * g0.w);
                    w.z = pk2(v[4] * rstd * g1.x, v[5] * rstd * g1.y); w.w = pk2(v[6] * rstd * g1.z, v[7] * rstd * g1.w);
                    *((u32x4*)(CQN + (size_t)row * 384) + lane) = w;
                }
            }
            {
                float* p = out_row(out, row, O_PCKV, O_SCKV, 256);
                f32x4 v = *((const f32x4*)p + lane);
                const float s = (v.x * v.x + v.y * v.y) + (v.z * v.z + v.w * v.w);
                const float rstd = rsqrtf(wave_sum(s) * (1.f / 256.f) + EPSN);
                const f32x4 gg = *((const f32x4*)INP(13) + lane);
                v.x *= rstd * gg.x; v.y *= rstd * gg.y; v.z *= rstd * gg.z; v.w *= rstd * gg.w;
                *((f32x4*)p + lane) = v;
                u32x2 w; w.x = pk2(v.x, v.y); w.y = pk2(v.z, v.w);
                *((u32x2*)(LAT + (size_t)row_krow(row) * 256) + lane) = w;
            }
        }
    }
    SEAM(2);

    if (IN(3)) REPS(3) {
#ifndef NO_P3A
        {
            pg8::Gemm g{CQN, (const bf16*)(ws + W_UQ), MROWS, 768, 384}; pg8::StaticOrder S; S.init(MROWS, 768, G, bid);
            EpiUQ E{QM, TABM};
            pg8::gemm_phase<EpiUQ, pg8::StaticOrder, true, true>(lds, g, S, E);
        }
#endif
#ifndef NO_P3B
        {
            pg8::Gemm g{LAT, (const bf16*)(ws + W_UKV), MKROWS, 1024, 256}; pg8::StaticOrder S; S.init(MKROWS, 1024, G, (bid + 58) % G);
            EpiBf16Split E{KN, VM};
            pg8::gemm_phase<EpiBf16Split, pg8::StaticOrder, true, true>(lds, g, S, E);
        }
#endif
    }
    SEAM(3);

#ifndef REP_P4
#define REP_P4 1
#endif
    if (IN(4)) for (int rep_ = 0; rep_ < REP_P4; ++rep_) {
        PHASE_IDS
        float lam;
        {
            float sa = 0.f, sb = 0.f;
            if (lane < 32) { sa = INP(16)[lane] * INP(17)[lane]; sb = INP(18)[lane] * INP(19)[lane]; }
            sa = wave_sum(sa); sb = wave_sum(sb);
            lam = expf(sa) - expf(sb) + LAM_INIT;
        }
        constexpr int BIG = 1 << 30;
#define O_MLA OA
#define O_DIFF (OA + 512)
#define O_MEM (OA + 1024)
#ifndef KMASK
#define KMASK 15
#endif
#define AU_INIT(a) AU a; a.lam = lam; a.subg = INP(20); a.ldo = 512; a.Kb = nullptr; a.Vb = nullptr; a.Kr = KR; a.ldkr = 32; a.nsplit = BIG; a.ldk = 512; a.ldv = 512; a.limbase = BIG / 2;
        if (KMASK & 1) for (int it = bid; it < 256; it += G) {
#pragma unroll 1
            for (int e = 0; e < 2; ++e) {
                AU_INIT(a)
                const int head = it & 7, pair = it >> 3, qb = e == 0 ? 63 - pair : pair;
                a.qrow0 = qb * 256; a.nq = 256; a.nkeys = (qb + 1) * 256; a.limbase = 4 * qb;
                a.Q = QM + head * 96; a.ldq = 768; a.Ka = KN + head * 64; a.Va = VM + head * 64; a.O = O_MLA + head * 64;
                attn_unit<0, false, true>(lds, a, tid);
            }
        }
        if (KMASK & 1) for (int it = bid; it < 128; it += G) {
            AU_INIT(a)
            const int b = it >> 3, head = it & 7; const size_t k0 = (size_t)SEQ + (size_t)b * SKEYS;
            a.qrow0 = SEQ + b * 32; a.nq = 32; a.nkeys = SKEYS;
            a.Q = QM + head * 96; a.ldq = 768; a.Ka = KN + k0 * 512 + head * 64; a.Kr = KR + k0 * 32; a.Va = VM + k0 * 512 + head * 64; a.O = O_MLA + head * 64;
            attn_unit<0, false, false>(lds, a, tid);
        }
#ifndef REP_DIFF
#define REP_DIFF 1
#endif
        if (KMASK & 2) for (int rp_ = 0; rp_ < REP_DIFF; ++rp_) for (int it = bid; it < 256; it += G) {
#pragma unroll 1
            for (int e = 0; e < 2; ++e) {
                AU_INIT(a)
                const int head = it & 7, pair = it >> 3, qb = e == 0 ? 63 - pair : pair;
                a.qrow0 = qb * 256; a.nq = 256; a.nkeys = (qb + 1) * 256; a.limbase = 4 * qb;
                a.Q = DQ + head * 64; a.ldq = 512; a.Ka = DKP + head * 64; a.Va = DVP + head * 64; a.O = O_DIFF + head * 64;
                attn_unit<1, false, true>(lds, a, tid);
            }
        }
        if (KMASK & 4) for (int it = (bid + G / 2) % G; it < 128; it += G) {
            AU_INIT(a)
            const int b = it >> 3, head = it & 7;
            a.qrow0 = SEQ + b * 32; a.nq = 32; a.nkeys = SKEYS; a.Q = DQ + head * 64; a.ldq = 512; a.nsplit = PAST;
            a.Ka = INP(4) + (size_t)b * PAST * 512 + head * 64; a.Kb = out + O_SDK + (size_t)b * 32 * 512 + head * 64;
            a.Va = INP(5) + (size_t)b * PAST * 512 + head * 64; a.Vb = out + O_SDV + (size_t)b * 32 * 512 + head * 64;
            a.O = O_DIFF + head * 64;
            attn_unit<1, true, false>(lds, a, tid);
        }
        if (KMASK & 8) for (int it = bid; it < 320; it += G) {
            AU_INIT(a)
            a.nkeys = NMEM; a.ldq = 512;
            if (it < 256) { const int qb = it >> 2, hm = it & 3; a.qrow0 = qb * 256; a.nq = 256; a.Q = MQ + hm * 128; a.Ka = MKB + hm * 128; a.Va = MVB + hm * 128; a.O = O_MEM + hm * 128; }
            else { const int jj = it - 256, b = jj >> 2, hm = jj & 3; a.qrow0 = SEQ + b * 32; a.nq = 32; a.Q = MQ + hm * 128;
                a.Ka = MKB + (size_t)(1 + b) * NMEM * 512 + hm * 128; a.Va = MVB + (size_t)(1 + b) * NMEM * 512 + hm * 128; a.O = O_MEM + hm * 128; }
            attn_unit<2, false, true>(lds, a, tid);
        }
#undef AU_INIT
    }
    SEAM(4);

    if (IN(5)) REPS(5) {
        pg8::Gemm g{OA, (const bf16*)(ws + W_OM), MROWS, 1024, 1536, 0}; pg8::StaticOrder S; S.init(MROWS, 1024, G, bid); EpiMergeK E{GB, MRGB};
        pg8::gemm_phase<EpiMergeK, pg8::StaticOrder, true, true>(lds, g, S, E);
    }
    SEAM(5);

    if (IN(6)) REPS(6) {
        { pg8::Gemm g{MRGB, (const bf16*)(ws + W_OUT), SEQ, 1024, 1024, 0}; pg8::StaticOrder S; S.init(SEQ, 1024, G, bid); EpiF32 E{MIX, 1024};
          pg8::gemm_phase<EpiF32, pg8::StaticOrder, true, true>(lds, g, S, E); }
        { int kl = 128; asm volatile("" : "+s"(kl));
          pg8::Gemm g{MRGB, (const bf16*)(ws + W_OUT), MROWS, 1024, 1024, kl}; PieceOrder S{8, kl, G, (bid + 96) % G}; EpiPart E{(float*)(ws + WS_PART), 7};
          pg8::gemm_phase<EpiPart, PieceOrder, true, true>(lds, g, S, E); }
    }
    SEAM(6);

    if (IN(7)) REPS(7) {
        PHASE_IDS
        for (int row = gw; row < MROWS; row += NGW) {
            const float* xr = row < SEQ ? INP(0) + (size_t)row * DM : INP(1) + (size_t)(row - SEQ) * DM;
            const f32x4* mr = (const f32x4*)(MIX + (size_t)row * DM) + lane;
            f32x4 v[4]; float s = 0.f;
#pragma unroll
            for (int j = 0; j < 4; ++j) {
                if (row < SEQ) v[j] = mr[64 * j];
                else { const f32x4* pr = (const f32x4*)((const float*)(ws + WS_PART) + (size_t)(row - SEQ) * DM) + lane + 64 * j; v[j] = pr[0];
#pragma unroll
                    for (int sl = 1; sl < 8; ++sl) v[j] += pr[(size_t)sl * (512 * 1024 / 4)]; }
                s += (v[j].x * v[j].x + v[j].y * v[j].y) + (v[j].z * v[j].z + v[j].w * v[j].w); }
            const float rstd = rsqrtf(wave_sum(s) * (1.f / 1024.f) + EPSN);
            float s2 = 0.f;
#pragma unroll
            for (int j = 0; j < 4; ++j) { const f32x4 gg = *((const f32x4*)INP(30) + lane + 64 * j); const f32x4 xx = *((const f32x4*)xr + lane + 64 * j);
                v[j].x = xx.x + v[j].x * rstd * gg.x; v[j].y = xx.y + v[j].y * rstd * gg.y; v[j].z = xx.z + v[j].z * rstd * gg.z; v[j].w = xx.w + v[j].w * rstd * gg.w;
                s2 += (v[j].x * v[j].x + v[j].y * v[j].y) + (v[j].z * v[j].z + v[j].w * v[j].w);
                *((f32x4*)(out + O_Y + (size_t)row * DM) + lane + 64 * j) = v[j]; }
            const float rstd2 = rsqrtf(wave_sum(s2) * (1.f / 1024.f) + EPSN);
#pragma unroll
            for (int j = 0; j < 4; ++j) { const f32x4 gg = *((const f32x4*)INP(31) + lane + 64 * j);
                u32x2 w; w.x = pk2(v[j].x * rstd2 * gg.x, v[j].y * rstd2 * gg.y); w.y = pk2(v[j].z * rstd2 * gg.z, v[j].w * rstd2 * gg.w);
                *((u32x2*)(XN + (size_t)row * DM) + lane + 64 * j) = w; }
        }
    }
    SEAM(7);

    if (IN(8)) REPS(8) {
        pg8::Gemm g{XN, (const bf16*)(ws + W_UP), MROWS, DFF, 1024}; pg8::StaticOrder S; S.init(MROWS, DFF, G, bid); EpiUp E{UB};
        pg8::gemm_phase<EpiUp, pg8::StaticOrder, true, true>(lds, g, S, E);
    }
    SEAM(8);

    if (IN(9)) REPS(9) {
        { pg8::Gemm g{UB, (const bf16*)(ws + W_DN), SEQ, 1024, DFF, 0}; pg8::StaticOrder S; S.init(SEQ, 1024, G, bid); EpiF32 E{MIX, 1024};
          pg8::gemm_phase<EpiF32, pg8::StaticOrder, true, true>(lds, g, S, E); }
        { pg8::Gemm g{UB, (const bf16*)(ws + W_DN), MROWS, 1024, DFF, 256}; PieceOrder S{16, 256, G, bid}; EpiPart E{(float*)(ws + WS_PART), 8};
          pg8::gemm_phase<EpiPart, PieceOrder, true, true>(lds, g, S, E); }
    }
    SEAM(9);

    if (IN(10)) {
        PHASE_IDS
        for (int row = gw; row < MROWS; row += NGW) {
            const f32x4* fr_ = (const f32x4*)(MIX + (size_t)row * DM) + lane;
            f32x4 v[4]; float s = 0.f;
#pragma unroll
            for (int j = 0; j < 4; ++j) {
                if (row < SEQ) v[j] = fr_[64 * j];
                else { const f32x4* pr = (const f32x4*)((const float*)(ws + WS_PART) + (size_t)(row - SEQ) * DM) + lane + 64 * j; v[j] = pr[0];
#pragma unroll
                    for (int sl = 1; sl < 16; ++sl) v[j] += pr[(size_t)sl * (512 * 1024 / 4)]; }
                s += (v[j].x * v[j].x + v[j].y * v[j].y) + (v[j].z * v[j].z + v[j].w * v[j].w); }
            const float rstd = rsqrtf(wave_sum(s) * (1.f / 1024.f) + EPSN);
#pragma unroll
            for (int j = 0; j < 4; ++j) { const f32x4 gg = *((const f32x4*)INP(34) + lane + 64 * j); f32x4* yp = (f32x4*)(out + O_Y + (size_t)row * DM) + lane + 64 * j; const f32x4 xx = *yp;
                f32x4 y; y.x = xx.x + v[j].x * rstd * gg.x; y.y = xx.y + v[j].y * rstd * gg.y; y.z = xx.z + v[j].z * rstd * gg.z; y.w = xx.w + v[j].w * rstd * gg.w; *yp = y; }
        }
    }
#undef IN
#undef SEAM
}

#ifndef MK_N_LAUNCHES
#define MK_N_LAUNCHES 1
#endif

extern "C" void kernel_launch(void* const* d_in, const int* in_sizes, int n_in, void* d_out, int out_size, void* d_ws, size_t ws_size, hipStream_t stream) {
    static int grid = 0;
    if (grid == 0) {
        if (n_in != 35 || out_size != (int)O_END || ws_size < WS_END) { fprintf(stderr, "kernel_launch: unexpected shapes: n_in %d out %d ws %zu\n", n_in, out_size, ws_size); grid = -1; return; }
        int dev = 0, cus = 0, per_cu = 0;
        hipGetDevice(&dev); hipDeviceGetAttribute(&cus, hipDeviceAttributeMultiprocessorCount, dev);
        if (hipFuncSetAttribute((const void*)fwd_kernel, hipFuncAttributeMaxDynamicSharedMemorySize, LDS_BYTES) != hipSuccess) { fprintf(stderr, "kernel_launch: hipFuncSetAttribute failed\n"); grid = -1; return; }
        hipOccupancyMaxActiveBlocksPerMultiprocessor(&per_cu, (const void*)fwd_kernel, 512, LDS_BYTES);
        (void)hipGetLastError();
        if (per_cu < 1) per_cu = 1;
        grid = cus;
    }
    if (grid < 0) return;
    if (hipMemsetAsync(d_ws, 0, 16384, stream) != hipSuccess) { fprintf(stderr, "kernel_launch: memset of the barrier words failed\n"); return; }
    Args a{};
    for (int i = 0; i < 35; ++i) a.in[i] = (const float*)d_in[i];
    a.out = (float*)d_out; a.ws = (unsigned char*)d_ws;
#if MK_N_LAUNCHES == 1
    a.ph_lo = 0; a.ph_hi = NPHASE;
    void* kargs[] = {&a};
    hipError_t e = hipLaunchCooperativeKernel((const void*)fwd_kernel, dim3(grid), dim3(512), kargs, LDS_BYTES, stream);
    if (e != hipSuccess) fprintf(stderr, "cooperative launch failed: %s (grid %d)\n", hipGetErrorString(e), grid);
#else
    for (int p = 0; p < NPHASE; ++p) { a.ph_lo = p; a.ph_hi = p + 1; hipLaunchKernelGGL(fwd_kernel, dim3(grid), dim3(512), LDS_BYTES, stream, a); }
#endif
}
```
